# Optimizing an MI355X kernel written in HIP

```python
import math
import jax, jax.numpy as jnp
from jax import lax
import numpy as np

D_MODEL = 4096
BATCH = 4
SEQ = 2048
DEPTH = 1

MEM_LEN = 256
MLA_HEADS = 16
MLA_Q_RANK = 1024
MLA_KV_RANK = 512
MLA_NOPE = 128
MLA_ROPE = 64
MLA_V = 128
Q_BLOCK = 128
RET_HEADS = 8
RET_DK = 256
RET_DV = 512
RET_CHUNK = 128
X_HEADS = 4
X_HEAD_DIM = D_MODEL // X_HEADS
D_FF = 11008
CONV_W = 3
ROPE_THETA = 10000.0
LN_EPS = 1e-5
RMS_EPS = 1e-6
ALPHA = (2 * DEPTH) ** 0.25
BETA = (8 * DEPTH) ** -0.25
N_BRANCHES = 2

IN_SIZES = (MLA_Q_RANK, MLA_KV_RANK, MLA_ROPE,
            RET_HEADS * RET_DK, RET_HEADS * RET_DK, RET_HEADS * RET_DV, RET_HEADS * RET_DV,
            N_BRANCHES * D_MODEL)
IN_WIDTH = int(sum(IN_SIZES))
IN_SPLITS = [int(v) for v in np.cumsum(IN_SIZES)[:-1]]

kernel_name = 'hybrid_mla_retention_encoder_block'


def _layer_norm(x, g, b):
    xf = x.astype(jnp.float32)
    mu = jnp.mean(xf, axis=-1, keepdims=True)
    var = jnp.mean(jnp.square(xf - mu), axis=-1, keepdims=True)
    y = (xf - mu) * lax.rsqrt(var + LN_EPS)
    return (y * g.astype(jnp.float32) + b.astype(jnp.float32)).astype(x.dtype)


def _rms_norm(x, g):
    xf = x.astype(jnp.float32)
    y = xf * lax.rsqrt(jnp.mean(jnp.square(xf), axis=-1, keepdims=True) + RMS_EPS)
    return (y * g.astype(jnp.float32)).astype(x.dtype)


def _group_norm(o):
    of = o.astype(jnp.float32)
    mu = jnp.mean(of, axis=-1, keepdims=True)
    var = jnp.mean(jnp.square(of - mu), axis=-1, keepdims=True)
    return ((of - mu) * lax.rsqrt(var + LN_EPS)).astype(o.dtype)


def _rope(t, positions):
    d = t.shape[-1]
    half = d // 2
    inv = ROPE_THETA ** (-jnp.arange(half, dtype=jnp.float32) / half)
    ang = positions.astype(jnp.float32)[:, :, None] * inv
    cos = jnp.cos(ang)[:, :, None, :].astype(t.dtype)
    sin = jnp.sin(ang)[:, :, None, :].astype(t.dtype)
    t1, t2 = t[..., :half], t[..., half:]
    return jnp.concatenate([t1 * cos - t2 * sin, t2 * cos + t1 * sin], axis=-1)


def _blocked_attention(q, k, v, scale):
    B, S, H, dq = q.shape
    dv = v.shape[-1]
    nb = S // Q_BLOCK
    qb = q.reshape(B, nb, Q_BLOCK, H, dq).transpose(1, 0, 2, 3, 4)

    def one_block(q_blk):
        s = jnp.einsum('bqhd,bkhd->bhqk', q_blk, k).astype(jnp.float32) * scale
        p = jax.nn.softmax(s, axis=-1).astype(v.dtype)
        return jnp.einsum('bhqk,bkhe->bqhe', p, v)

    o = lax.map(one_block, qb)
    return o.transpose(1, 0, 2, 3, 4).reshape(B, S, H, dv)


def _log_decay(e):
    return jnp.log1p(-jnp.exp2(-e.astype(jnp.float32)))


def _retention_scan(q, k, v, log_g, strict):
    B, H, S, dk = q.shape
    dv = v.shape[-1]
    nc = S // RET_CHUNK
    dt = q.dtype
    idx = jnp.arange(RET_CHUNK, dtype=jnp.float32)
    diff = idx[:, None] - idx[None, :]
    mask = (diff > 0) if strict else (diff >= 0)
    decay_in = jnp.where(mask[None], jnp.exp(log_g[:, None, None] * jnp.where(mask, diff, 0.0)[None]), 0.0).astype(dt)
    xi = jnp.exp(log_g[:, None] * (idx + 1.0)).astype(dt)[None, :, :, None]
    zeta = jnp.exp(log_g[:, None] * (RET_CHUNK - 1.0 - idx)).astype(dt)[None, :, :, None]
    g_chunk = jnp.exp(log_g * RET_CHUNK).astype(dt)[None, :, None, None]

    def to_chunks(t):
        return jnp.moveaxis(t.reshape(B, H, nc, RET_CHUNK, t.shape[-1]), 2, 0)

    def step(state, inp):
        qc, kc, vc = inp
        scores = jnp.einsum('bhnd,bhmd->bhnm', qc, kc) * decay_in[None]
        o = jnp.einsum('bhnm,bhme->bhne', scores, vc) + jnp.einsum('bhnd,bhde->bhne', qc, state) * xi
        state = state * g_chunk + jnp.einsum('bhmd,bhme->bhde', kc * zeta, vc)
        return state, o

    state0 = jnp.zeros((B, H, dk, dv), dtype=dt)
    _, o = lax.scan(step, state0, (to_chunks(q), to_chunks(k), to_chunks(v)))
    return jnp.moveaxis(o, 0, 2).reshape(B, H, S, dv)


def _dwconv_centred(u, w, b):
    up = jnp.pad(u, ((0, 0), (1, 1), (0, 0)))
    return up[:, :-2] * w[0] + up[:, 1:-1] * w[1] + up[:, 2:] * w[2] + b


def setup_inputs(seed: int = 0) -> dict:
    key = jax.random.key(seed)
    ks = jax.random.split(key, 32)
    f32 = jnp.float32

    def w(k, shape, fan_in, scale=1.0):
        return jax.random.normal(k, shape, f32) * (fan_in ** -0.5) * scale

    def gain(k, shape):
        return 1.0 + 0.02 * jax.random.normal(k, shape, f32)

    def bias(k, shape):
        return 0.01 * jax.random.normal(k, shape, f32)

    L = DEPTH
    x = jax.random.normal(ks[0], (BATCH, SEQ, D_MODEL), f32)
    mem = jax.random.normal(ks[1], (BATCH, MEM_LEN, D_MODEL), f32)
    positions = jax.random.randint(ks[2], (BATCH, 1), 0, 1024, dtype=jnp.int32) + jnp.arange(SEQ, dtype=jnp.int32)[None, :]
    decay_base = 5.0 + jnp.arange(RET_HEADS, dtype=f32)
    return {
        'x': x,
        'mem': mem,
        'positions': positions,
        'w_in': w(ks[3], (L, D_MODEL, IN_WIDTH), D_MODEL),
        'gate_bias': bias(ks[4], (L, N_BRANCHES, D_MODEL)),
        'q_norm_g': gain(ks[5], (L, MLA_Q_RANK)),
        'w_uq': w(ks[6], (L, MLA_Q_RANK, MLA_HEADS * (MLA_NOPE + MLA_ROPE)), MLA_Q_RANK),
        'kv_norm_g': gain(ks[7], (L, MLA_KV_RANK)),
        'w_ukv': w(ks[8], (L, MLA_KV_RANK, MLA_HEADS * (MLA_NOPE + MLA_V)), MLA_KV_RANK),
        'ret_decay_fwd': decay_base + 0.1 * jax.random.normal(ks[9], (L, RET_HEADS), f32),
        'ret_decay_bwd': decay_base + 0.1 * jax.random.normal(ks[10], (L, RET_HEADS), f32),
        'w_br_mla': w(ks[11], (L, MLA_HEADS * MLA_V, D_MODEL), MLA_HEADS * MLA_V),
        'w_br_ret': w(ks[12], (L, RET_HEADS * RET_DV, D_MODEL), RET_HEADS * RET_DV),
        'w_o': w(ks[13], (L, D_MODEL, D_MODEL), D_MODEL, BETA),
        'ln1_g': gain(ks[14], (L, D_MODEL)),
        'ln1_b': bias(ks[15], (L, D_MODEL)),
        'w_cq': w(ks[16], (L, D_MODEL, D_MODEL), D_MODEL),
        'w_ck': w(ks[17], (L, D_MODEL, D_MODEL), D_MODEL),
        'w_cv': w(ks[18], (L, D_MODEL, D_MODEL), D_MODEL),
        'w_co': w(ks[19], (L, D_MODEL, D_MODEL), D_MODEL, BETA),
        'ln2_g': gain(ks[20], (L, D_MODEL)),
        'ln2_b': bias(ks[21], (L, D_MODEL)),
        'w_ffn_in': w(ks[22], (L, D_MODEL, 2 * D_FF), D_MODEL),
        'conv_w': w(ks[23], (L, CONV_W, 2 * D_FF), CONV_W),
        'conv_b': bias(ks[24], (L, 2 * D_FF)),
        'w_ffn_out': w(ks[25], (L, D_FF, D_MODEL), D_FF, BETA),
        'ln3_g': gain(ks[26], (L, D_MODEL)),
        'ln3_b': bias(ks[27], (L, D_MODEL)),
    }


def reference(x, mem, positions, w_in, gate_bias, q_norm_g, w_uq, kv_norm_g, w_ukv,
              ret_decay_fwd, ret_decay_bwd, w_br_mla, w_br_ret, w_o, ln1_g, ln1_b,
              w_cq, w_ck, w_cv, w_co, ln2_g, ln2_b, w_ffn_in, conv_w, conv_b,
              w_ffn_out, ln3_g, ln3_b):
    B, S, _ = x.shape
    M = mem.shape[1]
    h = x
    for l in range(DEPTH):
        proj = h @ w_in[l]
        c_q, c_kv, k_r, r_q, r_k, r_v, r_g, gates = jnp.split(proj, IN_SPLITS, axis=-1)

        q = (_rms_norm(c_q, q_norm_g[l]) @ w_uq[l]).reshape(B, S, MLA_HEADS, MLA_NOPE + MLA_ROPE)
        q_nope, q_pe = q[..., :MLA_NOPE], _rope(q[..., MLA_NOPE:], positions)
        kv = (_rms_norm(c_kv, kv_norm_g[l]) @ w_ukv[l]).reshape(B, S, MLA_HEADS, MLA_NOPE + MLA_V)
        k_nope, v_mla = kv[..., :MLA_NOPE], kv[..., MLA_NOPE:]
        k_pe = _rope(k_r[:, :, None, :], positions)
        q_full = jnp.concatenate([q_nope, q_pe], axis=-1)
        k_full = jnp.concatenate([k_nope, jnp.broadcast_to(k_pe, (B, S, MLA_HEADS, MLA_ROPE))], axis=-1)
        a_out = _blocked_attention(q_full, k_full, v_mla, (MLA_NOPE + MLA_ROPE) ** -0.5)
        a_out = a_out.reshape(B, S, MLA_HEADS * MLA_V)

        rq = _rope(r_q.reshape(B, S, RET_HEADS, RET_DK), positions).transpose(0, 2, 1, 3)
        rk = (_rope(r_k.reshape(B, S, RET_HEADS, RET_DK), positions) * (RET_DK ** -0.5)).transpose(0, 2, 1, 3)
        rv = r_v.reshape(B, S, RET_HEADS, RET_DV).transpose(0, 2, 1, 3)
        o_fwd = _retention_scan(rq, rk, rv, _log_decay(ret_decay_fwd[l]), False)
        o_bwd = _retention_scan(rq[:, :, ::-1], rk[:, :, ::-1], rv[:, :, ::-1],
                                _log_decay(ret_decay_bwd[l]), True)[:, :, ::-1]
        o_ret = _group_norm(o_fwd + o_bwd).transpose(0, 2, 1, 3).reshape(B, S, RET_HEADS * RET_DV)
        r_out = jax.nn.silu(r_g) * o_ret

        g = jax.nn.sigmoid(gates.reshape(B, S, N_BRANCHES, D_MODEL) + gate_bias[l])
        mixed = g[:, :, 0] * (a_out @ w_br_mla[l]) + g[:, :, 1] * (r_out @ w_br_ret[l])
        h = _layer_norm(ALPHA * h + mixed @ w_o[l], ln1_g[l], ln1_b[l])

        cq = (h @ w_cq[l]).reshape(B, S, X_HEADS, X_HEAD_DIM)
        ck = (mem @ w_ck[l]).reshape(B, M, X_HEADS, X_HEAD_DIM)
        cv = (mem @ w_cv[l]).reshape(B, M, X_HEADS, X_HEAD_DIM)
        s = jnp.einsum('bqhd,bmhd->bhqm', cq, ck).astype(jnp.float32) * (X_HEAD_DIM ** -0.5)
        p = jax.nn.softmax(s, axis=-1).astype(cv.dtype)
        c_out = jnp.einsum('bhqm,bmhd->bqhd', p, cv).reshape(B, S, D_MODEL)
        h = _layer_norm(ALPHA * h + c_out @ w_co[l], ln2_g[l], ln2_b[l])

        u = _dwconv_centred(h @ w_ffn_in[l], conv_w[l], conv_b[l])
        up, gt = u[..., :D_FF], u[..., D_FF:]
        h = _layer_norm(ALPHA * h + (jax.nn.silu(gt) * up) @ w_ffn_out[l], ln3_g[l], ln3_b[l])
    return h
```

```cpp
#include <hip/hip_runtime.h>
#include <cstdio>
#include <cstdint>

#ifndef MK_PER_PHASE
#define MK_PER_PHASE 0
#endif

#define LAS __attribute__((address_space(3)))
#define GAS __attribute__((address_space(1)))
typedef unsigned short bf16_t;
typedef short bf16x8 __attribute__((ext_vector_type(8)));
typedef short s16x4 __attribute__((ext_vector_type(4)));
typedef float f32x2 __attribute__((ext_vector_type(2)));
typedef float f32x4 __attribute__((ext_vector_type(4)));
typedef float f32x16 __attribute__((ext_vector_type(16)));
typedef unsigned u32x2 __attribute__((ext_vector_type(2)));
typedef unsigned u32x4 __attribute__((ext_vector_type(4)));

constexpr int NB = 4, SEQ = 2048, T = NB * SEQ, D = 4096;
constexpr int MEM = 256, TM = NB * MEM;
constexpr int INW = 22080, INP = 22272;
constexpr int DFF = 11008, DFF2 = 22016;
constexpr float ALPHA = 1.189207115002721f;
constexpr float LN_EPS = 1e-5f, RMS_EPS = 1e-6f;
constexpr int NWAVES = 8;
constexpr int GTP = 8192 + 128, RGP = 4096 + 64;

constexpr size_t MiB = 1u << 20;
constexpr size_t WS_CTL = 0, CTL_ZERO_BYTES = 640 * 1024;
constexpr size_t WS_RSS = 64 * 1024;
constexpr size_t WS_RS1 = 128 * 1024, WS_RS2 = 192 * 1024, WS_RS3 = 256 * 1024;
constexpr size_t WS_S1 = 320 * 1024, WS_C1 = 336 * 1024;
constexpr size_t WS_S2 = 352 * 1024, WS_C2 = 448 * 1024;
constexpr size_t WS_CONVW = 640 * 1024;
constexpr size_t WS_CONVB = WS_CONVW + 3 * (size_t)DFF2 * 4;
constexpr size_t WS_MISC = 1000 * 1024;
constexpr size_t WS_WIN = 1 * MiB;
constexpr size_t WS_WFI = 175 * MiB;
constexpr size_t WS_WFO = 347 * MiB;
constexpr size_t WS_WBR = 433 * MiB;
constexpr size_t WS_WO = 465 * MiB, WS_WCQ = 497 * MiB, WS_WCK = 529 * MiB, WS_WCV = 561 * MiB, WS_WCO = 593 * MiB;
constexpr size_t WS_WBM = 625 * MiB;
constexpr size_t WS_WUQ = 641 * MiB;
constexpr size_t WS_WUKV = 647 * MiB;
constexpr size_t WS_MEMB = 651 * MiB;
constexpr size_t WS_ROPER = 659 * MiB;
constexpr size_t WS_ROPEA = 667 * MiB;
constexpr size_t WS_XB = 670 * MiB;
constexpr size_t WS_ROUT = 670 * MiB;
constexpr size_t WS_CQM = 734 * MiB;
constexpr size_t WS_CKV = 750 * MiB;
constexpr size_t WS_KPE = 758 * MiB;
constexpr size_t WS_RQ = 759 * MiB;
constexpr size_t WS_RK = 791 * MiB;
constexpr size_t WS_RVT = 823 * MiB;
constexpr size_t WS_RG = 1335 * MiB;
constexpr size_t WS_GT = 887 * MiB;
constexpr size_t WS_SC = 1079 * MiB;
constexpr size_t WS_END = 1400 * MiB;
constexpr size_t WS_AO = 1 * MiB;
constexpr size_t WS_Q = 33 * MiB;
constexpr size_t WS_KV = 81 * MiB;
constexpr size_t WS_ORET = 33 * MiB;
constexpr size_t WS_TMP = 1079 * MiB;
constexpr size_t WS_MIXED = 1207 * MiB;
constexpr size_t WS_Z = 887 * MiB;
constexpr size_t WS_ZB = 1015 * MiB;
constexpr size_t WS_MQT = 1079 * MiB;
constexpr size_t WS_VWT = 1111 * MiB;
constexpr size_t WS_CK = 1143 * MiB;
constexpr size_t WS_CV = 1151 * MiB;
constexpr size_t WS_XS = 1159 * MiB;
constexpr size_t WS_XP = 1223 * MiB;
constexpr size_t WS_SX = 1239 * MiB, WS_CX = WS_SX + 16384;
constexpr size_t WS_EDGE = 433 * MiB;
constexpr size_t WS_ACT = 1 * MiB;

constexpr int CW_BAR = 4096;

constexpr int RING_BYTES = 131072;
constexpr int LDSCTL_OFF = RING_BYTES, MISC_OFF = LDSCTL_OFF + 320;
constexpr int TR_OFF = RING_BYTES + 1024, TR_BYTES = 8 * 2048;
constexpr int LDS_BYTES = 155648;
static_assert(TR_OFF + TR_BYTES <= LDS_BYTES && MISC_OFF + 128 <= TR_OFF, "LDS map");

#define LDS_WAIT() asm volatile("s_waitcnt lgkmcnt(0)" ::: "memory")
#define VM_WAIT() asm volatile("s_waitcnt vmcnt(0)" ::: "memory")

typedef __bf16 bf16x2_t __attribute__((ext_vector_type(2)));
__device__ __forceinline__ unsigned cvt_pk_bf16(float lo, float hi) { const f32x2 v = {lo, hi}; const bf16x2_t b = __builtin_convertvector(v, bf16x2_t); return __builtin_bit_cast(unsigned, b); }
__device__ __forceinline__ int lane_id() { int l; asm volatile("v_mbcnt_lo_u32_b32 %0, -1, 0\n\tv_mbcnt_hi_u32_b32 %0, -1, %0" : "=v"(l)); return l; }
__device__ __forceinline__ float bf_lo(unsigned w) { return __uint_as_float(w << 16); }
__device__ __forceinline__ float bf_hi(unsigned w) { return __uint_as_float(w & 0xffff0000u); }
__device__ __forceinline__ float sigmoidf_(float x) { return __builtin_amdgcn_rcpf(1.0f + __expf(-x)); }
__device__ __forceinline__ float siluf_(float x) { return x * __builtin_amdgcn_rcpf(1.0f + __expf(-x)); }
__device__ __forceinline__ void rope_cs(float pos, float invr, float& c, float& s_) { const float xr = __builtin_amdgcn_fractf(pos * invr); c = __builtin_amdgcn_cosf(xr); s_ = __builtin_amdgcn_sinf(xr); }
__device__ __forceinline__ float rope_invr(int i, float half_inv) { return exp2f(-(float)i * (13.287712379549449f * half_inv)) * 0.15915494309189535f; }
__device__ __forceinline__ float dpp_ror1(float x)  { return __builtin_bit_cast(float, __builtin_amdgcn_update_dpp(0, __builtin_bit_cast(int, x), 0x121, 0xf, 0xf, false)); }
__device__ __forceinline__ float dpp_ror15(float x) { return __builtin_bit_cast(float, __builtin_amdgcn_update_dpp(0, __builtin_bit_cast(int, x), 0x12f, 0xf, 0xf, false)); }
__device__ __forceinline__ float wave_sum(float v) {
#pragma unroll
    for (int o = 1; o < 64; o <<= 1) v += __shfl_xor(v, o);
    return v;
}
__device__ __forceinline__ float wave_max(float v) {
#pragma unroll
    for (int o = 1; o < 64; o <<= 1) v = fmaxf(v, __shfl_xor(v, o));
    return v;
}

#ifndef PG8_SP2
#define PG8_SP2 1
#endif
namespace pg8 {
constexpr int BM = 256, BK = 64, HALF = 128, HTB = HALF * BK * 2, STAGE_BYTES = 8 * HTB, NXCD = 8, WGM = 8;
__host__ __device__ __forceinline__ int lds_byte(int r, int c) { const int st = (r >> 4) * 2 + (c >> 5), rr = r & 15, cc = c & 31, ob = rr * 64 + cc * 2; return st * 1024 + (ob ^ (((ob >> 9) & 1) << 5)); }
__host__ __device__ __forceinline__ void stage_rc(int b, int& R, int& C) { const int st = b / 1024, sb = b % 1024, swz = sb ^ (((sb >> 9) & 1) << 5); R = (st >> 1) * 16 + swz / 64; C = (st & 1) * 32 + (swz % 64) / 2; }
__host__ __device__ __forceinline__ int perm32(int rho) { const int n = rho >> 4, i = rho & 15; return 8 * (i >> 2) + 4 * n + (i & 3); }

struct Unit { int pm, pn, z; };
struct Gemm { const bf16_t* A; const bf16_t* Bt; int lda, ldb, K, nh; long sAb, sAh, sBb, sBh; };

struct Order {
    int nM, nN, per, ntot, G, c;
    __device__ __forceinline__ void init(int nM_, int nN_, int nZ_, int G_, int c_) { nM = nM_; nN = nN_; per = nM_ * nN_; ntot = per * nZ_; G = G_; c = c_; }
    __device__ __forceinline__ bool next(int i, Unit& u) const {
        const long L = (long)i * G + c; if (L >= ntot) return false;
        int id = (int)L; { const int q = ntot / NXCD, r = ntot % NXCD, xcd = id % NXCD, off = id / NXCD; id = (xcd < r ? xcd * (q + 1) : r * (q + 1) + (xcd - r) * q) + off; }
        u.z = id / per; const int w = id % per;
        const int nig = WGM * nN, gid = w / nig, fm = gid * WGM, gsz = (nM - fm) < WGM ? (nM - fm) : WGM;
        u.pm = fm + ((w % nig) % gsz); u.pn = (w % nig) / gsz; return true;
    }
};

typedef f32x4 Acc[2][2][4][2];

template <class Epi>
__device__ __forceinline__ void gemm_phase(LAS unsigned char* lds, const Gemm g, const Order& S, const Epi& E, const int wid) {
    const int wr = wid >> 2, wc = wid & 3;
    const int K = g.K, nt = K / BK;
    const size_t kstep = (size_t)(BK * 2);
    const size_t hA = (size_t)HALF * g.lda * 2, hB = (size_t)HALF * g.ldb * 2;
    const unsigned ldsw = (unsigned)wid * 1024u;
    unsigned voffA[2], voffB[2]; int aoff, boff;
#define PG8_LANESETUP() do { const int lane_ = lane_id(), tid_ = wid * 64 + lane_; \
        _Pragma("unroll") for (int i = 0; i < 2; ++i) { int R, C; stage_rc(tid_ * 16 + i * 8192, R, C); const int Rb = Epi::PERM ? ((R & ~31) + perm32(R & 31)) : R; \
            voffA[i] = (unsigned)(R * g.lda + C) * 2u; voffB[i] = (unsigned)(Rb * g.ldb + C) * 2u; } \
        aoff = lds_byte(wr * 64 + (lane_ & 15), (lane_ >> 4) * 8); boff = lds_byte(wc * 32 + (lane_ & 15), (lane_ >> 4) * 8); } while (0)
    PG8_LANESETUP();
#define PG8_SA(b, h) (((b) * 2 + (h)) * HTB)
#define PG8_SB(b, h) ((4 + (b) * 2 + (h)) * HTB)
#define PG8_STAGE(bufoff, gbase, voff) do { _Pragma("unroll") for (int _i = 0; _i < 2; ++_i) \
        __builtin_amdgcn_global_load_lds((const unsigned*)((const char*)(gbase) + (voff)[_i]), (LAS unsigned*)(lds + (bufoff) + ldsw + _i * 8192), 16, 0, 0); } while (0)
#define PG8_LDA(dst, b, h) do { _Pragma("unroll") for (int m = 0; m < 4; ++m) _Pragma("unroll") for (int k = 0; k < 2; ++k) dst[m][k] = *(const LAS bf16x8*)(lds + PG8_SA(b, h) + aoff + m * 2048 + k * 1024); } while (0)
#define PG8_LDB(dst, b, h) do { _Pragma("unroll") for (int n = 0; n < 2; ++n) _Pragma("unroll") for (int k = 0; k < 2; ++k) dst[n][k] = *(const LAS bf16x8*)(lds + PG8_SB(b, h) + boff + n * 2048 + k * 1024); } while (0)
#define PG8_MMA(ai, bj, At, Bt) do { __builtin_amdgcn_s_setprio(1); _Pragma("unroll") for (int m = 0; m < 4; ++m) _Pragma("unroll") for (int n = 0; n < 2; ++n) _Pragma("unroll") for (int k = 0; k < 2; ++k) \
        acc[ai][bj][m][n] = __builtin_amdgcn_mfma_f32_16x16x32_bf16(Bt[n][k], At[m][k], acc[ai][bj][m][n], 0, 0, 0); __builtin_amdgcn_s_setprio(0); } while (0)
#define PG8_WAIT_V(n) asm volatile("s_waitcnt vmcnt(" #n ")" ::: "memory")
#define PG8_WAIT_L(n) asm volatile("s_waitcnt lgkmcnt(" #n ")" ::: "memory")
#define PG8_BAR __builtin_amdgcn_s_barrier()
#define PG8_SCHED __builtin_amdgcn_sched_barrier(0)
    Unit cur, nxt; int ui = 0;
    if (!S.next(0, cur)) return;
    Acc acc;
#pragma unroll
    for (int a = 0; a < 2; ++a)
#pragma unroll
        for (int b = 0; b < 2; ++b)
#pragma unroll
            for (int m = 0; m < 4; ++m)
#pragma unroll
                for (int n = 0; n < 2; ++n) acc[a][b][m][n] = (f32x4){0.f, 0.f, 0.f, 0.f};
    bf16x8 At[4][2], B0[2][2], B1[2][2];
#define PG8_APTR(u) ((const char*)g.A + ((size_t)((u).z / g.nh) * g.sAb + (size_t)((u).z % g.nh) * g.sAh + (size_t)(u).pm * BM * g.lda) * 2)
#define PG8_BPTR(u) ((const char*)g.Bt + ((size_t)((u).z / g.nh) * g.sBb + (size_t)((u).z % g.nh) * g.sBh + (size_t)(u).pn * BM * g.ldb) * 2)
    const char* cA = PG8_APTR(cur); const char* cB = PG8_BPTR(cur);
#if PG8_SP2
    PG8_STAGE(PG8_SB(0, 0), cB, voffB); PG8_STAGE(PG8_SB(0, 1), cB + hB, voffB); PG8_STAGE(PG8_SA(0, 0), cA, voffA); PG8_STAGE(PG8_SA(0, 1), cA + hA, voffA);
    if (wr == 1) PG8_BAR;
    PG8_WAIT_V(2); PG8_BAR;
    PG8_STAGE(PG8_SB(1, 0), cB + kstep, voffB); PG8_STAGE(PG8_SA(1, 0), cA + kstep, voffA); PG8_STAGE(PG8_SB(1, 1), cB + hB + kstep, voffB);
    PG8_WAIT_V(6); PG8_BAR;
#else
    PG8_STAGE(PG8_SB(0, 0), cB, voffB); PG8_STAGE(PG8_SA(0, 0), cA, voffA); PG8_STAGE(PG8_SB(0, 1), cB + hB, voffB); PG8_STAGE(PG8_SA(0, 1), cA + hA, voffA);
    if (wr == 1) PG8_BAR;
    PG8_WAIT_V(4); PG8_BAR;
    PG8_STAGE(PG8_SB(1, 0), cB + kstep, voffB); PG8_STAGE(PG8_SA(1, 0), cA + kstep, voffA); PG8_STAGE(PG8_SB(1, 1), cB + hB + kstep, voffB);
    PG8_WAIT_V(6); PG8_BAR;
#endif
    for (;;) {
        const bool has_next = S.next(ui + 1, nxt);
        const char* nA = has_next ? PG8_APTR(nxt) : cA; const char* nB = has_next ? PG8_BPTR(nxt) : cB;
        for (int t = 0; t < nt; t += 2) {
            const bool last = (t == nt - 2);
            const char* a1 = cA + (size_t)(t + 1) * kstep;
            const char* a2 = last ? nA : cA + (size_t)(t + 2) * kstep; const char* b2 = last ? nB : cB + (size_t)(t + 2) * kstep;
            const char* a3 = a2 + kstep; const char* b3 = b2 + kstep;
#if PG8_SP2
            PG8_LDB(B0, 0, 0); PG8_LDB(B1, 0, 1); PG8_SCHED; PG8_LDA(At, 0, 0); PG8_STAGE(PG8_SA(1, 1), a1 + hA, voffA);
            PG8_WAIT_V(8); PG8_WAIT_L(0); PG8_BAR; PG8_MMA(0, 0, At, B0); PG8_MMA(0, 1, At, B1); PG8_BAR; PG8_SCHED;
            PG8_LDA(At, 0, 1); PG8_STAGE(PG8_SB(0, 0), b2, voffB); PG8_STAGE(PG8_SB(0, 1), b2 + hB, voffB); PG8_STAGE(PG8_SA(0, 0), a2, voffA);
            PG8_WAIT_V(8); PG8_WAIT_L(0); PG8_BAR; PG8_MMA(1, 0, At, B0); PG8_MMA(1, 1, At, B1); PG8_BAR; PG8_SCHED;
            PG8_LDB(B0, 1, 0); PG8_LDB(B1, 1, 1); PG8_SCHED; PG8_LDA(At, 1, 0); PG8_STAGE(PG8_SA(0, 1), a2 + hA, voffA);
            PG8_WAIT_V(8); PG8_WAIT_L(0); PG8_BAR; PG8_MMA(0, 0, At, B0); PG8_MMA(0, 1, At, B1); PG8_BAR; PG8_SCHED;
            PG8_LDA(At, 1, 1); PG8_STAGE(PG8_SB(1, 0), b3, voffB); PG8_STAGE(PG8_SB(1, 1), b3 + hB, voffB); PG8_STAGE(PG8_SA(1, 0), a3, voffA);
            PG8_WAIT_V(8); PG8_WAIT_L(0); PG8_BAR; PG8_MMA(1, 0, At, B0); PG8_MMA(1, 1, At, B1); PG8_BAR; PG8_SCHED;
#else
            PG8_LDB(B0, 0, 0); PG8_SCHED; PG8_LDA(At, 0, 0); PG8_STAGE(PG8_SA(1, 1), a1 + hA, voffA);
            PG8_WAIT_L(8); PG8_BAR; PG8_WAIT_L(0); PG8_MMA(0, 0, At, B0); PG8_BAR; PG8_SCHED;
            PG8_LDB(B1, 0, 1); PG8_STAGE(PG8_SB(0, 0), b2, voffB);
            PG8_BAR; PG8_WAIT_L(0); PG8_MMA(0, 1, At, B1); PG8_BAR;
            PG8_LDA(At, 0, 1); PG8_STAGE(PG8_SA(0, 0), a2, voffA);
            PG8_BAR; PG8_WAIT_L(0); PG8_MMA(1, 0, At, B0); PG8_BAR; PG8_SCHED;
            PG8_STAGE(PG8_SB(0, 1), b2 + hB, voffB);
            PG8_WAIT_V(6); PG8_BAR; PG8_MMA(1, 1, At, B1); PG8_BAR;
            PG8_LDB(B0, 1, 0); PG8_SCHED; PG8_LDA(At, 1, 0); PG8_STAGE(PG8_SA(0, 1), a2 + hA, voffA);
            PG8_WAIT_L(8); PG8_BAR; PG8_WAIT_L(0); PG8_MMA(0, 0, At, B0); PG8_BAR; PG8_SCHED;
            PG8_LDB(B1, 1, 1); PG8_STAGE(PG8_SB(1, 0), b3, voffB);
            PG8_BAR; PG8_WAIT_L(0); PG8_MMA(0, 1, At, B1); PG8_BAR;
            PG8_LDA(At, 1, 1); PG8_STAGE(PG8_SA(1, 0), a3, voffA);
            PG8_BAR; PG8_WAIT_L(0); PG8_MMA(1, 0, At, B0); PG8_BAR; PG8_SCHED;
            PG8_STAGE(PG8_SB(1, 1), b3 + hB, voffB);
            PG8_WAIT_V(6); PG8_BAR; PG8_MMA(1, 1, At, B1); PG8_BAR;
#endif
        }
        if (wr == 0) PG8_BAR;
        { const int le_ = lane_id(); E(acc, cur, wr, wc, le_ & 15, le_ >> 4); }
        if (!has_next) break;
#pragma unroll
        for (int a = 0; a < 2; ++a)
#pragma unroll
            for (int b = 0; b < 2; ++b)
#pragma unroll
                for (int m = 0; m < 4; ++m)
#pragma unroll
                    for (int n = 0; n < 2; ++n) acc[a][b][m][n] = (f32x4){0.f, 0.f, 0.f, 0.f};
        cur = nxt; cA = nA; cB = nB; ++ui;
        PG8_LANESETUP();
        if (wr == 1) PG8_BAR;
    }
    PG8_WAIT_V(0);
    PG8_BAR;
#undef PG8_LANESETUP
#undef PG8_APTR
#undef PG8_BPTR
#undef PG8_SA
#undef PG8_SB
#undef PG8_STAGE
#undef PG8_LDA
#undef PG8_LDB
#undef PG8_MMA
#undef PG8_WAIT_V
#undef PG8_WAIT_L
#undef PG8_BAR
#undef PG8_SCHED
}

__device__ __forceinline__ u32x4 pack8(const f32x4 v0, const f32x4 v1) { u32x4 w; w.x = cvt_pk_bf16(v0[0], v0[1]); w.y = cvt_pk_bf16(v0[2], v0[3]); w.z = cvt_pk_bf16(v1[0], v1[1]); w.w = cvt_pk_bf16(v1[2], v1[3]); return w; }

struct EpiBf16 {
    static constexpr bool PERM = true;
    bf16_t* O; int ldc; float scale; int nh; long sb, sh; const float* rss; float rinv;
    __device__ __forceinline__ void operator()(const Acc& acc, const Unit& u, int wr, int wc, int fr, int fq) const {
        bf16_t* base = O + (size_t)(u.z / nh) * sb + (size_t)(u.z % nh) * sh;
        const int row0 = u.pm * BM + wr * 64 + fr, col0 = u.pn * BM + wc * 32 + 8 * fq;
#pragma unroll
        for (int ai = 0; ai < 2; ++ai)
#pragma unroll
            for (int m = 0; m < 4; ++m) { const int row = row0 + ai * HALF + m * 16; float sc = scale; if (rss) sc *= rsqrtf(rss[row] * rinv + RMS_EPS);
                bf16_t* rowp = base + (size_t)row * ldc + col0;
#pragma unroll
                for (int bj = 0; bj < 2; ++bj) *(u32x4*)(rowp + bj * HALF) = pack8(acc[ai][bj][m][0] * sc, acc[ai][bj][m][1] * sc); }
    }
};
template <size_t O_OFF, int ldc, size_t RS_OFF, size_t SV_OFF, size_t CV_OFF> struct EpiBf16LN {
    static constexpr bool PERM = true;
    unsigned char* wsb; float scale;
    __device__ __forceinline__ void operator()(const Acc& acc, const Unit& u, int wr, int wc, int fr, int fq) const {
        bf16_t* O = (bf16_t*)(wsb + O_OFF); const float* rs = (const float*)(wsb + RS_OFF); const float* sv = (const float*)(wsb + SV_OFF); const float* cv = (const float*)(wsb + CV_OFF);
        const int row0 = u.pm * BM + wr * 64 + fr, col0 = u.pn * BM + wc * 32 + 8 * fq;
        f32x2 st[2][4]; f32x4 s4[2][2], c4[2][2];
#pragma unroll
        for (int ai = 0; ai < 2; ++ai)
#pragma unroll
            for (int m = 0; m < 4; ++m) st[ai][m] = *(const f32x2*)(rs + (size_t)(row0 + ai * HALF + m * 16) * 2);
#pragma unroll
        for (int bj = 0; bj < 2; ++bj)
#pragma unroll
            for (int n = 0; n < 2; ++n) { s4[bj][n] = *(const f32x4*)(sv + col0 + bj * HALF + 4 * n); c4[bj][n] = *(const f32x4*)(cv + col0 + bj * HALF + 4 * n); }
        asm volatile("" ::: "memory");
#pragma unroll
        for (int ai = 0; ai < 2; ++ai)
#pragma unroll
            for (int m = 0; m < 4; ++m) { const int row = row0 + ai * HALF + m * 16; const float mean = st[ai][m].x * (1.0f / D), rstd = rsqrtf(st[ai][m].y * (1.0f / D) - mean * mean + LN_EPS) * scale;
                bf16_t* rowp = O + (size_t)row * ldc + col0;
#pragma unroll
                for (int bj = 0; bj < 2; ++bj) *(u32x4*)(rowp + bj * HALF) = pack8((acc[ai][bj][m][0] - s4[bj][0] * mean) * rstd + c4[bj][0] * scale, (acc[ai][bj][m][1] - s4[bj][1] * mean) * rstd + c4[bj][1] * scale); }
    }
};
struct EpiF32 {
    static constexpr bool PERM = false;
    float* C; int ldc; int nh; long sb, sh;
    __device__ __forceinline__ void operator()(const Acc& acc, const Unit& u, int wr, int wc, int fr, int fq) const {
        float* base = C + (size_t)(u.z / nh) * sb + (size_t)(u.z % nh) * sh;
        const int row0 = u.pm * BM + wr * 64 + fr, col0 = u.pn * BM + wc * 32 + 4 * fq;
#pragma unroll
        for (int ai = 0; ai < 2; ++ai)
#pragma unroll
            for (int m = 0; m < 4; ++m) { float* rowp = base + (size_t)(row0 + ai * HALF + m * 16) * ldc + col0;
#pragma unroll
                for (int bj = 0; bj < 2; ++bj)
#pragma unroll
                    for (int n = 0; n < 2; ++n) *(f32x4*)(rowp + bj * HALF + n * 16) = acc[ai][bj][m][n]; }
    }
};
__device__ __forceinline__ void row_stat_add(float* rs, int row, float s_, float q_, int fq) {
    s_ += __shfl_xor(s_, 16); s_ += __shfl_xor(s_, 32); q_ += __shfl_xor(q_, 16); q_ += __shfl_xor(q_, 32);
    if (fq < 2) atomicAdd(rs + (size_t)row * 2 + fq, fq == 0 ? s_ : q_);
}
template <size_t ZB_OFF, size_t RS_OFF> struct EpiResStat {
    static constexpr bool PERM = true;
    unsigned char* wsb; const float* base;
    __device__ __forceinline__ void operator()(const Acc& acc, const Unit& u, int wr, int wc, int fr, int fq) const {
        bf16_t* ZB = (bf16_t*)(wsb + ZB_OFF); float* rs = (float*)(wsb + RS_OFF);
        const int row0 = u.pm * BM + wr * 64 + fr, col0 = u.pn * BM + wc * 32 + 8 * fq;
#pragma unroll
        for (int ah = 0; ah < 4; ++ah) { const int ai = ah >> 1, mh = ah & 1; f32x4 bs[2][2][2];
#pragma unroll
            for (int ml = 0; ml < 2; ++ml)
#pragma unroll
                for (int bj = 0; bj < 2; ++bj)
#pragma unroll
                    for (int n = 0; n < 2; ++n) bs[ml][bj][n] = __builtin_nontemporal_load((const f32x4*)(base + (size_t)(row0 + ai * HALF + (2 * mh + ml) * 16) * D + col0 + bj * HALF + 4 * n));
            asm volatile("" ::: "memory");
#pragma unroll
            for (int ml = 0; ml < 2; ++ml) { const int m = 2 * mh + ml, row = row0 + ai * HALF + m * 16; const size_t off = (size_t)row * D + col0; float s_ = 0.f, q_ = 0.f;
#pragma unroll
                for (int bj = 0; bj < 2; ++bj) { f32x4 z[2];
#pragma unroll
                    for (int n = 0; n < 2; ++n) { z[n] = bs[ml][bj][n] * ALPHA + acc[ai][bj][m][n];
                        s_ += (z[n][0] + z[n][1]) + (z[n][2] + z[n][3]); q_ += (z[n][0] * z[n][0] + z[n][1] * z[n][1]) + (z[n][2] * z[n][2] + z[n][3] * z[n][3]); }
                    *(u32x4*)(ZB + off + bj * HALF) = pack8(z[0], z[1]); }
                row_stat_add(rs, row, s_, q_, fq); }
            asm volatile("" ::: "memory"); }
    }
};
template <size_t ZB_OFF, size_t RSIN_OFF, size_t RSOUT_OFF, bool STATS, int ZR = 0> struct EpiResLN {
    static constexpr bool PERM = true;
    unsigned char* wsb; const float* g; const float* b;
    __device__ __forceinline__ void operator()(const Acc& acc, const Unit& u, int wr, int wc, int fr, int fq) const {
        bf16_t* ZB = (bf16_t*)(wsb + ZB_OFF); const float* rsin = (const float*)(wsb + RSIN_OFF); float* rsout = (float*)(wsb + RSOUT_OFF);
        const int row0 = u.z * ZR + u.pm * BM + wr * 64 + fr, col0 = u.pn * BM + wc * 32 + 8 * fq;
        f32x4 g4[2][2], b4[2][2];
#pragma unroll
        for (int bj = 0; bj < 2; ++bj)
#pragma unroll
            for (int n = 0; n < 2; ++n) { g4[bj][n] = *(const f32x4*)(g + col0 + bj * HALF + 4 * n); b4[bj][n] = *(const f32x4*)(b + col0 + bj * HALF + 4 * n); }
#pragma unroll
        for (int ah = 0; ah < 4; ++ah) { const int ai = ah >> 1, mh = ah & 1; u32x4 zw[2][2]; f32x2 st[2];
#pragma unroll
            for (int ml = 0; ml < 2; ++ml) { const size_t row = (size_t)(row0 + ai * HALF + (2 * mh + ml) * 16); st[ml] = *(const f32x2*)(rsin + row * 2);
#pragma unroll
                for (int bj = 0; bj < 2; ++bj) zw[ml][bj] = *(const u32x4*)(ZB + row * D + col0 + bj * HALF); }
            asm volatile("" ::: "memory");
#pragma unroll
            for (int ml = 0; ml < 2; ++ml) { const int m = 2 * mh + ml, row = row0 + ai * HALF + m * 16; const size_t off = (size_t)row * D + col0; float s_ = 0.f, q_ = 0.f;
                const float mean = st[ml].x * (1.0f / D), rstd = rsqrtf(st[ml].y * (1.0f / D) - mean * mean + LN_EPS);
#pragma unroll
                for (int bj = 0; bj < 2; ++bj) { const u32x4 w_ = zw[ml][bj]; f32x4 z[2];
                    const f32x4 zo0 = {bf_lo(w_.x), bf_hi(w_.x), bf_lo(w_.y), bf_hi(w_.y)}, zo1 = {bf_lo(w_.z), bf_hi(w_.z), bf_lo(w_.w), bf_hi(w_.w)};
                    z[0] = ((zo0 - mean) * rstd * g4[bj][0] + b4[bj][0]) * ALPHA + acc[ai][bj][m][0]; z[1] = ((zo1 - mean) * rstd * g4[bj][1] + b4[bj][1]) * ALPHA + acc[ai][bj][m][1];
#pragma unroll
                    for (int n = 0; n < 2; ++n) { s_ += (z[n][0] + z[n][1]) + (z[n][2] + z[n][3]); q_ += (z[n][0] * z[n][0] + z[n][1] * z[n][1]) + (z[n][2] * z[n][2] + z[n][3] * z[n][3]); }
                    *(u32x4*)(ZB + off + bj * HALF) = pack8(z[0], z[1]); }
                if (STATS) row_stat_add(rsout, row, s_, q_, fq); }
            asm volatile("" ::: "memory"); }
    }
};
struct EpiGate0 {
    static constexpr bool PERM = true;
    bf16_t* C; const bf16_t* G;
    __device__ __forceinline__ void operator()(const Acc& acc, const Unit& u, int wr, int wc, int fr, int fq) const {
        const int row0 = u.pm * BM + wr * 64 + fr, col0 = u.pn * BM + wc * 32 + 8 * fq;
#pragma unroll
        for (int ai = 0; ai < 2; ++ai) { u32x4 gw[4][2];
#pragma unroll
            for (int m = 0; m < 4; ++m)
#pragma unroll
                for (int bj = 0; bj < 2; ++bj) gw[m][bj] = *(const u32x4*)(G + (size_t)(row0 + ai * HALF + m * 16) * GTP + col0 + bj * HALF);
            asm volatile("" ::: "memory");
#pragma unroll
            for (int m = 0; m < 4; ++m) { const int row = row0 + ai * HALF + m * 16;
#pragma unroll
                for (int bj = 0; bj < 2; ++bj) { const int col = col0 + bj * HALF; const u32x4 g = gw[m][bj];
                    const f32x4 g0 = {bf_lo(g.x), bf_hi(g.x), bf_lo(g.y), bf_hi(g.y)}, g1 = {bf_lo(g.z), bf_hi(g.z), bf_lo(g.w), bf_hi(g.w)};
                    *(u32x4*)(C + (size_t)row * D + col) = pack8(g0 * acc[ai][bj][m][0], g1 * acc[ai][bj][m][1]); } }
            asm volatile("" ::: "memory"); }
    }
};
struct EpiGate1 {
    static constexpr bool PERM = true;
    bf16_t* O; const bf16_t* TMP; const bf16_t* G;
    __device__ __forceinline__ void operator()(const Acc& acc, const Unit& u, int wr, int wc, int fr, int fq) const {
        const int row0 = u.pm * BM + wr * 64 + fr, col0 = u.pn * BM + wc * 32 + 8 * fq;
#pragma unroll
        for (int ah = 0; ah < 4; ++ah) { const int ai = ah >> 1, mh = ah & 1; u32x4 g0w[2][2], g1w[2][2], tw[2][2];
#pragma unroll
            for (int ml = 0; ml < 2; ++ml)
#pragma unroll
                for (int bj = 0; bj < 2; ++bj) { const size_t row = (size_t)(row0 + ai * HALF + (2 * mh + ml) * 16);
                    g0w[ml][bj] = __builtin_nontemporal_load((const u32x4*)(G + row * GTP + col0 + bj * HALF)); g1w[ml][bj] = __builtin_nontemporal_load((const u32x4*)(G + row * GTP + 4096 + col0 + bj * HALF)); tw[ml][bj] = __builtin_nontemporal_load((const u32x4*)(TMP + row * D + col0 + bj * HALF)); }
            asm volatile("" ::: "memory");
#pragma unroll
            for (int ml = 0; ml < 2; ++ml) { const int m = 2 * mh + ml, row = row0 + ai * HALF + m * 16;
#pragma unroll
                for (int bj = 0; bj < 2; ++bj) { const int col = col0 + bj * HALF; const u32x4 ga = g0w[ml][bj], gb = g1w[ml][bj], t = tw[ml][bj];
                    const f32x4 a0 = {bf_lo(ga.x), bf_hi(ga.x), bf_lo(ga.y), bf_hi(ga.y)}, a1 = {bf_lo(ga.z), bf_hi(ga.z), bf_lo(ga.w), bf_hi(ga.w)};
                    const f32x4 b0 = {bf_lo(gb.x), bf_hi(gb.x), bf_lo(gb.y), bf_hi(gb.y)}, b1 = {bf_lo(gb.z), bf_hi(gb.z), bf_lo(gb.w), bf_hi(gb.w)};
                    const f32x4 t0 = {bf_lo(t.x), bf_hi(t.x), bf_lo(t.y), bf_hi(t.y)}, t1 = {bf_lo(t.z), bf_hi(t.z), bf_lo(t.w), bf_hi(t.w)};
                    *(u32x4*)(O + (size_t)row * D + col) = pack8(a0 * t0 + b0 * acc[ai][bj][m][0], a1 * t1 + b1 * acc[ai][bj][m][1]); } }
            asm volatile("" ::: "memory"); }
    }
};
__device__ __forceinline__ unsigned dpp_ror1u(unsigned x)  { return (unsigned)__builtin_amdgcn_update_dpp(0, (int)x, 0x121, 0xf, 0xf, false); }
__device__ __forceinline__ unsigned dpp_ror15u(unsigned x) { return (unsigned)__builtin_amdgcn_update_dpp(0, (int)x, 0x12f, 0xf, 0xf, false); }
template <size_t ACT_OFF, size_t EDGE_OFF, size_t RS_OFF, size_t SV_OFF, size_t CV_OFF, size_t CW_OFF, size_t CB_OFF> struct EpiFfnConv {
    static constexpr bool PERM = true;
    unsigned char* wsb; LAS unsigned* H;
    __device__ __forceinline__ void operator()(const Acc& acc, const Unit& u, int wr, int wc, int fr, int fq) const {
        bf16_t* ACT = (bf16_t*)(wsb + ACT_OFF); unsigned* EDGE = (unsigned*)(wsb + EDGE_OFF);
        const float* rs = (const float*)(wsb + RS_OFF); const float* sv = (const float*)(wsb + SV_OFF); const float* cv = (const float*)(wsb + CV_OFF);
        const float* cw = (const float*)(wsb + CW_OFF); const float* cb = (const float*)(wsb + CB_OFF);
        int frl = fr, colt = wc * 32 + 8 * fq; asm volatile("" : "+v"(frl), "+v"(colt));
        const int row0 = u.pm * BM + wr * 64 + frl;
        u32x2 P[2][2][4][2];
#pragma unroll
        for (int ai = 0; ai < 2; ++ai) { float mean[4], rstd[4];
#pragma unroll
            for (int m = 0; m < 4; ++m) { const f32x2 st = *(const f32x2*)(rs + (size_t)(row0 + ai * HALF + m * 16) * 2); mean[m] = st.x * (1.0f / D); rstd[m] = rsqrtf(st.y * (1.0f / D) - mean[m] * mean[m] + LN_EPS); }
#pragma unroll
            for (int bj = 0; bj < 2; ++bj) { f32x4 s4[2], c4[2];
#pragma unroll
                for (int n = 0; n < 2; ++n) { s4[n] = *(const f32x4*)(sv + u.pn * BM + bj * HALF + colt + 4 * n); c4[n] = *(const f32x4*)(cv + u.pn * BM + bj * HALF + colt + 4 * n); }
#pragma unroll
                for (int m = 0; m < 4; ++m)
#pragma unroll
                    for (int n = 0; n < 2; ++n) { const f32x4 v = (acc[ai][bj][m][n] - s4[n] * mean[m]) * rstd[m] + c4[n]; P[ai][bj][m][n].x = cvt_pk_bf16(v[0], v[1]); P[ai][bj][m][n].y = cvt_pk_bf16(v[2], v[3]); }
                __builtin_amdgcn_sched_barrier(0); } }
        if (frl == 0 || frl == 15) { const int tb = frl == 15 ? 1 : 0;
#pragma unroll
            for (int ai = 0; ai < 2; ++ai)
#pragma unroll
                for (int bj = 0; bj < 2; ++bj)
#pragma unroll
                    for (int n = 0; n < 2; ++n) { const int hp = (bj * HALF + colt + 4 * n) >> 1, blk = 2 * ai + wr; const unsigned mk = 0u - (unsigned)tb; u32x2 v; v.x = (P[ai][bj][0][n].x & ~mk) | (P[ai][bj][3][n].x & mk); v.y = (P[ai][bj][0][n].y & ~mk) | (P[ai][bj][3][n].y & mk);
                        *(LAS u32x2*)(H + (blk * 2 + tb) * 128 + hp) = v; } }
        if (wr == 0 ? frl < 2 : frl >= 14) { const int e = wr == 0 ? frl : frl - 12;
#pragma unroll
            for (int bj = 0; bj < 2; ++bj)
#pragma unroll
                for (int n = 0; n < 2; ++n) { const int hp = (bj * HALF + colt + 4 * n) >> 1; const unsigned mk = wr == 0 ? 0u : ~0u; u32x2 v; v.x = (P[0][bj][0][n].x & ~mk) | (P[1][bj][3][n].x & mk); v.y = (P[0][bj][0][n].y & ~mk) | (P[1][bj][3][n].y & mk);
                    *(u32x2*)(EDGE + (size_t)(u.pm * 4 + e) * (DFF2 / 2) + u.pn * (BM / 2) + hp) = v; } }
        asm volatile("s_waitcnt lgkmcnt(0)" ::: "memory"); __builtin_amdgcn_s_barrier(); asm volatile("" ::: "memory");
#pragma unroll
        for (int n = 0; n < 2; ++n) {
            f32x4 W[2][4];
#pragma unroll
            for (int bj = 0; bj < 2; ++bj) { const int c_ = bj * DFF + u.pn * 128 + colt + 4 * n;
                W[bj][0] = *(const f32x4*)(cw + c_); W[bj][1] = *(const f32x4*)(cw + DFF2 + c_); W[bj][2] = *(const f32x4*)(cw + 2 * (size_t)DFF2 + c_); W[bj][3] = *(const f32x4*)(cb + c_); }
            asm volatile("" ::: "memory");
#pragma unroll
            for (int ai = 0; ai < 2; ++ai) { int frb = frl, colb = colt; asm volatile("" : "+v"(frb), "+v"(colb));
                const int ch = u.pn * 128 + colb + 4 * n, blk = 2 * ai + wr, bup = blk > 0 ? blk - 1 : 0, bdn = blk < 3 ? blk + 1 : 3;
                const bool first = frb == 0, lastl = frb == 15;
                u32x2 ht[2], hb[2];
#pragma unroll
                for (int bj = 0; bj < 2; ++bj) { const int hp = (bj * HALF + colb + 4 * n) >> 1; ht[bj] = *(const LAS u32x2*)(H + (bup * 2 + 1) * 128 + hp); hb[bj] = *(const LAS u32x2*)(H + (bdn * 2 + 0) * 128 + hp); }
                unsigned wlo[4];
#pragma unroll
                for (int jp = 0; jp < 2; ++jp) { float cu0[4], cu1[4];
#pragma unroll
                    for (int bj = 0; bj < 2; ++bj) {
                        const f32x2 w0 = {W[bj][0][2 * jp], W[bj][0][2 * jp + 1]}, w1 = {W[bj][1][2 * jp], W[bj][1][2 * jp + 1]}, w2 = {W[bj][2][2 * jp], W[bj][2][2 * jp + 1]}, bb = {W[bj][3][2 * jp], W[bj][3][2 * jp + 1]};
                        unsigned a[4], b[4];
#pragma unroll
                        for (int m = 0; m < 4; ++m) { a[m] = dpp_ror1u(P[ai][bj][m][n][jp]); b[m] = dpp_ror15u(P[ai][bj][m][n][jp]); }
#pragma unroll
                        for (int m = 0; m < 4; ++m) { const unsigned xc = P[ai][bj][m][n][jp];
                            const unsigned pv = first ? (m > 0 ? a[m > 0 ? m - 1 : 0] : ht[bj][jp]) : a[m];
                            const unsigned nx = lastl ? (m < 3 ? b[m < 3 ? m + 1 : 3] : hb[bj][jp]) : b[m];
                            const float r0 = bf_lo(pv) * w0[0] + bf_lo(xc) * w1[0] + bf_lo(nx) * w2[0] + bb[0];
                            const float r1 = bf_hi(pv) * w0[1] + bf_hi(xc) * w1[1] + bf_hi(nx) * w2[1] + bb[1];
                            if (bj == 0) { cu0[m] = r0; cu1[m] = r1; }
                            else { cu0[m] = siluf_(r0) * cu0[m]; cu1[m] = siluf_(r1) * cu1[m]; } } }
#pragma unroll
                    for (int m = 0; m < 4; ++m) { const unsigned w_ = cvt_pk_bf16(cu0[m], cu1[m]);
                        if (jp == 0) wlo[m] = w_;
                        else { const int rt = ai * HALF + wr * 64 + m * 16 + frb; u32x2 w; w.x = wlo[m]; w.y = w_;
                               *(u32x2*)(ACT + (size_t)(u.pm * BM + rt) * DFF + ch) = w; } } }
                asm volatile("" ::: "memory"); __builtin_amdgcn_sched_barrier(0); } }
    }
};
struct EpiRetS {
    static constexpr bool PERM = true;
    bf16_t* O; const float* dec;
    __device__ __forceinline__ void operator()(const Acc& acc, const Unit& u, int wr, int wc, int fr, int fq) const {
        const int h = u.z & 7; const float lf = dec[h], lb = dec[8 + h];
        bf16_t* base = O + (size_t)u.z * SEQ * SEQ;
        int frl = fr, cwl = wc * 32 + 8 * fq; asm volatile("" : "+v"(frl), "+v"(cwl));
        const int rl0 = wr * 64 + frl, row0 = u.pm * BM + rl0, col0 = u.pn * BM + cwl;
        if (u.pm != u.pn) {
            const bool below = u.pm > u.pn; const float lg = below ? lf : lb;
            const float cb0 = below ? (float)((u.pm - u.pn) * BM) : (float)((u.pn - u.pm) * BM - 255);
            float R[2][4]; f32x4 C[2][2];
#pragma unroll
            for (int ai = 0; ai < 2; ++ai)
#pragma unroll
                for (int m = 0; m < 4; ++m) { const float r_ = (float)(rl0 + ai * HALF + m * 16); R[ai][m] = __builtin_amdgcn_exp2f((below ? r_ : 255.0f - r_) * lg); }
#pragma unroll
            for (int bj = 0; bj < 2; ++bj)
#pragma unroll
                for (int n = 0; n < 2; ++n)
#pragma unroll
                    for (int j = 0; j < 4; ++j) { const float c_ = (float)(cwl + bj * HALF + 4 * n + j); C[bj][n][j] = __builtin_amdgcn_exp2f((below ? cb0 - c_ : cb0 + c_) * lg); }
#pragma unroll
            for (int ai = 0; ai < 2; ++ai)
#pragma unroll
                for (int m = 0; m < 4; ++m) { const int row = row0 + ai * HALF + m * 16;
#pragma unroll
                    for (int bj = 0; bj < 2; ++bj) __builtin_nontemporal_store(pack8(acc[ai][bj][m][0] * C[bj][0] * R[ai][m], acc[ai][bj][m][1] * C[bj][1] * R[ai][m]), (u32x4*)(base + (size_t)row * SEQ + col0 + bj * HALF)); }
        } else {
#pragma unroll
            for (int ai = 0; ai < 2; ++ai)
#pragma unroll
                for (int m = 0; m < 4; ++m) { const int row = row0 + ai * HALF + m * 16;
#pragma unroll
                    for (int bj = 0; bj < 2; ++bj) { const int col = col0 + bj * HALF; f32x4 v[2];
#pragma unroll
                        for (int n = 0; n < 2; ++n)
#pragma unroll
                            for (int j = 0; j < 4; ++j) { const int dd = row - (col + 4 * n + j); const float e = dd >= 0 ? (float)dd * lf : (float)(-dd) * lb; v[n][j] = acc[ai][bj][m][n][j] * __builtin_amdgcn_exp2f(e); }
                        __builtin_nontemporal_store(pack8(v[0], v[1]), (u32x4*)(base + (size_t)row * SEQ + col)); } }
        }
    }
};
struct EpiQ {
    static constexpr bool PERM = true;
    bf16_t* Q; const float* rss; const int* pos;
    __device__ __forceinline__ void operator()(const Acc& acc, const Unit& u, int wr, int wc, int fr, int fq) const {
        const int row0 = u.pm * BM + wr * 64 + fr;
        float rs[2][4]; int ps[2][4];
#pragma unroll
        for (int ai = 0; ai < 2; ++ai)
#pragma unroll
            for (int m = 0; m < 4; ++m) { rs[ai][m] = rss[row0 + ai * HALF + m * 16]; ps[ai][m] = pos[row0 + ai * HALF + m * 16]; }
        asm volatile("" ::: "memory");
        if (u.pn < 8) {
#pragma unroll
            for (int ai = 0; ai < 2; ++ai)
#pragma unroll
                for (int m = 0; m < 4; ++m) { const int row = row0 + ai * HALF + m * 16; const float sc = rsqrtf(rs[ai][m] * (1.0f / 1024.0f) + RMS_EPS); bf16_t* qrow = Q + (size_t)row * 3072;
#pragma unroll
                    for (int bj = 0; bj < 2; ++bj) *(u32x4*)(qrow + (2 * u.pn + bj) * 192 + wc * 32 + 8 * fq) = pack8(acc[ai][bj][m][0] * sc, acc[ai][bj][m][1] * sc); }
        } else {
            const int head = 4 * (u.pn - 8) + wc; float invr[8]; int fql = fq; asm volatile("" : "+v"(fql));
#pragma unroll
            for (int i = 0; i < 8; ++i) invr[i] = rope_invr(8 * fql + i, 1.0f / 32.0f);
#pragma unroll
            for (int ai = 0; ai < 2; ++ai)
#pragma unroll
                for (int m = 0; m < 4; ++m) { const int row = row0 + ai * HALF + m * 16; const float sc = rsqrtf(rs[ai][m] * (1.0f / 1024.0f) + RMS_EPS), pf = (float)ps[ai][m]; bf16_t* qrow = Q + (size_t)row * 3072; f32x4 o1[2], o2[2];
#pragma unroll
                    for (int n = 0; n < 2; ++n)
#pragma unroll
                        for (int j = 0; j < 4; ++j) { float c, sn; rope_cs(pf, invr[4 * n + j], c, sn); const float t1 = acc[ai][0][m][n][j] * sc, t2 = acc[ai][1][m][n][j] * sc; o1[n][j] = t1 * c - t2 * sn; o2[n][j] = t2 * c + t1 * sn; }
                    *(u32x4*)(qrow + head * 192 + 128 + 8 * fq) = pack8(o1[0], o1[1]); *(u32x4*)(qrow + head * 192 + 160 + 8 * fq) = pack8(o2[0], o2[1]); }
        }
    }
};
struct EpiProj {
    static constexpr bool PERM = true;
    bf16_t *CQ, *CKV, *KPE, *RQ, *RK, *RVT, *RG, *GT; float* rss; const int* pos; const float* gbias; LAS unsigned char* lds;
    __device__ __forceinline__ void operator()(const Acc& acc, const Unit& u, int wr, int wc, int fr, int fq) const {
        int fql = fq; asm volatile("" : "+v"(fql));
        const int pn = u.pn, row0 = u.pm * BM + wr * 64 + fr, cw = wc * 32 + 8 * fq, cwl = wc * 32 + 8 * fql;
        if (pn < 6) {
            bf16_t* O = pn < 4 ? CQ : CKV; const int ldc = pn < 4 ? 1024 : 512, colt = pn < 4 ? pn * BM : (pn - 4) * BM; float* ss = rss + (pn < 4 ? 0 : T);
#pragma unroll
            for (int ai = 0; ai < 2; ++ai)
#pragma unroll
                for (int m = 0; m < 4; ++m) { const int row = row0 + ai * HALF + m * 16; float s = 0.f;
#pragma unroll
                    for (int bj = 0; bj < 2; ++bj) { const f32x4 a = acc[ai][bj][m][0], b = acc[ai][bj][m][1];
                        s += (a[0] * a[0] + a[1] * a[1]) + (a[2] * a[2] + a[3] * a[3]) + (b[0] * b[0] + b[1] * b[1]) + (b[2] * b[2] + b[3] * b[3]);
                        *(u32x4*)(O + (size_t)row * ldc + colt + bj * HALF + cw) = pack8(a, b); }
                    s += __shfl_xor(s, 16); s += __shfl_xor(s, 32);
                    if (fq == 0) atomicAdd(ss + row, s); }
        } else if (pn == 6) {
            if (wc == 0) {
                int ps[2][4]; float invr[8];
#pragma unroll
                for (int ai = 0; ai < 2; ++ai)
#pragma unroll
                    for (int m = 0; m < 4; ++m) ps[ai][m] = pos[row0 + ai * HALF + m * 16];
                asm volatile("" ::: "memory");
#pragma unroll
                for (int i = 0; i < 8; ++i) invr[i] = rope_invr(8 * fql + i, 1.0f / 32.0f);
#pragma unroll
                for (int ai = 0; ai < 2; ++ai)
#pragma unroll
                    for (int m = 0; m < 4; ++m) { const int row = row0 + ai * HALF + m * 16; const float pf = (float)ps[ai][m]; f32x4 o1[2], o2[2];
#pragma unroll
                        for (int n = 0; n < 2; ++n)
#pragma unroll
                            for (int j = 0; j < 4; ++j) { float c, sn; rope_cs(pf, invr[4 * n + j], c, sn); const float t1 = acc[ai][0][m][n][j], t2 = acc[ai][1][m][n][j]; o1[n][j] = t1 * c - t2 * sn; o2[n][j] = t2 * c + t1 * sn; }
                        *(u32x4*)(KPE + (size_t)row * 64 + 8 * fq) = pack8(o1[0], o1[1]); *(u32x4*)(KPE + (size_t)row * 64 + 32 + 8 * fq) = pack8(o2[0], o2[1]); }
            }
        } else if (pn < 23) {
            const bool isk = pn >= 15; const int head = isk ? pn - 15 : pn - 7; bf16_t* O = isk ? RK : RQ; const float sc = isk ? 0.0625f : 1.0f;
            int ps[2][4]; float invr[8];
#pragma unroll
            for (int ai = 0; ai < 2; ++ai)
#pragma unroll
                for (int m = 0; m < 4; ++m) ps[ai][m] = pos[row0 + ai * HALF + m * 16];
            asm volatile("" ::: "memory");
#pragma unroll
            for (int i = 0; i < 8; ++i) invr[i] = rope_invr(cwl + i, 1.0f / 128.0f);
#pragma unroll
            for (int ai = 0; ai < 2; ++ai)
#pragma unroll
                for (int m = 0; m < 4; ++m) { const int row = row0 + ai * HALF + m * 16; const float pf = (float)ps[ai][m]; f32x4 o1[2], o2[2];
#pragma unroll
                    for (int n = 0; n < 2; ++n)
#pragma unroll
                        for (int j = 0; j < 4; ++j) { float c, sn; rope_cs(pf, invr[4 * n + j], c, sn); const float t1 = acc[ai][0][m][n][j] * sc, t2 = acc[ai][1][m][n][j] * sc; o1[n][j] = t1 * c - t2 * sn; o2[n][j] = t2 * c + t1 * sn; }
                    bf16_t* op = O + (size_t)row * 2048 + head * 256 + cw;
                    *(u32x4*)op = pack8(o1[0], o1[1]); *(u32x4*)(op + 128) = pack8(o2[0], o2[1]); }
        } else if (pn < 39) {
            const int t = pn - 23, head = t >> 1, e0 = (t & 1) * 256, lane = fq * 16 + fr;
            LAS unsigned char* tb = lds + TR_OFF + (wr * 4 + wc) * 2048;
            const int b = (u.pm * BM) >> 11, s0 = (u.pm * BM) & 2047;
#pragma unroll
            for (int ai = 0; ai < 2; ++ai)
#pragma unroll
                for (int bj = 0; bj < 2; ++bj)
#pragma unroll
                    for (int n = 0; n < 2; ++n) {
#pragma unroll
                        for (int m = 0; m < 4; ++m)
#pragma unroll
                            for (int j = 0; j < 4; ++j) { const unsigned w = cvt_pk_bf16(acc[ai][bj][m][n][j], 0.f); *(LAS bf16_t*)(tb + (4 * fq + j) * 128 + (16 * m + fr) * 2) = (bf16_t)(w & 0xffffu); }
#pragma unroll
                        for (int i = 0; i < 2; ++i) { const int q = lane + 64 * i, lc = q >> 3, rc = q & 7; const u32x4 v = *(const LAS u32x4*)(tb + lc * 128 + rc * 16);
                            const int e = e0 + bj * HALF + wc * 32 + 8 * (lc >> 2) + 4 * n + (lc & 3), sp = s0 + ai * HALF + wr * 64 + rc * 8;
                            __builtin_nontemporal_store(v, (u32x4*)(RVT + ((size_t)(b * 8 + head) * 512 + e) * SEQ + sp)); }
                    }
        } else if (pn < 55) {
            const int colt = (pn - 39) * BM;
#pragma unroll
            for (int ai = 0; ai < 2; ++ai)
#pragma unroll
                for (int m = 0; m < 4; ++m) { const int row = row0 + ai * HALF + m * 16;
#pragma unroll
                    for (int bj = 0; bj < 2; ++bj) { f32x4 v[2];
#pragma unroll
                        for (int n = 0; n < 2; ++n)
#pragma unroll
                            for (int j = 0; j < 4; ++j) v[n][j] = siluf_(acc[ai][bj][m][n][j]);
                        __builtin_nontemporal_store(pack8(v[0], v[1]), (u32x4*)(RG + (size_t)row * RGP + colt + bj * HALF + cw)); } }
        } else {
            const int colt = (pn - 55) * BM;
#pragma unroll
            for (int ai = 0; ai < 2; ++ai)
#pragma unroll
                for (int m = 0; m < 4; ++m) { const int row = row0 + ai * HALF + m * 16;
#pragma unroll
                    for (int bj = 0; bj < 2; ++bj) { const int col = colt + bj * HALF + cw; const f32x4 b0 = *(const f32x4*)(gbias + col), b1 = *(const f32x4*)(gbias + col + 4); f32x4 v[2];
#pragma unroll
                        for (int j = 0; j < 4; ++j) { v[0][j] = sigmoidf_(acc[ai][bj][m][0][j] + b0[j]); v[1][j] = sigmoidf_(acc[ai][bj][m][1][j] + b1[j]); }
                        __builtin_nontemporal_store(pack8(v[0], v[1]), (u32x4*)(GT + (size_t)row * GTP + col)); } }
        }
    }
};
}

namespace att {
constexpr int NW = 8, QBLK = 32, KVBLK = 64;
constexpr float SCALE = 0.07216878364870323f;
constexpr float THR = 8.f;
constexpr int LDQ = 3072, LDKV = 4096, LDKR = 64, LDO = 2048;
constexpr int SHM_V = KVBLK * 128 * 2, SHM_K = KVBLK * 128 * 2, SHM_KR = KVBLK * 64 * 2;
constexpr int OFF_V = 0, OFF_K = 2 * SHM_V, OFF_KR = OFF_K + 2 * SHM_K, OFF_WS = OFF_KR + 2 * SHM_KR, OFF_QR = OFF_WS + NW * 64 * 4, ATT_LDS = OFF_QR + NW * 4096;
#define KSWZ(row, colB) ((row) * 256 + ((colB) ^ (((row) & 7) << 4)))
#define KRSWZ(row, colB) ((row) * 128 + ((colB) ^ ((((row) >> 1) & 7) << 4)))
#define SBAR() __builtin_amdgcn_sched_barrier(0)
typedef LAS char* lptr;
__device__ __forceinline__ int crow(int r, int hi) { return (r & 3) + 8 * (r >> 2) + 4 * hi; }
__device__ __forceinline__ void partialSM(f32x16& p0, f32x16& p1, float& m_reg, float& mn, float& alpha) {
    constexpr float C = SCALE * 1.4426950408889634f;
    float pmax = p0[0];
#pragma unroll
    for (int r = 1; r < 16; ++r) pmax = fmaxf(pmax, p0[r]);
#pragma unroll
    for (int r = 0; r < 16; ++r) pmax = fmaxf(pmax, p1[r]);
    { auto rr = __builtin_amdgcn_permlane32_swap(__float_as_uint(pmax), __float_as_uint(pmax), false, false);
      pmax = fmaxf(__uint_as_float(rr[0]), __uint_as_float(rr[1])); }
    if (__builtin_expect(__all(pmax - m_reg <= THR / SCALE), 1)) { mn = m_reg; alpha = 1.f; }
    else { mn = fmaxf(m_reg, pmax); alpha = __builtin_amdgcn_exp2f((m_reg - mn) * C); m_reg = mn; }
    const float mnC = -mn * C;
#pragma unroll
    for (int r = 0; r < 16; ++r) p0[r] = fmaf(p0[r], C, mnC);
#pragma unroll
    for (int r = 0; r < 16; ++r) p1[r] = fmaf(p1[r], C, mnC);
#pragma unroll
    for (int r = 0; r < 16; ++r) p0[r] = __builtin_amdgcn_exp2f(p0[r]);
}
__device__ __forceinline__ void finishSM(f32x16& p0, f32x16& p1, float alpha, float& l_reg, bf16x8& pa0, bf16x8& pa1, bf16x8& pa2, bf16x8& pa3) {
#pragma unroll
    for (int r = 0; r < 16; ++r) p1[r] = __builtin_amdgcn_exp2f(p1[r]);
    float ps = 0;
#pragma unroll
    for (int r = 0; r < 16; ++r) ps += p0[r];
#pragma unroll
    for (int r = 0; r < 16; ++r) ps += p1[r];
    { auto rr = __builtin_amdgcn_permlane32_swap(__float_as_uint(ps), __float_as_uint(ps), false, false);
      ps = __uint_as_float(rr[0]) + __uint_as_float(rr[1]); }
    l_reg = l_reg * alpha + ps;
#define PK4(P, BASE, OUT) do { unsigned a0 = cvt_pk_bf16(P[BASE + 0], P[BASE + 1]), a1 = cvt_pk_bf16(P[BASE + 2], P[BASE + 3]);   \
    unsigned b0 = cvt_pk_bf16(P[BASE + 4], P[BASE + 5]), b1 = cvt_pk_bf16(P[BASE + 6], P[BASE + 7]);                              \
    auto r0 = __builtin_amdgcn_permlane32_swap(a0, b0, false, false); auto r1 = __builtin_amdgcn_permlane32_swap(a1, b1, false, false); \
    u32x4 w = {r0[0], r1[0], r0[1], r1[1]}; OUT = *reinterpret_cast<bf16x8*>(&w); } while (0)
    PK4(p0, 0, pa0); PK4(p0, 8, pa1); PK4(p1, 0, pa2); PK4(p1, 8, pa3);
#undef PK4
}
__device__ __forceinline__ void qkt(f32x16& p0, f32x16& p1, lptr Ks, lptr Krs, const bf16x8* qr, const LAS bf16x8* qsp, int r32, int hi) {
    p0 = f32x16{}; p1 = f32x16{};
#pragma unroll
    for (int d0 = 0; d0 < 8; ++d0) { const int cb = (d0 * 16 + hi * 8) * 2;
        const bf16x8 b0 = *(const LAS bf16x8*)(Ks + KSWZ(r32, cb));
        const bf16x8 b1 = *(const LAS bf16x8*)(Ks + KSWZ(32 + r32, cb));
        p0 = __builtin_amdgcn_mfma_f32_32x32x16_bf16(b0, qr[d0], p0, 0, 0, 0);
        p1 = __builtin_amdgcn_mfma_f32_32x32x16_bf16(b1, qr[d0], p1, 0, 0, 0); }
#pragma unroll
    for (int d0 = 0; d0 < 4; ++d0) { const int cb = (d0 * 16 + hi * 8) * 2;
        const bf16x8 b0 = *(const LAS bf16x8*)(Krs + KRSWZ(r32, cb));
        const bf16x8 b1 = *(const LAS bf16x8*)(Krs + KRSWZ(32 + r32, cb));
        const bf16x8 q = qsp[d0 * 64];
        p0 = __builtin_amdgcn_mfma_f32_32x32x16_bf16(b0, q, p0, 0, 0, 0);
        p1 = __builtin_amdgcn_mfma_f32_32x32x16_bf16(b1, q, p1, 0, 0, 0); }
}
__device__ __forceinline__ int v_st(int k, int c) { const int kk = (k & ~0xC) | ((k & 4) << 1) | ((k & 8) >> 1); return ((kk >> 3) * 4 + (c >> 5)) * 512 + ((kk & 7) * 32 + (c & 31)) * 2; }
__device__ __forceinline__ int v_rd_base(int lane) { return ((lane & 3) << 3) | (((lane >> 2) & 3) << 6) | (((lane >> 4) & 1) << 5) | (((lane >> 5) & 1) << 8); }
constexpr int v_rd_off(int d0, int ks, int half) { return d0 * 512 + ks * 4096 + half * 2048; }
template <int OFF> __device__ __forceinline__ s16x4 tr_read(int vb) {
    s16x4 r; asm volatile("ds_read_b64_tr_b16 %0, %1 offset:%2" : "=&v"(r) : "v"(vb), "i"(OFF) : "memory"); return r;
}
template <int D0> __device__ __forceinline__ void pv_one(f32x16& od, int vb, bf16x8 pa0, bf16x8 pa1, bf16x8 pa2, bf16x8 pa3) {
    const s16x4 l0 = tr_read<v_rd_off(D0, 0, 0)>(vb), h0 = tr_read<v_rd_off(D0, 0, 1)>(vb), l1 = tr_read<v_rd_off(D0, 1, 0)>(vb), h1 = tr_read<v_rd_off(D0, 1, 1)>(vb);
    const s16x4 l2 = tr_read<v_rd_off(D0, 2, 0)>(vb), h2 = tr_read<v_rd_off(D0, 2, 1)>(vb), l3 = tr_read<v_rd_off(D0, 3, 0)>(vb), h3 = tr_read<v_rd_off(D0, 3, 1)>(vb);
    asm volatile("s_waitcnt lgkmcnt(0)" ::: "memory"); SBAR();
#define PK(L, H) (bf16x8){L[0], L[1], L[2], L[3], H[0], H[1], H[2], H[3]}
    od = __builtin_amdgcn_mfma_f32_32x32x16_bf16(pa0, PK(l0, h0), od, 0, 0, 0);
    od = __builtin_amdgcn_mfma_f32_32x32x16_bf16(pa1, PK(l1, h1), od, 0, 0, 0);
    od = __builtin_amdgcn_mfma_f32_32x32x16_bf16(pa2, PK(l2, h2), od, 0, 0, 0);
    od = __builtin_amdgcn_mfma_f32_32x32x16_bf16(pa3, PK(l3, h3), od, 0, 0, 0);
#undef PK
}
__device__ __forceinline__ void pv_d0(f32x16* o, int vb, bf16x8 pa0, bf16x8 pa1, bf16x8 pa2, bf16x8 pa3) {
    pv_one<0>(o[0], vb, pa0, pa1, pa2, pa3); pv_one<1>(o[1], vb, pa0, pa1, pa2, pa3); pv_one<2>(o[2], vb, pa0, pa1, pa2, pa3); pv_one<3>(o[3], vb, pa0, pa1, pa2, pa3);
}
__device__ __forceinline__ void attn_unit(const bf16_t* __restrict__ Qb, const bf16_t* __restrict__ Kh, const bf16_t* __restrict__ Vh, const bf16_t* __restrict__ Krb,
                                          bf16_t* __restrict__ Ob, int seq, lptr lds, const int wid) {
    const int lane = lane_id(), tid = wid * 64 + lane, r32 = lane & 31, hi = lane >> 5;
    (void)Vh; lptr V_lds = lds + OFF_V; lptr K_lds = lds + OFF_K; lptr KR_lds = lds + OFF_KR;
    LAS float* ws = (LAS float*)(lds + OFF_WS) + wid * 64; LAS float* li_l = ws; LAS float* al_l = ws + 32;
    float m_reg = -1e30f, l_reg = 0; f32x16 o[4] = {}; bf16x8 qr[8];
    LAS bf16x8* qsp = (LAS bf16x8*)(lds + OFF_QR + wid * 4096) + lane;
    { const char* Qw = (const char*)Qb + (size_t)(wid * QBLK) * LDQ * 2; const unsigned qoff = (unsigned)(r32 * LDQ + hi * 8) * 2u;
#pragma unroll
      for (int d0 = 0; d0 < 8; ++d0) qr[d0] = *reinterpret_cast<const bf16x8*>(Qw + qoff + d0 * 32);
#pragma unroll
      for (int d0 = 0; d0 < 4; ++d0) qsp[d0 * 64] = *reinterpret_cast<const bf16x8*>(Qw + qoff + (8 + d0) * 32); }
    const int sr = tid >> 4, sc = (tid & 15) * 8, vst0 = v_st(sr, sc), vst1 = v_st(32 + sr, sc);
    const int kr_r = tid >> 3, kr_c = (tid & 7) * 8, krst = KRSWZ(kr_r, kr_c * 2);
    const int vb0 = (int)(uintptr_t)V_lds + v_rd_base(lane);
    const unsigned kvoff = (unsigned)(sr * LDKV + sc) * 2u, kroff = (unsigned)(kr_r * LDKR + kr_c) * 2u;
    bf16x8 vs0, vs1, ks0, ks1, krs;
#define SLOAD(k0) do { const char* kb_ = (const char*)Kh + (size_t)(k0) * LDKV * 2; const char* rb_ = (const char*)Krb + (size_t)(k0) * LDKR * 2; \
    ks0 = *reinterpret_cast<const bf16x8*>(kb_ + kvoff); vs0 = *reinterpret_cast<const bf16x8*>(kb_ + kvoff + 256); \
    ks1 = *reinterpret_cast<const bf16x8*>(kb_ + (size_t)32 * LDKV * 2 + kvoff); vs1 = *reinterpret_cast<const bf16x8*>(kb_ + (size_t)32 * LDKV * 2 + kvoff + 256); \
    krs = *reinterpret_cast<const bf16x8*>(rb_ + kroff); } while (0)
#define SWRITE(b) do { *(LAS bf16x8*)(V_lds + (b) * SHM_V + vst0) = vs0; *(LAS bf16x8*)(V_lds + (b) * SHM_V + vst1) = vs1; const int kc = sc * 2; \
    *(LAS bf16x8*)(K_lds + (b) * SHM_K + KSWZ(sr, kc)) = ks0; *(LAS bf16x8*)(K_lds + (b) * SHM_K + KSWZ(32 + sr, kc)) = ks1; \
    *(LAS bf16x8*)(KR_lds + (b) * SHM_KR + krst) = krs; } while (0)
#define SWAIT() asm volatile("s_waitcnt vmcnt(0)" ::: "memory")
#define RESC(a) do { if (__any((a) < 1.f)) { if (hi == 0) al_l[r32] = (a); asm volatile("s_waitcnt lgkmcnt(0)" ::: "memory"); \
    _Pragma("unroll") for (int d = 0; d < 4; ++d) _Pragma("unroll") for (int r = 0; r < 16; ++r) o[d][r] *= al_l[crow(r, hi)]; } } while (0)
    f32x16 pA0, pA1, pB0, pB1; float mnA, mnB, alA, alB; bf16x8 pa0, pa1, pa2, pa3; const int NT = seq / KVBLK;
    SLOAD(0); SWAIT(); SWRITE(0); __syncthreads();
    qkt(pA0, pA1, K_lds, KR_lds, qr, qsp, r32, hi); partialSM(pA0, pA1, m_reg, mnA, alA);
    SLOAD(KVBLK);
    SWAIT(); SWRITE(1); __syncthreads();
    for (int j = 1; j + 1 < NT; j += 2) {
        SBAR(); qkt(pB0, pB1, K_lds + SHM_K, KR_lds + SHM_KR, qr, qsp, r32, hi);
        finishSM(pA0, pA1, alA, l_reg, pa0, pa1, pa2, pa3); SBAR();
        SLOAD((j + 1) * KVBLK); SBAR();
        pv_d0(o, vb0, pa0, pa1, pa2, pa3); partialSM(pB0, pB1, m_reg, mnB, alB);
        __syncthreads(); SWAIT(); SWRITE(0);
        RESC(alB); __syncthreads();
        SBAR(); qkt(pA0, pA1, K_lds, KR_lds, qr, qsp, r32, hi);
        finishSM(pB0, pB1, alB, l_reg, pa0, pa1, pa2, pa3); SBAR();
        SLOAD((j + 2) * KVBLK); SBAR();
        pv_d0(o, vb0 + SHM_V, pa0, pa1, pa2, pa3); partialSM(pA0, pA1, m_reg, mnA, alA);
        __syncthreads(); SWAIT(); SWRITE(1);
        RESC(alA); __syncthreads();
    }
    SBAR(); qkt(pB0, pB1, K_lds + SHM_K, KR_lds + SHM_KR, qr, qsp, r32, hi);
    finishSM(pA0, pA1, alA, l_reg, pa0, pa1, pa2, pa3); SBAR();
    pv_d0(o, vb0, pa0, pa1, pa2, pa3); partialSM(pB0, pB1, m_reg, mnB, alB);
    __syncthreads(); RESC(alB);
    finishSM(pB0, pB1, alB, l_reg, pa0, pa1, pa2, pa3); SBAR();
    pv_d0(o, vb0 + SHM_V, pa0, pa1, pa2, pa3);
    if (hi == 0) li_l[r32] = l_reg; asm volatile("s_waitcnt lgkmcnt(0)" ::: "memory");
    float rli[16];
#pragma unroll
    for (int r = 0; r < 16; ++r) rli[r] = __builtin_amdgcn_rcpf(li_l[crow(r, hi)]);
    char* Ow = (char*)Ob + (size_t)(wid * QBLK) * LDO * 2; const unsigned ooff = (unsigned)(4 * hi * LDO + r32) * 2u;
#pragma unroll
    for (int r = 0; r < 16; ++r) { const int orel = (r & 3) + 8 * (r >> 2);
#pragma unroll
        for (int d0 = 0; d0 < 4; ++d0) { const unsigned w = cvt_pk_bf16(o[d0][r] * rli[r], 0.f); *(bf16_t*)(Ow + ooff + (orel * LDO + d0 * 32) * 2) = (bf16_t)(w & 0xffffu); } }
    __syncthreads();
#undef SLOAD
#undef SWRITE
#undef SWAIT
#undef RESC
}
}

#define XB_TMO      128
#define XB_XCNT(j)  (256  + 64 * (j))
#define XB_XSUB(j)  (1280 + 64 * (j))
#define XB_XGEN(j)  (2304 + 64 * (j))
#define XB_TOP      3328
#define XB_TOPGEN   3392
#define XCD_BAR_WORDS 3456
#define XB_SPIN_CAP (1u << 18)
__device__ __forceinline__ unsigned xb_ld(unsigned* p)              { return __hip_atomic_load(p, __ATOMIC_RELAXED, __HIP_MEMORY_SCOPE_AGENT); }
__device__ __forceinline__ unsigned xb_add(unsigned* p, unsigned v) { return __hip_atomic_fetch_add(p, v, __ATOMIC_RELAXED, __HIP_MEMORY_SCOPE_AGENT); }
__device__ __forceinline__ unsigned xb_xcc_id() { return (unsigned)__builtin_amdgcn_s_getreg((3 << 11) | 20) & 0xFu; }
#define XB_SPIN(cond, bar) do { unsigned _sp = 0; while (cond) { __builtin_amdgcn_s_sleep(1); \
    if ((++_sp & 255u) == 0u) { if (xb_ld(&(bar)[XB_TMO])) break; if (_sp > XB_SPIN_CAP) { atomicAdd(&(bar)[XB_TMO], 1u); break; } } } } while (0)
struct XcdBarrier { unsigned* bar; unsigned x; volatile LAS unsigned* st; };
__device__ __forceinline__ XcdBarrier xcd_barrier_post(unsigned* bar, volatile LAS unsigned* st, const bool t0) {
    XcdBarrier b; b.bar = bar; b.x = xb_xcc_id(); b.st = st;
    if (t0) (void)xb_add(&bar[XB_XCNT(b.x)], 1u);
    return b;
}
__device__ __forceinline__ void xcd_barrier_complete(unsigned* bar, unsigned x, unsigned& nloc, unsigned& nx) {
    const unsigned G = gridDim.x * gridDim.y * gridDim.z;
    unsigned sum, cnt, mine, sp = 0u;
    for (;;) {
        sum = 0u; cnt = 0u; mine = 0u;
#pragma unroll
        for (unsigned j = 0; j < 16; ++j) { const unsigned c = xb_ld(&bar[XB_XCNT(j)]); sum += c; cnt += (c > 0u) ? 1u : 0u; mine = (j == x) ? c : mine; }
        if (sum == G) break;
        __builtin_amdgcn_s_sleep(1);
        if ((++sp & 255u) == 0u) { if (xb_ld(&bar[XB_TMO])) break; if (sp > XB_SPIN_CAP) { atomicAdd(&bar[XB_TMO], 1u); break; } }
    }
    nloc = mine > 0u ? mine : 1u; nx = cnt > 0u ? cnt : 1u;
}
__device__ __forceinline__ void xcd_barrier(const XcdBarrier& b, const bool t0) {
    asm volatile("s_waitcnt vmcnt(0)" ::: "memory");
    __syncthreads();
    if (t0) {
        unsigned* bar = b.bar;
        __builtin_amdgcn_s_waitcnt(0);
        unsigned nloc = b.st[0], nx = b.st[1];
        if (nloc == 0u) { xcd_barrier_complete(bar, b.x, nloc, nx); b.st[0] = nloc; b.st[1] = nx; }
        const unsigned old = xb_add(&bar[XB_XSUB(b.x)], 1u);
        const unsigned gen = old / nloc;
        if (old + 1u == (gen + 1u) * nloc) {
            __builtin_amdgcn_fence(__ATOMIC_RELEASE, "agent");
            asm volatile("s_waitcnt vmcnt(0)" ::: "memory");
            const unsigned og = xb_add(&bar[XB_TOP], 1u);
            const unsigned tg = og / nx;
            if (og + 1u == (tg + 1u) * nx) xb_add(&bar[XB_TOPGEN], 1u);
            else XB_SPIN(xb_ld(&bar[XB_TOPGEN]) == tg, bar);
            __builtin_amdgcn_fence(__ATOMIC_ACQUIRE, "agent");
            xb_add(&bar[XB_XGEN(b.x)], 1u);
            asm volatile("s_waitcnt vmcnt(0)" ::: "memory");
        } else {
            XB_SPIN(xb_ld(&bar[XB_XGEN(b.x)]) == gen, bar);
            __builtin_amdgcn_fence(__ATOMIC_ACQUIRE, "agent");
            asm volatile("s_waitcnt vmcnt(0)" ::: "memory");
        }
    }
    __syncthreads();
}

__device__ __forceinline__ int wfi_src(int nb) { const int pn = nb >> 3, q = nb & 7; return (q >> 2) * DFF + pn * 128 + (q & 3) * 32; }
__device__ __forceinline__ int win_src(int nb) { const int n0 = nb * 32; if (n0 < 1536) return n0; if (n0 < 1792) return n0 == 1536 ? 1536 : (n0 == 1664 ? 1568 : -1); return n0 - 192; }
__device__ __forceinline__ int wuq_src(int nb) { const int n0 = nb * 32; if (n0 < 2048) return (n0 >> 7) * 192 + (n0 & 127);
    const int w = n0 - 2048, t = w >> 8, wi = w & 255, bj = wi >> 7, hh = (wi & 127) >> 5; return (4 * t + hh) * 192 + 128 + 32 * bj; }
__device__ __forceinline__ void p0_item(const float* __restrict__ W, int ldw, int K, bf16_t* __restrict__ WT, int sc, int dn, int k0, const float* __restrict__ gk, LAS float* scr, int lane) {
    const int c = lane & 7;
    if (sc < 0) {
#pragma unroll
        for (int j = 0; j < 4; ++j) { const int n = (lane >> 3) + 8 * j; *(u32x4*)(WT + (size_t)(dn + n) * K + k0 + 8 * c) = (u32x4){0u, 0u, 0u, 0u}; }
        return;
    }
#pragma unroll 8
    for (int i = 0; i < 32; ++i) { const int kk = 2 * i + (lane >> 5); float v = __builtin_nontemporal_load(W + (size_t)(k0 + kk) * ldw + sc + (lane & 31)); if (gk) v *= gk[k0 + kk]; scr[kk * 33 + (lane & 31)] = v; }
    LDS_WAIT(); asm volatile("" ::: "memory");
#pragma unroll
    for (int j = 0; j < 4; ++j) { const int n = (lane >> 3) + 8 * j; const LAS float* s = scr + (8 * c) * 33 + n;
        u32x4 o; o.x = cvt_pk_bf16(s[0 * 33], s[1 * 33]); o.y = cvt_pk_bf16(s[2 * 33], s[3 * 33]); o.z = cvt_pk_bf16(s[4 * 33], s[5 * 33]); o.w = cvt_pk_bf16(s[6 * 33], s[7 * 33]);
        __builtin_nontemporal_store(o, (u32x4*)(WT + (size_t)(dn + n) * K + k0 + 8 * c)); }
    LDS_WAIT(); asm volatile("" ::: "memory");
}

__device__ __forceinline__ void p0_item_ln(const float* __restrict__ W, int ldw, int K, bf16_t* __restrict__ WT, int sc, int dn, int k0, const float* __restrict__ gk, const float* __restrict__ bk,
                                           float* sv, float* cv, LAS float* scr, int lane) {
    const int c = lane & 7;
#pragma unroll 8
    for (int i = 0; i < 32; ++i) { const int kk = 2 * i + (lane >> 5); scr[kk * 33 + (lane & 31)] = __builtin_nontemporal_load(W + (size_t)(k0 + kk) * ldw + sc + (lane & 31)); }
    const f32x4 ga = *(const f32x4*)(gk + k0 + 8 * c), gb = *(const f32x4*)(gk + k0 + 8 * c + 4), ba = *(const f32x4*)(bk + k0 + 8 * c), bb = *(const f32x4*)(bk + k0 + 8 * c + 4);
    LDS_WAIT(); asm volatile("" ::: "memory");
    float sk = 0.f, ck = 0.f;
#pragma unroll
    for (int j = 0; j < 4; ++j) { const int n = (lane >> 3) + 8 * j; const LAS float* sp = scr + (8 * c) * 33 + n;
        const float w0 = sp[0 * 33], w1 = sp[1 * 33], w2 = sp[2 * 33], w3 = sp[3 * 33], w4 = sp[4 * 33], w5 = sp[5 * 33], w6 = sp[6 * 33], w7 = sp[7 * 33];
        u32x4 o; o.x = cvt_pk_bf16(w0 * ga[0], w1 * ga[1]); o.y = cvt_pk_bf16(w2 * ga[2], w3 * ga[3]); o.z = cvt_pk_bf16(w4 * gb[0], w5 * gb[1]); o.w = cvt_pk_bf16(w6 * gb[2], w7 * gb[3]);
        __builtin_nontemporal_store(o, (u32x4*)(WT + (size_t)(dn + n) * K + k0 + 8 * c));
        float ss = ((bf_lo(o.x) + bf_hi(o.x)) + (bf_lo(o.y) + bf_hi(o.y))) + ((bf_lo(o.z) + bf_hi(o.z)) + (bf_lo(o.w) + bf_hi(o.w)));
        float cs = ((w0 * ba[0] + w1 * ba[1]) + (w2 * ba[2] + w3 * ba[3])) + ((w4 * bb[0] + w5 * bb[1]) + (w6 * bb[2] + w7 * bb[3]));
        ss += __shfl_xor(ss, 1); ss += __shfl_xor(ss, 2); ss += __shfl_xor(ss, 4); cs += __shfl_xor(cs, 1); cs += __shfl_xor(cs, 2); cs += __shfl_xor(cs, 4);
        if (c == j) { sk = ss; ck = cs; } }
    if (c < 4) { const int n = (lane >> 3) + 8 * c; atomicAdd(sv + dn + n, sk); atomicAdd(cv + dn + n, ck); }
    LDS_WAIT(); asm volatile("" ::: "memory");
}

__device__ __forceinline__ void p0_item_lnr(const float* __restrict__ W, int ldw, bf16_t* __restrict__ WR, int sc, int k0, const float* __restrict__ gk, const float* __restrict__ bk,
                                            float* sv, float* cv, int lane) {
    const int cp = lane & 15, r4 = lane >> 4;
    float s0 = 0.f, s1 = 0.f, c0 = 0.f, c1 = 0.f;
#pragma unroll 8
    for (int i = 0; i < 16; ++i) { const int k = k0 + 4 * i + r4; const f32x2 w = __builtin_nontemporal_load((const f32x2*)(W + (size_t)k * ldw + sc + 2 * cp)); const float g = gk[k], b = bk[k];
        const unsigned o = cvt_pk_bf16(w.x * g, w.y * g); *(unsigned*)(WR + (size_t)k * ldw + sc + 2 * cp) = o;
        s0 += bf_lo(o); s1 += bf_hi(o); c0 += w.x * b; c1 += w.y * b; }
    s0 += __shfl_xor(s0, 16); s0 += __shfl_xor(s0, 32); s1 += __shfl_xor(s1, 16); s1 += __shfl_xor(s1, 32);
    c0 += __shfl_xor(c0, 16); c0 += __shfl_xor(c0, 32); c1 += __shfl_xor(c1, 16); c1 += __shfl_xor(c1, 32);
    if (r4 == 0) { atomicAdd(sv + sc + 2 * cp, s0); atomicAdd(sv + sc + 2 * cp + 1, s1); atomicAdd(cv + sc + 2 * cp, c0); atomicAdd(cv + sc + 2 * cp + 1, c1); }
}

constexpr int NPHASE = 21;
struct Args { const void* in[28]; float* out; unsigned char* ws; int ph_lo, ph_hi; };
static_assert(WS_CONVB + (size_t)DFF2 * 4 <= WS_MISC && WS_CONVW >= CTL_ZERO_BYTES, "conv weight copy");
static_assert(WS_C2 + DFF2 * 4 <= CTL_ZERO_BYTES && WS_MISC >= CTL_ZERO_BYTES && WS_MISC + 64 <= WS_WIN, "control region");
static_assert(sizeof(Args) == 28 * 8 + 8 + 8 + 8, "Args has no padding");

__global__ void __launch_bounds__(NWAVES * 64, 2) mk_fwd(Args args) {
    extern __shared__ __attribute__((aligned(16))) unsigned char lds_raw[];
    LAS unsigned char* lds = (LAS unsigned char*)lds_raw;
    volatile LAS unsigned* MISC = (volatile LAS unsigned*)(lds + MISC_OFF);
    const int wave = __builtin_amdgcn_readfirstlane((int)threadIdx.x >> 6);
#define tid (wave * 64 + lane)
    const int G = gridDim.x, bx = blockIdx.x;
    const int vcu = (G % 8 == 0) ? (bx % 8) * (G / 8) + bx / 8 : bx;
    const int gw = vcu * NWAVES + wave, NGW = G * NWAVES;
    const int NGT = G * NWAVES * 64;
#define gtid (vcu * (NWAVES * 64) + wave * 64 + lane)
    unsigned char* ws = args.ws;
    unsigned* ctl = (unsigned*)(ws + WS_CTL);
    { const int lane = lane_id(); for (int u = tid; u < (LDS_BYTES - LDSCTL_OFF) / 4; u += NWAVES * 64) ((LAS unsigned*)(lds + LDSCTL_OFF))[u] = 0u; }
    __syncthreads();
    XcdBarrier bar; bar.bar = ctl + CW_BAR; bar.x = 0; bar.st = nullptr;
#if !MK_PER_PHASE
    bar = xcd_barrier_post(ctl + CW_BAR, MISC + 8, wave == 0 && lane_id() == 0);
#define GRID_BAR() xcd_barrier(bar, wave == 0 && lane_id() == 0)
#else
#define GRID_BAR() do {} while (0)
#endif
    const int lo = args.ph_lo, hi = args.ph_hi;
#ifndef DUP_MASK
#define DUP_MASK 0u
#endif
#define IN(k) (lo <= (k) && (k) < hi)
#define REP(k) for (int rep_ = 0; rep_ < (((DUP_MASK >> (k)) & 1u) ? 2 : 1); ++rep_)
#define SEAM(k) do { if (IN(k) && IN((k) + 1)) GRID_BAR(); } while (0)

#define in_x ((const float*)args.in[0])
#define in_mem ((const float*)args.in[1])
#define in_positions ((const int*)args.in[2])
#define in_w_in ((const float*)args.in[3])
#define in_gate_bias ((const float*)args.in[4])
#define in_q_norm_g ((const float*)args.in[5])
#define in_w_uq ((const float*)args.in[6])
#define in_kv_norm_g ((const float*)args.in[7])
#define in_w_ukv ((const float*)args.in[8])
#define in_dec_f ((const float*)args.in[9])
#define in_dec_b ((const float*)args.in[10])
#define in_w_br_mla ((const float*)args.in[11])
#define in_w_br_ret ((const float*)args.in[12])
#define in_w_o ((const float*)args.in[13])
#define in_ln1_g ((const float*)args.in[14])
#define in_ln1_b ((const float*)args.in[15])
#define in_w_cq ((const float*)args.in[16])
#define in_w_ck ((const float*)args.in[17])
#define in_w_cv ((const float*)args.in[18])
#define in_w_co ((const float*)args.in[19])
#define in_ln2_g ((const float*)args.in[20])
#define in_ln2_b ((const float*)args.in[21])
#define in_w_ffn_in ((const float*)args.in[22])
#define in_conv_w ((const float*)args.in[23])
#define in_conv_b ((const float*)args.in[24])
#define in_w_ffn_out ((const float*)args.in[25])
#define in_ln3_g ((const float*)args.in[26])
#define in_ln3_b ((const float*)args.in[27])
#define Win_t ((bf16_t*)(ws + WS_WIN))
#define Wfi_t ((bf16_t*)(ws + WS_WFI))
#define Wfo_t ((bf16_t*)(ws + WS_WFO))
#define Wbr_t ((bf16_t*)(ws + WS_WBR))
#define Wo_t ((bf16_t*)(ws + WS_WO))
#define Wcq_r ((bf16_t*)(ws + WS_WCQ))
#define Wck_t ((bf16_t*)(ws + WS_WCK))
#define Wcv_t ((bf16_t*)(ws + WS_WCV))
#define Wco_t ((bf16_t*)(ws + WS_WCO))
#define Wbm_t ((bf16_t*)(ws + WS_WBM))
#define Wuq_t ((bf16_t*)(ws + WS_WUQ))
#define Wukv_t ((bf16_t*)(ws + WS_WUKV))
#define MEMB ((bf16_t*)(ws + WS_MEMB))
#define ROPER ((f32x2*)(ws + WS_ROPER))
#define ROPEA ((f32x2*)(ws + WS_ROPEA))
#define RSS ((float*)(ws + WS_RSS))
#define RS1 ((float*)(ws + WS_RS1))
#define RS2 ((float*)(ws + WS_RS2))
#define RS3 ((float*)(ws + WS_RS3))
#define S1V ((float*)(ws + WS_S1))
#define C1V ((float*)(ws + WS_C1))
#define S2V ((float*)(ws + WS_S2))
#define C2V ((float*)(ws + WS_C2))
#define ZB ((bf16_t*)(ws + WS_ZB))
#define DEC ((float*)(ws + WS_MISC))
#define XB ((bf16_t*)(ws + WS_XB))
#define CQM ((bf16_t*)(ws + WS_CQM))
#define CKV ((bf16_t*)(ws + WS_CKV))
#define KPE ((bf16_t*)(ws + WS_KPE))
#define RQ ((bf16_t*)(ws + WS_RQ))
#define RK ((bf16_t*)(ws + WS_RK))
#define RVT ((bf16_t*)(ws + WS_RVT))
#define RG ((bf16_t*)(ws + WS_RG))
#define GT ((bf16_t*)(ws + WS_GT))
#define SC ((bf16_t*)(ws + WS_SC))
#define AO ((bf16_t*)(ws + WS_AO))
#define QB ((bf16_t*)(ws + WS_Q))
#define KVB ((bf16_t*)(ws + WS_KV))
#define ORET ((bf16_t*)(ws + WS_ORET))
#define ROUT ((bf16_t*)(ws + WS_ROUT))
#define TMP ((bf16_t*)(ws + WS_TMP))
#define MIXED ((bf16_t*)(ws + WS_MIXED))
#define Z ((float*)(ws + WS_Z))
#define MQT ((bf16_t*)(ws + WS_MQT))
#define VWT ((bf16_t*)(ws + WS_VWT))
#define CK ((bf16_t*)(ws + WS_CK))
#define CV ((bf16_t*)(ws + WS_CV))
#define SXV ((float*)(ws + WS_SX))
#define CXV ((float*)(ws + WS_CX))
#define XS ((float*)(ws + WS_XS))
#define XP ((bf16_t*)(ws + WS_XP))
#define EDGE ((unsigned*)(ws + WS_EDGE))
#define ACT ((bf16_t*)(ws + WS_ACT))

#define GEMM_CALL(EpiT, Ev, Aptr, Bptr, lda_, ldb_, K_, nM_, nN_, nZ_, nh_, sAb_, sAh_, sBb_, sBh_) do { \
        pg8::Gemm g_{(Aptr), (Bptr), (lda_), (ldb_), (K_), (nh_), (long)(sAb_), (long)(sAh_), (long)(sBb_), (long)(sBh_)}; \
        pg8::Order S_; S_.init((nM_), (nN_), (nZ_), G, bx); pg8::gemm_phase<EpiT>(lds, g_, S_, (Ev), wave); } while (0)

    constexpr int I_IN = (INP / 32) * (D / 64), I_UQ = (3072 / 32) * (1024 / 64), I_UKV = (4096 / 32) * (512 / 64), I_BM = (4096 / 32) * (2048 / 64), I_SQ = (4096 / 32) * (4096 / 64);
    constexpr int I_FI = (DFF2 / 32) * (D / 64), I_FO = (4096 / 32) * (DFF / 64);
    const bool split = (G == 256);
#define CONV_WCO(lo_, hi_, w_, nw_) do { LAS float* scr_ = (LAS float*)(lds + wave * 16384); for (int r = (lo_) + (w_); r < (hi_); r += (nw_)) { const int nblk = 4096 / 32, kb = r / nblk, nb = r % nblk; \
        p0_item(in_w_co, 4096, 4096, Wco_t, nb * 32, nb * 32, kb * 64, nullptr, scr_, lane); } } while (0)
#define CONV_WFI2(w_, nw_) do { LAS float* scr_ = (LAS float*)(lds + wave * 16384); for (int r = I_FI / 2 + (w_); r < I_FI; r += (nw_)) { const int nblk = DFF2 / 32, kb = r / nblk, nb = r % nblk; \
        p0_item_ln(in_w_ffn_in, DFF2, D, Wfi_t, wfi_src(nb), nb * 32, kb * 64, in_ln2_g, in_ln2_b, S2V, C2V, scr_, lane); } } while (0)
#define CONV_WFO(w_, nw_) do { LAS float* scr_ = (LAS float*)(lds + wave * 16384); for (int r = (w_); r < I_FO; r += (nw_)) { const int nblk = 4096 / 32, kb = r / nblk, nb = r % nblk; \
        p0_item(in_w_ffn_out, 4096, DFF, Wfo_t, nb * 32, nb * 32, kb * 64, nullptr, scr_, lane); } } while (0)
    if (IN(0)) REP(0) { const int lane = lane_id();
        LAS float* scr = (LAS float*)(lds + wave * 16384);
        constexpr int NITEMS = I_IN + I_UQ + I_UKV + I_BM + 5 * I_SQ + I_FI / 2;
        for (int it = gw; it < NITEMS; it += NGW) {
            int r = it;
            if (r < I_IN) { const int nblk = INP / 32, kb = r / nblk, nb = r % nblk; p0_item(in_w_in, INW, D, Win_t, win_src(nb), nb * 32, kb * 64, nullptr, scr, lane); continue; } r -= I_IN;
            if (r < I_UQ) { const int nblk = 3072 / 32, kb = r / nblk, nb = r % nblk; p0_item(in_w_uq, 3072, 1024, Wuq_t, wuq_src(nb), nb * 32, kb * 64, in_q_norm_g, scr, lane); continue; } r -= I_UQ;
            if (r < I_UKV) { const int nblk = 4096 / 32, kb = r / nblk, nb = r % nblk; p0_item(in_w_ukv, 4096, 512, Wukv_t, nb * 32, nb * 32, kb * 64, in_kv_norm_g, scr, lane); continue; } r -= I_UKV;
            if (r < I_BM) { const int nblk = 4096 / 32, kb = r / nblk, nb = r % nblk; p0_item(in_w_br_mla, 4096, 2048, Wbm_t, nb * 32, nb * 32, kb * 64, nullptr, scr, lane); continue; } r -= I_BM;
            if (r < 5 * I_SQ) { const int wsel = r / I_SQ; r -= wsel * I_SQ; const int nblk = 4096 / 32, kb = r / nblk, nb = r % nblk;
                const float* W = wsel == 0 ? in_w_br_ret : wsel == 1 ? in_w_o : wsel == 2 ? in_w_cq : wsel == 3 ? in_w_ck : in_w_cv;
                bf16_t* WT = wsel == 0 ? Wbr_t : wsel == 1 ? Wo_t : wsel == 2 ? Wcq_r : wsel == 3 ? Wck_t : Wcv_t;
                if (wsel == 2) p0_item_lnr(W, 4096, WT, nb * 32, kb * 64, in_ln1_g, in_ln1_b, S1V, C1V, lane);
                else p0_item(W, 4096, 4096, WT, nb * 32, nb * 32, kb * 64, nullptr, scr, lane);
                continue; } r -= 5 * I_SQ;
            { const int nblk = DFF2 / 32, kb = r / nblk, nb = r % nblk; p0_item_ln(in_w_ffn_in, DFF2, D, Wfi_t, wfi_src(nb), nb * 32, kb * 64, in_ln2_g, in_ln2_b, S2V, C2V, scr, lane); }
        }
        if (!split) { CONV_WCO(0, I_SQ, gw, NGW); CONV_WFI2(gw, NGW); CONV_WFO(gw, NGW); }
        for (long i = gtid; i < (long)T * D / 8; i += NGT) { const f32x4 a = __builtin_nontemporal_load((const f32x4*)(in_x + i * 8)), b = __builtin_nontemporal_load((const f32x4*)(in_x + i * 8 + 4)); *(u32x4*)(XB + i * 8) = pg8::pack8(a, b); }
        for (long i = gtid; i < (long)TM * D / 8; i += NGT) { const f32x4 a = *(const f32x4*)(in_mem + i * 8), b = *(const f32x4*)(in_mem + i * 8 + 4); *(u32x4*)(MEMB + i * 8) = pg8::pack8(a, b); }
        for (int i = gtid; i < 3 * DFF2 / 4; i += NGT) ((f32x4*)(ws + WS_CONVW))[i] = ((const f32x4*)in_conv_w)[i];
        for (int i = gtid; i < DFF2 / 4; i += NGT) ((f32x4*)(ws + WS_CONVB))[i] = ((const f32x4*)in_conv_b)[i];
        if (gtid < 16) { const float e = gtid < 8 ? in_dec_f[gtid] : in_dec_b[gtid - 8]; DEC[gtid] = log1pf(-exp2f(-e)) * 1.4426950408889634f; }
        __syncthreads();
    }
    SEAM(0);

    if (IN(1)) REP(1) {
        pg8::EpiProj E{CQM, CKV, KPE, RQ, RK, RVT, RG, GT, RSS, in_positions, in_gate_bias, lds};
        GEMM_CALL(pg8::EpiProj, E, XB, Win_t, D, D, D, 32, 87, 1, 1, 0, 0, 0, 0);
        const int lane = lane_id();
        if (split && bx >= 224) CONV_WCO(0, I_SQ / 2, (bx - 224) * NWAVES + wave, 32 * NWAVES);
    }
    SEAM(1);

    if (IN(2)) REP(2) {
        { pg8::EpiQ E{QB, RSS, in_positions}; GEMM_CALL(pg8::EpiQ, E, CQM, Wuq_t, 1024, 1024, 1024, 32, 12, 1, 1, 0, 0, 0, 0); }
        { pg8::EpiBf16 E{KVB, 4096, 1.0f, 1, 0, 0, RSS + T, 1.0f / 512.0f}; GEMM_CALL(pg8::EpiBf16, E, CKV, Wukv_t, 512, 512, 512, 32, 16, 1, 1, 0, 0, 0, 0); }
    }
    SEAM(2);

    if (IN(3)) REP(3) {
        for (int idx = vcu; idx < 512; idx += G) {
            const int bh = idx >> 3, qb = idx & 7, b = bh >> 4, h = bh & 15;
            const size_t row0 = (size_t)b * SEQ + qb * 256, key0 = (size_t)b * SEQ;
            att::attn_unit(QB + row0 * 3072 + h * 192, KVB + key0 * 4096 + h * 256, KVB + key0 * 4096 + h * 256 + 128, KPE + key0 * 64, AO + row0 * 2048 + h * 128, SEQ, (att::lptr)lds, wave);
        }
    }
    if (IN(3) && IN(4)) __syncthreads();

    if (IN(4)) REP(4) {
        pg8::EpiRetS E{SC, DEC};
        GEMM_CALL(pg8::EpiRetS, E, RQ, RK, 2048, 2048, 256, 8, 8, 32, 8, (long)SEQ * 2048, 256, (long)SEQ * 2048, 256);
    }
    SEAM(4);

    if (IN(5)) REP(5) {
        pg8::EpiBf16 E{ORET, D, 1.0f, 8, (long)SEQ * D, 512, nullptr, 0.f};
        GEMM_CALL(pg8::EpiBf16, E, SC, RVT, 2048, 2048, 2048, 8, 2, 32, 8, (long)8 * SEQ * SEQ, (long)SEQ * SEQ, (long)8 * 512 * SEQ, (long)512 * SEQ);
    }
    SEAM(5);

    if (IN(6)) REP(6) { const int lane = lane_id();
        for (int it = gw; it < T * 8; it += NGW) {
            const size_t off = (size_t)it * 512;
            const u32x2 aw = __builtin_nontemporal_load((const u32x2*)(ORET + off + lane * 4)), bw = __builtin_nontemporal_load((const u32x2*)(ORET + off + 256 + lane * 4));
            const f32x4 a = {bf_lo(aw.x), bf_hi(aw.x), bf_lo(aw.y), bf_hi(aw.y)}, b = {bf_lo(bw.x), bf_hi(bw.x), bf_lo(bw.y), bf_hi(bw.y)};
            const float mean = wave_sum((a[0] + a[1]) + (a[2] + a[3]) + (b[0] + b[1]) + (b[2] + b[3])) * (1.0f / 512.0f);
            const f32x4 da = a - mean, db = b - mean;
            const float var = wave_sum((da[0] * da[0] + da[1] * da[1]) + (da[2] * da[2] + da[3] * da[3]) + (db[0] * db[0] + db[1] * db[1]) + (db[2] * db[2] + db[3] * db[3])) * (1.0f / 512.0f);
            const float rstd = rsqrtf(var + LN_EPS);
            const size_t goff = (size_t)(it >> 3) * RGP + (it & 7) * 512;
            const u32x2 ga = __builtin_nontemporal_load((const u32x2*)(RG + goff + lane * 4)), gb = __builtin_nontemporal_load((const u32x2*)(RG + goff + 256 + lane * 4));
            u32x2 oa, ob;
            oa.x = cvt_pk_bf16(da[0] * rstd * bf_lo(ga.x), da[1] * rstd * bf_hi(ga.x)); oa.y = cvt_pk_bf16(da[2] * rstd * bf_lo(ga.y), da[3] * rstd * bf_hi(ga.y));
            ob.x = cvt_pk_bf16(db[0] * rstd * bf_lo(gb.x), db[1] * rstd * bf_hi(gb.x)); ob.y = cvt_pk_bf16(db[2] * rstd * bf_lo(gb.y), db[3] * rstd * bf_hi(gb.y));
            *(u32x2*)(ROUT + off + lane * 4) = oa; *(u32x2*)(ROUT + off + 256 + lane * 4) = ob;
        }
    }
    if (IN(6) && IN(7)) __syncthreads();

    if (IN(7)) REP(7) { pg8::EpiBf16 E{TMP, D, 1.0f, 1, 0, 0, nullptr, 0.f}; GEMM_CALL(pg8::EpiBf16, E, AO, Wbm_t, 2048, 2048, 2048, 32, 16, 1, 1, 0, 0, 0, 0); }
    SEAM(7);
    if (IN(8)) REP(8) { pg8::EpiGate1 E{MIXED, TMP, GT}; GEMM_CALL(pg8::EpiGate1, E, ROUT, Wbr_t, D, D, D, 32, 16, 1, 1, 0, 0, 0, 0); }
    SEAM(8);
    if (IN(9)) REP(9) { typedef pg8::EpiResStat<WS_ZB, WS_RS1> EpiT9; EpiT9 E{ws, in_x}; GEMM_CALL(EpiT9, E, MIXED, Wo_t, D, D, D, 32, 16, 1, 1, 0, 0, 0, 0); }
    SEAM(9);

#define LN_PHASE(Zp, gp, bp, outF, outB) do { \
        for (int m = gw; m < T; m += NGW) { \
            const f32x4* zr = (const f32x4*)((Zp) + (size_t)m * D) + lane; f32x4 v[16]; float s = 0.f; \
            _Pragma("unroll") for (int j = 0; j < 16; ++j) { v[j] = zr[64 * j]; s += (v[j][0] + v[j][1]) + (v[j][2] + v[j][3]); } \
            const float mean = wave_sum(s) * (1.0f / D); float s2 = 0.f; \
            _Pragma("unroll") for (int j = 0; j < 16; ++j) { v[j] = v[j] - mean; s2 += (v[j][0] * v[j][0] + v[j][1] * v[j][1]) + (v[j][2] * v[j][2] + v[j][3] * v[j][3]); } \
            const float rstd = rsqrtf(wave_sum(s2) * (1.0f / D) + LN_EPS); \
            _Pragma("unroll") for (int j = 0; j < 16; ++j) { const f32x4 gg = ((const f32x4*)(gp))[64 * j + lane], bb = ((const f32x4*)(bp))[64 * j + lane]; const f32x4 y = v[j] * rstd * gg + bb; \
                if ((outF) != nullptr) ((f32x4*)((outF) + (size_t)m * D))[64 * j + lane] = y; \
                if ((outB) != nullptr) { u32x2 w; w.x = cvt_pk_bf16(y[0], y[1]); w.y = cvt_pk_bf16(y[2], y[3]); ((u32x2*)((outB) + (size_t)m * D))[64 * j + lane] = w; } } \
        } } while (0)

    if (IN(11)) REP(11) { const int lane = lane_id();
        if (bx < 64) { pg8::EpiBf16 E{CK, D, 1.0f, 1, 0, 0, nullptr, 0.f}; pg8::Gemm g_{MEMB, Wck_t, D, D, D, 1, 0, 0, 0, 0}; pg8::Order S_; S_.init(4, 16, 1, 64, bx); pg8::gemm_phase<pg8::EpiBf16>(lds, g_, S_, E, wave); }
        else if (bx >= 128) { if (split) { CONV_WFI2((bx - 128) * NWAVES + wave, 128 * NWAVES); CONV_WCO(I_SQ / 2, I_SQ, (bx - 128) * NWAVES + wave, 128 * NWAVES); } }
        else { pg8::EpiBf16 E{CV, D, 1.0f, 1, 0, 0, nullptr, 0.f}; pg8::Gemm g_{MEMB, Wcv_t, D, D, D, 1, 0, 0, 0, 0}; pg8::Order S_; S_.init(4, 16, 1, 64, bx - 64); pg8::gemm_phase<pg8::EpiBf16>(lds, g_, S_, E, wave); }
    }
    SEAM(11);

    if (IN(12)) REP(12) {
        { pg8::EpiBf16 E{MQT, D, 1.0f, 4, (long)1024 * D, (long)256 * D, nullptr, 0.f}; GEMM_CALL(pg8::EpiBf16, E, CK, Wcq_r, D, D, 1024, 1, 16, 16, 4, (long)MEM * D, 1024, 0, 1024); }
        { pg8::EpiBf16 E{VWT, 1024, 1.0f, 4, (long)D * 1024, 256, nullptr, 0.f}; GEMM_CALL(pg8::EpiBf16, E, Wco_t, CV, D, D, 1024, 16, 1, 16, 4, 0, 1024, (long)MEM * D, 1024); }
        const int lane = lane_id();
        for (int it = gw; it < TM * 4; it += NGW) { const int row = it >> 2, h = it & 3;
            const bf16_t* cr = CK + (size_t)row * D + h * 1024 + lane * 8; const float* sp = S1V + h * 1024 + lane * 8; const float* cp = C1V + h * 1024 + lane * 8;
            float sa = 0.f, ca = 0.f;
#pragma unroll
            for (int j = 0; j < 2; ++j) { const u32x4 w_ = *(const u32x4*)(cr + j * 512); const f32x4 s0 = *(const f32x4*)(sp + j * 512), s1 = *(const f32x4*)(sp + j * 512 + 4), c0 = *(const f32x4*)(cp + j * 512), c1 = *(const f32x4*)(cp + j * 512 + 4);
                const f32x4 k0 = {bf_lo(w_.x), bf_hi(w_.x), bf_lo(w_.y), bf_hi(w_.y)}, k1 = {bf_lo(w_.z), bf_hi(w_.z), bf_lo(w_.w), bf_hi(w_.w)};
                sa += ((k0[0] * s0[0] + k0[1] * s0[1]) + (k0[2] * s0[2] + k0[3] * s0[3])) + ((k1[0] * s1[0] + k1[1] * s1[1]) + (k1[2] * s1[2] + k1[3] * s1[3]));
                ca += ((k0[0] * c0[0] + k0[1] * c0[1]) + (k0[2] * c0[2] + k0[3] * c0[3])) + ((k1[0] * c1[0] + k1[1] * c1[1]) + (k1[2] * c1[2] + k1[3] * c1[3])); }
            sa = wave_sum(sa); ca = wave_sum(ca);
            if (lane == 0) { const int o = (row >> 8) * 1024 + h * 256 + (row & 255); SXV[o] = sa; CXV[o] = ca; } }
    }
    SEAM(12);

    if (IN(13)) REP(13) { pg8::EpiF32 E{XS, 1024, 2, (long)SEQ * 1024, (long)T * 1024}; GEMM_CALL(pg8::EpiF32, E, ZB, MQT, D, D, 2048, 8, 4, 8, 2, (long)SEQ * D, 2048, (long)1024 * D, 2048); }
    SEAM(13);

    if (IN(14)) REP(14) { const int lane = lane_id();
        for (int it = gw; it < T * 4; it += NGW) {
            const size_t off = (size_t)it * 256 + lane * 4; const int tok = it >> 2, fo = (tok >> 11) * 1024 + (it & 3) * 256 + lane * 4;
            const f32x4 a0 = __builtin_nontemporal_load((const f32x4*)(XS + off)), a1 = __builtin_nontemporal_load((const f32x4*)(XS + (size_t)T * 1024 + off)), sx = *(const f32x4*)(SXV + fo), cx = *(const f32x4*)(CXV + fo);
            const f32x2 st = *(const f32x2*)(RS1 + (size_t)tok * 2);
            const float mean = st.x * (1.0f / D), rstd = rsqrtf(st.y * (1.0f / D) - mean * mean + LN_EPS);
            const f32x4 a = (((a0 + a1) - sx * mean) * rstd + cx) * 0.03125f;
            const float mx = wave_max(fmaxf(fmaxf(a[0], a[1]), fmaxf(a[2], a[3])));
            f32x4 e; e[0] = __expf(a[0] - mx); e[1] = __expf(a[1] - mx); e[2] = __expf(a[2] - mx); e[3] = __expf(a[3] - mx);
            const float inv = 1.0f / wave_sum((e[0] + e[1]) + (e[2] + e[3]));
            u32x2 w; w.x = cvt_pk_bf16(e[0] * inv, e[1] * inv); w.y = cvt_pk_bf16(e[2] * inv, e[3] * inv);
            *(u32x2*)(XP + off) = w;
        }
    }
    SEAM(14);
    if (IN(15)) REP(15) { typedef pg8::EpiResLN<WS_ZB, WS_RS1, WS_RS2, true, SEQ> EpiT15; EpiT15 E{ws, in_ln1_g, in_ln1_b}; GEMM_CALL(EpiT15, E, XP, VWT, 1024, 1024, 1024, 8, 16, 4, 1, (long)SEQ * 1024, 0, (long)D * 1024, 0); }
    SEAM(15);
    if (IN(17)) REP(17) { typedef pg8::EpiFfnConv<WS_ACT, WS_EDGE, WS_RS2, WS_S2, WS_C2, WS_CONVW, WS_CONVB> EpiT17; EpiT17 E{ws, (LAS unsigned*)(lds + TR_OFF)};
        GEMM_CALL(EpiT17, E, ZB, Wfi_t, D, D, D, 32, 86, 1, 1, 0, 0, 0, 0);
        const int lane = lane_id();
        if (split && bx >= 192) CONV_WFO((bx - 192) * NWAVES + wave, 64 * NWAVES); }
    SEAM(17);

    if (IN(18)) REP(18) { const int lane = lane_id();
        constexpr int CU8 = DFF / 8, NIT = 64 * CU8;
        for (int it = gtid; it < NIT; it += NGT) {
            const int pe = it / CU8, cu = it - pe * CU8, c0 = cu * 8, pmi = pe >> 1, bot = pe & 1;
            const int tp = ((c0 >> 7) * 256 + (c0 & 127)) >> 1;
            const unsigned* e0 = EDGE + (size_t)(pmi * 4) * (DFF2 / 2) + tp;
            const bool hasp = bot ? true : (pmi & 7) != 0, hasn = bot ? (pmi & 7) != 7 : true;
            const unsigned* pp = bot ? e0 + 2 * (size_t)(DFF2 / 2) : e0 - (size_t)(DFF2 / 2);
            const unsigned* pc = bot ? e0 + 3 * (size_t)(DFF2 / 2) : e0;
            const unsigned* pn_ = bot ? e0 + 4 * (size_t)(DFF2 / 2) : e0 + (size_t)(DFF2 / 2);
            const u32x4 z4 = {0u, 0u, 0u, 0u};
            const u32x4 up = hasp ? *(const u32x4*)pp : z4, uc = *(const u32x4*)pc, un = hasn ? *(const u32x4*)pn_ : z4;
            const u32x4 gp = hasp ? *(const u32x4*)(pp + 64) : z4, gc = *(const u32x4*)(pc + 64), gn = hasn ? *(const u32x4*)(pn_ + 64) : z4;
            float o[8];
#pragma unroll
            for (int q = 0; q < 4; ++q) { const int c = c0 + 2 * q;
                const float u0 = bf_lo(up[q]) * in_conv_w[c] + bf_lo(uc[q]) * in_conv_w[DFF2 + c] + bf_lo(un[q]) * in_conv_w[2 * (size_t)DFF2 + c] + in_conv_b[c];
                const float u1 = bf_hi(up[q]) * in_conv_w[c + 1] + bf_hi(uc[q]) * in_conv_w[DFF2 + c + 1] + bf_hi(un[q]) * in_conv_w[2 * (size_t)DFF2 + c + 1] + in_conv_b[c + 1];
                const float g0 = bf_lo(gp[q]) * in_conv_w[DFF + c] + bf_lo(gc[q]) * in_conv_w[DFF2 + DFF + c] + bf_lo(gn[q]) * in_conv_w[2 * (size_t)DFF2 + DFF + c] + in_conv_b[DFF + c];
                const float g1 = bf_hi(gp[q]) * in_conv_w[DFF + c + 1] + bf_hi(gc[q]) * in_conv_w[DFF2 + DFF + c + 1] + bf_hi(gn[q]) * in_conv_w[2 * (size_t)DFF2 + DFF + c + 1] + in_conv_b[DFF + c + 1];
                o[2 * q] = siluf_(g0) * u0; o[2 * q + 1] = siluf_(g1) * u1; }
            u32x4 w; w.x = cvt_pk_bf16(o[0], o[1]); w.y = cvt_pk_bf16(o[2], o[3]); w.z = cvt_pk_bf16(o[4], o[5]); w.w = cvt_pk_bf16(o[6], o[7]);
            *(u32x4*)(ACT + (size_t)(pmi * 256 + (bot ? 255 : 0)) * DFF + c0) = w;
        }
    }
    SEAM(18);
    if (IN(19)) REP(19) { typedef pg8::EpiResLN<WS_ZB, WS_RS2, WS_RS3, false> EpiT19; EpiT19 E{ws, in_ln2_g, in_ln2_b}; GEMM_CALL(EpiT19, E, ACT, Wfo_t, DFF, DFF, DFF, 32, 16, 1, 1, 0, 0, 0, 0); }
    SEAM(19);
    if (IN(20)) REP(20) { const int lane = lane_id();
        for (int m = gw; m < T; m += NGW) {
            const u32x4* zr = (const u32x4*)(ZB + (size_t)m * D) + lane; f32x4* orow = (f32x4*)(args.out + (size_t)m * D);
            f32x4 z[16]; float s_ = 0.f;
#pragma unroll
            for (int j = 0; j < 8; ++j) { const u32x4 zw = __builtin_nontemporal_load(zr + 64 * j); z[2 * j] = (f32x4){bf_lo(zw.x), bf_hi(zw.x), bf_lo(zw.y), bf_hi(zw.y)}; z[2 * j + 1] = (f32x4){bf_lo(zw.z), bf_hi(zw.z), bf_lo(zw.w), bf_hi(zw.w)};
                s_ += ((z[2 * j][0] + z[2 * j][1]) + (z[2 * j][2] + z[2 * j][3])) + ((z[2 * j + 1][0] + z[2 * j + 1][1]) + (z[2 * j + 1][2] + z[2 * j + 1][3])); }
            const float mean = wave_sum(s_) * (1.0f / D); float q_ = 0.f;
#pragma unroll
            for (int j = 0; j < 16; ++j) { z[j] = z[j] - mean; q_ += (z[j][0] * z[j][0] + z[j][1] * z[j][1]) + (z[j][2] * z[j][2] + z[j][3] * z[j][3]); }
            const float rstd = rsqrtf(wave_sum(q_) * (1.0f / D) + LN_EPS);
#pragma unroll
            for (int j = 0; j < 8; ++j) { const int c4 = (64 * j + lane) * 2;
                const f32x4 g0 = ((const f32x4*)in_ln3_g)[c4], g1 = ((const f32x4*)in_ln3_g)[c4 + 1], b0 = ((const f32x4*)in_ln3_b)[c4], b1 = ((const f32x4*)in_ln3_b)[c4 + 1];
                __builtin_nontemporal_store(z[2 * j] * rstd * g0 + b0, orow + c4); __builtin_nontemporal_store(z[2 * j + 1] * rstd * g1 + b1, orow + c4 + 1); }
        }
    }
#undef IN
#undef SEAM
}

extern "C" void kernel_launch(void* const* d_in, const int* in_sizes, int n_in, void* d_out, int out_size, void* d_ws, size_t ws_size, hipStream_t stream) {
    static int grid = 0;
    if (grid == 0) {
        if (n_in != 28 || in_sizes[0] != T * D || out_size != T * D || ws_size < WS_END) { fprintf(stderr, "kernel_launch: unexpected shapes (n_in %d, in0 %d, out %d, ws %zu < %zu)\n", n_in, n_in > 0 ? in_sizes[0] : -1, out_size, ws_size, (size_t)WS_END); grid = -1; return; }
        int dev = 0, cus = 0, per_cu = 0;
        if (hipGetDevice(&dev) != hipSuccess || hipDeviceGetAttribute(&cus, hipDeviceAttributeMultiprocessorCount, dev) != hipSuccess) { grid = -1; return; }
        if (hipFuncSetAttribute((const void*)mk_fwd, hipFuncAttributeMaxDynamicSharedMemorySize, LDS_BYTES) != hipSuccess) { fprintf(stderr, "kernel_launch: hipFuncSetAttribute failed\n"); grid = -1; return; }
        if (hipOccupancyMaxActiveBlocksPerMultiprocessor(&per_cu, (const void*)mk_fwd, NWAVES * 64, LDS_BYTES) != hipSuccess || per_cu < 1) fprintf(stderr, "kernel_launch: occupancy query says %d\n", per_cu);
        (void)hipGetLastError();
        grid = cus;
    }
    if (grid < 0) return;
    (void)hipMemsetAsync((char*)d_ws + WS_CTL, 0, CTL_ZERO_BYTES, stream);
    Args a{};
    for (int i = 0; i < 28; ++i) a.in[i] = d_in[i];
    a.out = (float*)d_out; a.ws = (unsigned char*)d_ws;
#if MK_PER_PHASE
    for (int p = 0; p < NPHASE; ++p) { a.ph_lo = p; a.ph_hi = p + 1; hipLaunchKernelGGL(mk_fwd, dim3(grid), dim3(NWAVES * 64), LDS_BYTES, stream, a); }
#else
    a.ph_lo = 0; a.ph_hi = NPHASE; hipLaunchKernelGGL(mk_fwd, dim3(grid), dim3(NWAVES * 64), LDS_BYTES, stream, a);
#endif
    const hipError_t le = hipPeekAtLastError();
    if (le != hipSuccess) fprintf(stderr, "kernel_launch: launch failed: %s\n", hipGetErrorName(le));
}
```

```cpp
#include <hip/hip_runtime.h>
#include <cstdio>
#include <cstdint>

#ifndef MK_PER_PHASE
#define MK_PER_PHASE 0
#endif

#define LAS __attribute__((address_space(3)))
#define GAS __attribute__((address_space(1)))
typedef unsigned short bf16_t;
typedef short bf16x8 __attribute__((ext_vector_type(8)));
typedef short s16x4 __attribute__((ext_vector_type(4)));
typedef float f32x2 __attribute__((ext_vector_type(2)));
typedef float f32x4 __attribute__((ext_vector_type(4)));
typedef float f32x16 __attribute__((ext_vector_type(16)));
typedef unsigned u32x2 __attribute__((ext_vector_type(2)));
typedef unsigned u32x4 __attribute__((ext_vector_type(4)));

constexpr int NB = 4, SEQ = 2048, T = NB * SEQ, D = 4096;
constexpr int MEM = 256, TM = NB * MEM;
constexpr int INW = 22080, INP = 22272;
constexpr int DFF = 11008, DFF2 = 22016;
constexpr float ALPHA = 1.189207115002721f;
constexpr float LN_EPS = 1e-5f, RMS_EPS = 1e-6f;
constexpr int NWAVES = 8;
constexpr int GTP = 8192 + 128, RGP = 4096 + 64;

constexpr size_t MiB = 1u << 20;
constexpr size_t WS_CTL = 0, CTL_ZERO_BYTES = 640 * 1024;
constexpr size_t WS_RSS = 64 * 1024;
constexpr size_t WS_RS1 = 128 * 1024, WS_RS2 = 192 * 1024, WS_RS3 = 256 * 1024;
constexpr size_t WS_S1 = 320 * 1024, WS_C1 = 336 * 1024;
constexpr size_t WS_S2 = 352 * 1024, WS_C2 = 448 * 1024;
constexpr size_t WS_CONVW = 640 * 1024;
constexpr size_t WS_CONVB = WS_CONVW + 3 * (size_t)DFF2 * 4;
constexpr size_t WS_MISC = 1000 * 1024;
constexpr size_t WS_WIN = 1 * MiB;
constexpr size_t WS_WFI = 175 * MiB;
constexpr size_t WS_WFO = 347 * MiB;
constexpr size_t WS_WBR = 433 * MiB;
constexpr size_t WS_WO = 465 * MiB, WS_WCQ = 497 * MiB, WS_WCK = 529 * MiB, WS_WCV = 561 * MiB, WS_WCO = 593 * MiB;
constexpr size_t WS_WBM = 625 * MiB;
constexpr size_t WS_WUQ = 641 * MiB;
constexpr size_t WS_WUKV = 647 * MiB;
constexpr size_t WS_MEMB = 651 * MiB;
constexpr size_t WS_ROPER = 659 * MiB;
constexpr size_t WS_ROPEA = 667 * MiB;
constexpr size_t WS_XB = 670 * MiB;
constexpr size_t WS_ROUT = 670 * MiB;
constexpr size_t WS_CQM = 734 * MiB;
constexpr size_t WS_CKV = 750 * MiB;
constexpr size_t WS_KPE = 758 * MiB;
constexpr size_t WS_RQ = 759 * MiB;
constexpr size_t WS_RK = 791 * MiB;
constexpr size_t WS_RVT = 823 * MiB;
constexpr size_t WS_RG = 1335 * MiB;
constexpr size_t WS_GT = 887 * MiB;
constexpr size_t WS_SC = 1079 * MiB;
constexpr size_t WS_END = 1400 * MiB;
constexpr size_t WS_AO = 1 * MiB;
constexpr size_t WS_Q = 33 * MiB;
constexpr size_t WS_KV = 81 * MiB;
constexpr size_t WS_ORET = 33 * MiB;
constexpr size_t WS_TMP = 1079 * MiB;
constexpr size_t WS_MIXED = 1207 * MiB;
constexpr size_t WS_Z = 887 * MiB;
constexpr size_t WS_ZB = 1015 * MiB;
constexpr size_t WS_MQT = 1079 * MiB;
constexpr size_t WS_VWT = 1111 * MiB;
constexpr size_t WS_CK = 1143 * MiB;
constexpr size_t WS_CV = 1151 * MiB;
constexpr size_t WS_XS = 1159 * MiB;
constexpr size_t WS_XP = 1223 * MiB;
constexpr size_t WS_SX = 1239 * MiB, WS_CX = WS_SX + 16384;
constexpr size_t WS_EDGE = 433 * MiB;
constexpr size_t WS_ACT = 1 * MiB;

constexpr int CW_BAR = 4096;

constexpr int RING_BYTES = 131072;
constexpr int LDSCTL_OFF = RING_BYTES, MISC_OFF = LDSCTL_OFF + 320;
constexpr int TR_OFF = RING_BYTES + 1024, TR_BYTES = 8 * 2048;
constexpr int LDS_BYTES = 155648;
static_assert(TR_OFF + TR_BYTES <= LDS_BYTES && MISC_OFF + 128 <= TR_OFF, "LDS map");

#define LDS_WAIT() asm volatile("s_waitcnt lgkmcnt(0)" ::: "memory")
#define VM_WAIT() asm volatile("s_waitcnt vmcnt(0)" ::: "memory")

typedef __bf16 bf16x2_t __attribute__((ext_vector_type(2)));
__device__ __forceinline__ unsigned cvt_pk_bf16(float lo, float hi) { const f32x2 v = {lo, hi}; const bf16x2_t b = __builtin_convertvector(v, bf16x2_t); return __builtin_bit_cast(unsigned, b); }
__device__ __forceinline__ int lane_id() { int l; asm volatile("v_mbcnt_lo_u32_b32 %0, -1, 0\n\tv_mbcnt_hi_u32_b32 %0, -1, %0" : "=v"(l)); return l; }
__device__ __forceinline__ float bf_lo(unsigned w) { return __uint_as_float(w << 16); }
__device__ __forceinline__ float bf_hi(unsigned w) { return __uint_as_float(w & 0xffff0000u); }
__device__ __forceinline__ float sigmoidf_(float x) { return __builtin_amdgcn_rcpf(1.0f + __expf(-x)); }
__device__ __forceinline__ float siluf_(float x) { return x * __builtin_amdgcn_rcpf(1.0f + __expf(-x)); }
__device__ __forceinline__ void rope_cs(float pos, float invr, float& c, float& s_) { const float xr = __builtin_amdgcn_fractf(pos * invr); c = __builtin_amdgcn_cosf(xr); s_ = __builtin_amdgcn_sinf(xr); }
__device__ __forceinline__ float rope_invr(int i, float half_inv) { return exp2f(-(float)i * (13.287712379549449f * half_inv)) * 0.15915494309189535f; }
__device__ __forceinline__ float dpp_ror1(float x)  { return __builtin_bit_cast(float, __builtin_amdgcn_update_dpp(0, __builtin_bit_cast(int, x), 0x121, 0xf, 0xf, false)); }
__device__ __forceinline__ float dpp_ror15(float x) { return __builtin_bit_cast(float, __builtin_amdgcn_update_dpp(0, __builtin_bit_cast(int, x), 0x12f, 0xf, 0xf, false)); }
__device__ __forceinline__ float wave_sum(float v) {
#pragma unroll
    for (int o = 1; o < 64; o <<= 1) v += __shfl_xor(v, o);
    return v;
}
__device__ __forceinline__ float wave_max(float v) {
#pragma unroll
    for (int o = 1; o < 64; o <<= 1) v = fmaxf(v, __shfl_xor(v, o));
    return v;
}

#ifndef PG8_SP2
#define PG8_SP2 1
#endif
namespace pg8 {
constexpr int BM = 256, BK = 64, HALF = 128, HTB = HALF * BK * 2, STAGE_BYTES = 8 * HTB, NXCD = 8, WGM = 8;
__host__ __device__ __forceinline__ int lds_byte(int r, int c) { const int st = (r >> 4) * 2 + (c >> 5), rr = r & 15, cc = c & 31, ob = rr * 64 + cc * 2; return st * 1024 + (ob ^ (((ob >> 9) & 1) << 5)); }
__host__ __device__ __forceinline__ void stage_rc(int b, int& R, int& C) { const int st = b / 1024, sb = b % 1024, swz = sb ^ (((sb >> 9) & 1) << 5); R = (st >> 1) * 16 + swz / 64; C = (st & 1) * 32 + (swz % 64) / 2; }
__host__ __device__ __forceinline__ int perm32(int rho) { const int n = rho >> 4, i = rho & 15; return 8 * (i >> 2) + 4 * n + (i & 3); }

struct Unit { int pm, pn, z; };
struct Gemm { const bf16_t* A; const bf16_t* Bt; int lda, ldb, K, nh; long sAb, sAh, sBb, sBh; };

struct Order {
    int nM, nN, per, ntot, G, c;
    __device__ __forceinline__ void init(int nM_, int nN_, int nZ_, int G_, int c_) { nM = nM_; nN = nN_; per = nM_ * nN_; ntot = per * nZ_; G = G_; c = c_; }
    __device__ __forceinline__ bool next(int i, Unit& u) const {
        const long L = (long)i * G + c; if (L >= ntot) return false;
        int id = (int)L; { const int q = ntot / NXCD, r = ntot % NXCD, xcd = id % NXCD, off = id / NXCD; id = (xcd < r ? xcd * (q + 1) : r * (q + 1) + (xcd - r) * q) + off; }
        u.z = id / per; const int w = id % per;
        const int nig = WGM * nN, gid = w / nig, fm = gid * WGM, gsz = (nM - fm) < WGM ? (nM - fm) : WGM;
        u.pm = fm + ((w % nig) % gsz); u.pn = (w % nig) / gsz; return true;
    }
};

typedef f32x4 Acc[2][2][4][2];

template <class Epi>
__device__ __forceinline__ void gemm_phase(LAS unsigned char* lds, const Gemm g, const Order& S, const Epi& E, const int wid) {
    const int wr = wid >> 2, wc = wid & 3;
    const int K = g.K, nt = K / BK;
    const size_t kstep = (size_t)(BK * 2);
    const size_t hA = (size_t)HALF * g.lda * 2, hB = (size_t)HALF * g.ldb * 2;
    const unsigned ldsw = (unsigned)wid * 1024u;
    unsigned voffA[2], voffB[2]; int aoff, boff;
#define PG8_LANESETUP() do { const int lane_ = lane_id(), tid_ = wid * 64 + lane_; \
        _Pragma("unroll") for (int i = 0; i < 2; ++i) { int R, C; stage_rc(tid_ * 16 + i * 8192, R, C); const int Rb = Epi::PERM ? ((R & ~31) + perm32(R & 31)) : R; \
            voffA[i] = (unsigned)(R * g.lda + C) * 2u; voffB[i] = (unsigned)(Rb * g.ldb + C) * 2u; } \
        aoff = lds_byte(wr * 64 + (lane_ & 15), (lane_ >> 4) * 8); boff = lds_byte(wc * 32 + (lane_ & 15), (lane_ >> 4) * 8); } while (0)
    PG8_LANESETUP();
#define PG8_SA(b, h) (((b) * 2 + (h)) * HTB)
#define PG8_SB(b, h) ((4 + (b) * 2 + (h)) * HTB)
#define PG8_STAGE(bufoff, gbase, voff) do { _Pragma("unroll") for (int _i = 0; _i < 2; ++_i) \
        __builtin_amdgcn_global_load_lds((const unsigned*)((const char*)(gbase) + (voff)[_i]), (LAS unsigned*)(lds + (bufoff) + ldsw + _i * 8192), 16, 0, 0); } while (0)
#define PG8_LDA(dst, b, h) do { _Pragma("unroll") for (int m = 0; m < 4; ++m) _Pragma("unroll") for (int k = 0; k < 2; ++k) dst[m][k] = *(const LAS bf16x8*)(lds + PG8_SA(b, h) + aoff + m * 2048 + k * 1024); } while (0)
#define PG8_LDB(dst, b, h) do { _Pragma("unroll") for (int n = 0; n < 2; ++n) _Pragma("unroll") for (int k = 0; k < 2; ++k) dst[n][k] = *(const LAS bf16x8*)(lds + PG8_SB(b, h) + boff + n * 2048 + k * 1024); } while (0)
#define PG8_MMA(ai, bj, At, Bt) do { __builtin_amdgcn_s_setprio(1); _Pragma("unroll") for (int m = 0; m < 4; ++m) _Pragma("unroll") for (int n = 0; n < 2; ++n) _Pragma("unroll") for (int k = 0; k < 2; ++k) \
        acc[ai][bj][m][n] = __builtin_amdgcn_mfma_f32_16x16x32_bf16(Bt[n][k], At[m][k], acc[ai][bj][m][n], 0, 0, 0); __builtin_amdgcn_s_setprio(0); } while (0)
#define PG8_WAIT_V(n) asm volatile("s_waitcnt vmcnt(" #n ")" ::: "memory")
#define PG8_WAIT_L(n) asm volatile("s_waitcnt lgkmcnt(" #n ")" ::: "memory")
#define PG8_BAR __builtin_amdgcn_s_barrier()
#define PG8_SCHED __builtin_amdgcn_sched_barrier(0)
    Unit cur, nxt; int ui = 0;
    if (!S.next(0, cur)) return;
    Acc acc;
#pragma unroll
    for (int a = 0; a < 2; ++a)
#pragma unroll
        for (int b = 0; b < 2; ++b)
#pragma unroll
            for (int m = 0; m < 4; ++m)
#pragma unroll
                for (int n = 0; n < 2; ++n) acc[a][b][m][n] = (f32x4){0.f, 0.f, 0.f, 0.f};
    bf16x8 At[4][2], B0[2][2], B1[2][2];
#define PG8_APTR(u) ((const char*)g.A + ((size_t)((u).z / g.nh) * g.sAb + (size_t)((u).z % g.nh) * g.sAh + (size_t)(u).pm * BM * g.lda) * 2)
#define PG8_BPTR(u) ((const char*)g.Bt + ((size_t)((u).z / g.nh) * g.sBb + (size_t)((u).z % g.nh) * g.sBh + (size_t)(u).pn * BM * g.ldb) * 2)
    const char* cA = PG8_APTR(cur); const char* cB = PG8_BPTR(cur);
#if PG8_SP2
    PG8_STAGE(PG8_SB(0, 0), cB, voffB); PG8_STAGE(PG8_SB(0, 1), cB + hB, voffB); PG8_STAGE(PG8_SA(0, 0), cA, voffA); PG8_STAGE(PG8_SA(0, 1), cA + hA, voffA);
    if (wr == 1) PG8_BAR;
    PG8_WAIT_V(2); PG8_BAR;
    PG8_STAGE(PG8_SB(1, 0), cB + kstep, voffB); PG8_STAGE(PG8_SA(1, 0), cA + kstep, voffA); PG8_STAGE(PG8_SB(1, 1), cB + hB + kstep, voffB);
    PG8_WAIT_V(6); PG8_BAR;
#else
    PG8_STAGE(PG8_SB(0, 0), cB, voffB); PG8_STAGE(PG8_SA(0, 0), cA, voffA); PG8_STAGE(PG8_SB(0, 1), cB + hB, voffB); PG8_STAGE(PG8_SA(0, 1), cA + hA, voffA);
    if (wr == 1) PG8_BAR;
    PG8_WAIT_V(4); PG8_BAR;
    PG8_STAGE(PG8_SB(1, 0), cB + kstep, voffB); PG8_STAGE(PG8_SA(1, 0), cA + kstep, voffA); PG8_STAGE(PG8_SB(1, 1), cB + hB + kstep, voffB);
    PG8_WAIT_V(6); PG8_BAR;
#endif
    for (;;) {
        const bool has_next = S.next(ui + 1, nxt);
        const char* nA = has_next ? PG8_APTR(nxt) : cA; const char* nB = has_next ? PG8_BPTR(nxt) : cB;
        for (int t = 0; t < nt; t += 2) {
            const bool last = (t == nt - 2);
            const char* a1 = cA + (size_t)(t + 1) * kstep;
            const char* a2 = last ? nA : cA + (size_t)(t + 2) * kstep; const char* b2 = last ? nB : cB + (size_t)(t + 2) * kstep;
            const char* a3 = a2 + kstep; const char* b3 = b2 + kstep;
#if PG8_SP2
            PG8_LDB(B0, 0, 0); PG8_LDB(B1, 0, 1); PG8_SCHED; PG8_LDA(At, 0, 0); PG8_STAGE(PG8_SA(1, 1), a1 + hA, voffA);
            PG8_WAIT_V(8); PG8_WAIT_L(0); PG8_BAR; PG8_MMA(0, 0, At, B0); PG8_MMA(0, 1, At, B1); PG8_BAR; PG8_SCHED;
            PG8_LDA(At, 0, 1); PG8_STAGE(PG8_SB(0, 0), b2, voffB); PG8_STAGE(PG8_SB(0, 1), b2 + hB, voffB); PG8_STAGE(PG8_SA(0, 0), a2, voffA);
            PG8_WAIT_V(8); PG8_WAIT_L(0); PG8_BAR; PG8_MMA(1, 0, At, B0); PG8_MMA(1, 1, At, B1); PG8_BAR; PG8_SCHED;
            PG8_LDB(B0, 1, 0); PG8_LDB(B1, 1, 1); PG8_SCHED; PG8_LDA(At, 1, 0); PG8_STAGE(PG8_SA(0, 1), a2 + hA, voffA);
            PG8_WAIT_V(8); PG8_WAIT_L(0); PG8_BAR; PG8_MMA(0, 0, At, B0); PG8_MMA(0, 1, At, B1); PG8_BAR; PG8_SCHED;
            PG8_LDA(At, 1, 1); PG8_STAGE(PG8_SB(1, 0), b3, voffB); PG8_STAGE(PG8_SB(1, 1), b3 + hB, voffB); PG8_STAGE(PG8_SA(1, 0), a3, voffA);
            PG8_WAIT_V(8); PG8_WAIT_L(0); PG8_BAR; PG8_MMA(1, 0, At, B0); PG8_MMA(1, 1, At, B1); PG8_BAR; PG8_SCHED;
#else
            PG8_LDB(B0, 0, 0); PG8_SCHED; PG8_LDA(At, 0, 0); PG8_STAGE(PG8_SA(1, 1), a1 + hA, voffA);
            PG8_WAIT_L(8); PG8_BAR; PG8_WAIT_L(0); PG8_MMA(0, 0, At, B0); PG8_BAR; PG8_SCHED;
            PG8_LDB(B1, 0, 1); PG8_STAGE(PG8_SB(0, 0), b2, voffB);
            PG8_BAR; PG8_WAIT_L(0); PG8_MMA(0, 1, At, B1); PG8_BAR;
            PG8_LDA(At, 0, 1); PG8_STAGE(PG8_SA(0, 0), a2, voffA);
            PG8_BAR; PG8_WAIT_L(0); PG8_MMA(1, 0, At, B0); PG8_BAR; PG8_SCHED;
            PG8_STAGE(PG8_SB(0, 1), b2 + hB, voffB);
            PG8_WAIT_V(6); PG8_BAR; PG8_MMA(1, 1, At, B1); PG8_BAR;
            PG8_LDB(B0, 1, 0); PG8_SCHED; PG8_LDA(At, 1, 0); PG8_STAGE(PG8_SA(0, 1), a2 + hA, voffA);
            PG8_WAIT_L(8); PG8_BAR; PG8_WAIT_L(0); PG8_MMA(0, 0, At, B0); PG8_BAR; PG8_SCHED;
            PG8_LDB(B1, 1, 1); PG8_STAGE(PG8_SB(1, 0), b3, voffB);
            PG8_BAR; PG8_WAIT_L(0); PG8_MMA(0, 1, At, B1); PG8_BAR;
            PG8_LDA(At, 1, 1); PG8_STAGE(PG8_SA(1, 0), a3, voffA);
            PG8_BAR; PG8_WAIT_L(0); PG8_MMA(1, 0, At, B0); PG8_BAR; PG8_SCHED;
            PG8_STAGE(PG8_SB(1, 1), b3 + hB, voffB);
            PG8_WAIT_V(6); PG8_BAR; PG8_MMA(1, 1, At, B1); PG8_BAR;
#endif
        }
        if (wr == 0) PG8_BAR;
        { const int le_ = lane_id(); E(acc, cur, wr, wc, le_ & 15, le_ >> 4); }
        if (!has_next) break;
#pragma unroll
        for (int a = 0; a < 2; ++a)
#pragma unroll
            for (int b = 0; b < 2; ++b)
#pragma unroll
                for (int m = 0; m < 4; ++m)
#pragma unroll
                    for (int n = 0; n < 2; ++n) acc[a][b][m][n] = (f32x4){0.f, 0.f, 0.f, 0.f};
        cur = nxt; cA = nA; cB = nB; ++ui;
        PG8_LANESETUP();
        if (wr == 1) PG8_BAR;
    }
    PG8_WAIT_V(0);
    PG8_BAR;
#undef PG8_LANESETUP
#undef PG8_APTR
#undef PG8_BPTR
#undef PG8_SA
#undef PG8_SB
#undef PG8_STAGE
#undef PG8_LDA
#undef PG8_LDB
#undef PG8_MMA
#undef PG8_WAIT_V
#undef PG8_WAIT_L
#undef PG8_BAR
#undef PG8_SCHED
}

__device__ __forceinline__ u32x4 pack8(const f32x4 v0, const f32x4 v1) { u32x4 w; w.x = cvt_pk_bf16(v0[0], v0[1]); w.y = cvt_pk_bf16(v0[2], v0[3]); w.z = cvt_pk_bf16(v1[0], v1[1]); w.w = cvt_pk_bf16(v1[2], v1[3]); return w; }

struct EpiBf16 {
    static constexpr bool PERM = true;
    bf16_t* O; int ldc; float scale; int nh; long sb, sh; const float* rss; float rinv;
    __device__ __forceinline__ void operator()(const Acc& acc, const Unit& u, int wr, int wc, int fr, int fq) const {
        bf16_t* base = O + (size_t)(u.z / nh) * sb + (size_t)(u.z % nh) * sh;
        const int row0 = u.pm * BM + wr * 64 + fr, col0 = u.pn * BM + wc * 32 + 8 * fq;
#pragma unroll
        for (int ai = 0; ai < 2; ++ai)
#pragma unroll
            for (int m = 0; m < 4; ++m) { const int row = row0 + ai * HALF + m * 16; float sc = scale; if (rss) sc *= rsqrtf(rss[row] * rinv + RMS_EPS);
                bf16_t* rowp = base + (size_t)row * ldc + col0;
#pragma unroll
                for (int bj = 0; bj < 2; ++bj) *(u32x4*)(rowp + bj * HALF) = pack8(acc[ai][bj][m][0] * sc, acc[ai][bj][m][1] * sc); }
    }
};
template <size_t O_OFF, int ldc, size_t RS_OFF, size_t SV_OFF, size_t CV_OFF> struct EpiBf16LN {
    static constexpr bool PERM = true;
    unsigned char* wsb; float scale;
    __device__ __forceinline__ void operator()(const Acc& acc, const Unit& u, int wr, int wc, int fr, int fq) const {
        bf16_t* O = (bf16_t*)(wsb + O_OFF); const float* rs = (const float*)(wsb + RS_OFF); const float* sv = (const float*)(wsb + SV_OFF); const float* cv = (const float*)(wsb + CV_OFF);
        const int row0 = u.pm * BM + wr * 64 + fr, col0 = u.pn * BM + wc * 32 + 8 * fq;
        f32x2 st[2][4]; f32x4 s4[2][2], c4[2][2];
#pragma unroll
        for (int ai = 0; ai < 2; ++ai)
#pragma unroll
            for (int m = 0; m < 4; ++m) st[ai][m] = *(const f32x2*)(rs + (size_t)(row0 + ai * HALF + m * 16) * 2);
#pragma unroll
        for (int bj = 0; bj < 2; ++bj)
#pragma unroll
            for (int n = 0; n < 2; ++n) { s4[bj][n] = *(const f32x4*)(sv + col0 + bj * HALF + 4 * n); c4[bj][n] = *(const f32x4*)(cv + col0 + bj * HALF + 4 * n); }
        asm volatile("" ::: "memory");
#pragma unroll
        for (int ai = 0; ai < 2; ++ai)
#pragma unroll
            for (int m = 0; m < 4; ++m) { const int row = row0 + ai * HALF + m * 16; const float mean = st[ai][m].x * (1.0f / D), rstd = rsqrtf(st[ai][m].y * (1.0f / D) - mean * mean + LN_EPS) * scale;
                bf16_t* rowp = O + (size_t)row * ldc + col0;
#pragma unroll
                for (int bj = 0; bj < 2; ++bj) *(u32x4*)(rowp + bj * HALF) = pack8((acc[ai][bj][m][0] - s4[bj][0] * mean) * rstd + c4[bj][0] * scale, (acc[ai][bj][m][1] - s4[bj][1] * mean) * rstd + c4[bj][1] * scale); }
    }
};
struct EpiF32 {
    static constexpr bool PERM = false;
    float* C; int ldc; int nh; long sb, sh;
    __device__ __forceinline__ void operator()(const Acc& acc, const Unit& u, int wr, int wc, int fr, int fq) const {
        float* base = C + (size_t)(u.z / nh) * sb + (size_t)(u.z % nh) * sh;
        const int row0 = u.pm * BM + wr * 64 + fr, col0 = u.pn * BM + wc * 32 + 4 * fq;
#pragma unroll
        for (int ai = 0; ai < 2; ++ai)
#pragma unroll
            for (int m = 0; m < 4; ++m) { float* rowp = base + (size_t)(row0 + ai * HALF + m * 16) * ldc + col0;
#pragma unroll
                for (int bj = 0; bj < 2; ++bj)
#pragma unroll
                    for (int n = 0; n < 2; ++n) *(f32x4*)(rowp + bj * HALF + n * 16) = acc[ai][bj][m][n]; }
    }
};
__device__ __forceinline__ void row_stat_add(float* rs, int row, float s_, float q_, int fq) {
    s_ += __shfl_xor(s_, 16); s_ += __shfl_xor(s_, 32); q_ += __shfl_xor(q_, 16); q_ += __shfl_xor(q_, 32);
    if (fq < 2) atomicAdd(rs + (size_t)row * 2 + fq, fq == 0 ? s_ : q_);
}
template <size_t ZB_OFF, size_t RS_OFF> struct EpiResStat {
    static constexpr bool PERM = true;
    unsigned char* wsb; const float* base;
    __device__ __forceinline__ void operator()(const Acc& acc, const Unit& u, int wr, int wc, int fr, int fq) const {
        bf16_t* ZB = (bf16_t*)(wsb + ZB_OFF); float* rs = (float*)(wsb + RS_OFF);
        const int row0 = u.pm * BM + wr * 64 + fr, col0 = u.pn * BM + wc * 32 + 8 * fq;
#pragma unroll
        for (int ah = 0; ah < 4; ++ah) { const int ai = ah >> 1, mh = ah & 1; f32x4 bs[2][2][2];
#pragma unroll
            for (int ml = 0; ml < 2; ++ml)
#pragma unroll
                for (int bj = 0; bj < 2; ++bj)
#pragma unroll
                    for (int n = 0; n < 2; ++n) bs[ml][bj][n] = *(const f32x4*)(base + (size_t)(row0 + ai * HALF + (2 * mh + ml) * 16) * D + col0 + bj * HALF + 4 * n);
            asm volatile("" ::: "memory");
#pragma unroll
            for (int ml = 0; ml < 2; ++ml) { const int m = 2 * mh + ml, row = row0 + ai * HALF + m * 16; const size_t off = (size_t)row * D + col0; float s_ = 0.f, q_ = 0.f;
#pragma unroll
                for (int bj = 0; bj < 2; ++bj) { f32x4 z[2];
#pragma unroll
                    for (int n = 0; n < 2; ++n) { z[n] = bs[ml][bj][n] * ALPHA + acc[ai][bj][m][n];
                        s_ += (z[n][0] + z[n][1]) + (z[n][2] + z[n][3]); q_ += (z[n][0] * z[n][0] + z[n][1] * z[n][1]) + (z[n][2] * z[n][2] + z[n][3] * z[n][3]); }
                    *(u32x4*)(ZB + off + bj * HALF) = pack8(z[0], z[1]); }
                row_stat_add(rs, row, s_, q_, fq); }
            asm volatile("" ::: "memory"); }
    }
};
template <size_t ZB_OFF, size_t RSIN_OFF, size_t RSOUT_OFF, bool STATS, int ZR = 0> struct EpiResLN {
    static constexpr bool PERM = true;
    unsigned char* wsb; const float* g; const float* b;
    __device__ __forceinline__ void operator()(const Acc& acc, const Unit& u, int wr, int wc, int fr, int fq) const {
        bf16_t* ZB = (bf16_t*)(wsb + ZB_OFF); const float* rsin = (const float*)(wsb + RSIN_OFF); float* rsout = (float*)(wsb + RSOUT_OFF);
        const int row0 = u.z * ZR + u.pm * BM + wr * 64 + fr, col0 = u.pn * BM + wc * 32 + 8 * fq;
        f32x4 g4[2][2], b4[2][2];
#pragma unroll
        for (int bj = 0; bj < 2; ++bj)
#pragma unroll
            for (int n = 0; n < 2; ++n) { g4[bj][n] = *(const f32x4*)(g + col0 + bj * HALF + 4 * n); b4[bj][n] = *(const f32x4*)(b + col0 + bj * HALF + 4 * n); }
#pragma unroll
        for (int ah = 0; ah < 4; ++ah) { const int ai = ah >> 1, mh = ah & 1; u32x4 zw[2][2]; f32x2 st[2];
#pragma unroll
            for (int ml = 0; ml < 2; ++ml) { const size_t row = (size_t)(row0 + ai * HALF + (2 * mh + ml) * 16); st[ml] = *(const f32x2*)(rsin + row * 2);
#pragma unroll
                for (int bj = 0; bj < 2; ++bj) zw[ml][bj] = *(const u32x4*)(ZB + row * D + col0 + bj * HALF); }
            asm volatile("" ::: "memory");
#pragma unroll
            for (int ml = 0; ml < 2; ++ml) { const int m = 2 * mh + ml, row = row0 + ai * HALF + m * 16; const size_t off = (size_t)row * D + col0; float s_ = 0.f, q_ = 0.f;
                const float mean = st[ml].x * (1.0f / D), rstd = rsqrtf(st[ml].y * (1.0f / D) - mean * mean + LN_EPS);
#pragma unroll
                for (int bj = 0; bj < 2; ++bj) { const u32x4 w_ = zw[ml][bj]; f32x4 z[2];
                    const f32x4 zo0 = {bf_lo(w_.x), bf_hi(w_.x), bf_lo(w_.y), bf_hi(w_.y)}, zo1 = {bf_lo(w_.z), bf_hi(w_.z), bf_lo(w_.w), bf_hi(w_.w)};
                    z[0] = ((zo0 - mean) * rstd * g4[bj][0] + b4[bj][0]) * ALPHA + acc[ai][bj][m][0]; z[1] = ((zo1 - mean) * rstd * g4[bj][1] + b4[bj][1]) * ALPHA + acc[ai][bj][m][1];
#pragma unroll
                    for (int n = 0; n < 2; ++n) { s_ += (z[n][0] + z[n][1]) + (z[n][2] + z[n][3]); q_ += (z[n][0] * z[n][0] + z[n][1] * z[n][1]) + (z[n][2] * z[n][2] + z[n][3] * z[n][3]); }
                    *(u32x4*)(ZB + off + bj * HALF) = pack8(z[0], z[1]); }
                if (STATS) row_stat_add(rsout, row, s_, q_, fq); }
            asm volatile("" ::: "memory"); }
    }
};
struct EpiGate0 {
    static constexpr bool PERM = true;
    bf16_t* C; const bf16_t* G;
    __device__ __forceinline__ void operator()(const Acc& acc, const Unit& u, int wr, int wc, int fr, int fq) const {
        const int row0 = u.pm * BM + wr * 64 + fr, col0 = u.pn * BM + wc * 32 + 8 * fq;
#pragma unroll
        for (int ai = 0; ai < 2; ++ai) { u32x4 gw[4][2];
#pragma unroll
            for (int m = 0; m < 4; ++m)
#pragma unroll
                for (int bj = 0; bj < 2; ++bj) gw[m][bj] = *(const u32x4*)(G + (size_t)(row0 + ai * HALF + m * 16) * GTP + col0 + bj * HALF);
            asm volatile("" ::: "memory");
#pragma unroll
            for (int m = 0; m < 4; ++m) { const int row = row0 + ai * HALF + m * 16;
#pragma unroll
                for (int bj = 0; bj < 2; ++bj) { const int col = col0 + bj * HALF; const u32x4 g = gw[m][bj];
                    const f32x4 g0 = {bf_lo(g.x), bf_hi(g.x), bf_lo(g.y), bf_hi(g.y)}, g1 = {bf_lo(g.z), bf_hi(g.z), bf_lo(g.w), bf_hi(g.w)};
                    *(u32x4*)(C + (size_t)row * D + col) = pack8(g0 * acc[ai][bj][m][0], g1 * acc[ai][bj][m][1]); } }
            asm volatile("" ::: "memory"); }
    }
};
struct EpiGate1 {
    static constexpr bool PERM = true;
    bf16_t* O; const bf16_t* TMP; const bf16_t* G;
    __device__ __forceinline__ void operator()(const Acc& acc, const Unit& u, int wr, int wc, int fr, int fq) const {
        const int row0 = u.pm * BM + wr * 64 + fr, col0 = u.pn * BM + wc * 32 + 8 * fq;
#pragma unroll
        for (int ah = 0; ah < 4; ++ah) { const int ai = ah >> 1, mh = ah & 1; u32x4 g0w[2][2], g1w[2][2], tw[2][2];
#pragma unroll
            for (int ml = 0; ml < 2; ++ml)
#pragma unroll
                for (int bj = 0; bj < 2; ++bj) { const size_t row = (size_t)(row0 + ai * HALF + (2 * mh + ml) * 16);
                    g0w[ml][bj] = *(const u32x4*)(G + row * GTP + col0 + bj * HALF); g1w[ml][bj] = *(const u32x4*)(G + row * GTP + 4096 + col0 + bj * HALF); tw[ml][bj] = *(const u32x4*)(TMP + row * D + col0 + bj * HALF); }
            asm volatile("" ::: "memory");
#pragma unroll
            for (int ml = 0; ml < 2; ++ml) { const int m = 2 * mh + ml, row = row0 + ai * HALF + m * 16;
#pragma unroll
                for (int bj = 0; bj < 2; ++bj) { const int col = col0 + bj * HALF; const u32x4 ga = g0w[ml][bj], gb = g1w[ml][bj], t = tw[ml][bj];
                    const f32x4 a0 = {bf_lo(ga.x), bf_hi(ga.x), bf_lo(ga.y), bf_hi(ga.y)}, a1 = {bf_lo(ga.z), bf_hi(ga.z), bf_lo(ga.w), bf_hi(ga.w)};
                    const f32x4 b0 = {bf_lo(gb.x), bf_hi(gb.x), bf_lo(gb.y), bf_hi(gb.y)}, b1 = {bf_lo(gb.z), bf_hi(gb.z), bf_lo(gb.w), bf_hi(gb.w)};
                    const f32x4 t0 = {bf_lo(t.x), bf_hi(t.x), bf_lo(t.y), bf_hi(t.y)}, t1 = {bf_lo(t.z), bf_hi(t.z), bf_lo(t.w), bf_hi(t.w)};
                    *(u32x4*)(O + (size_t)row * D + col) = pack8(a0 * t0 + b0 * acc[ai][bj][m][0], a1 * t1 + b1 * acc[ai][bj][m][1]); } }
            asm volatile("" ::: "memory"); }
    }
};
__device__ __forceinline__ unsigned dpp_ror1u(unsigned x)  { return (unsigned)__builtin_amdgcn_update_dpp(0, (int)x, 0x121, 0xf, 0xf, false); }
__device__ __forceinline__ unsigned dpp_ror15u(unsigned x) { return (unsigned)__builtin_amdgcn_update_dpp(0, (int)x, 0x12f, 0xf, 0xf, false); }
template <size_t ACT_OFF, size_t EDGE_OFF, size_t RS_OFF, size_t SV_OFF, size_t CV_OFF, size_t CW_OFF, size_t CB_OFF> struct EpiFfnConv {
    static constexpr bool PERM = true;
    unsigned char* wsb; LAS unsigned* H;
    __device__ __forceinline__ void operator()(const Acc& acc, const Unit& u, int wr, int wc, int fr, int fq) const {
        bf16_t* ACT = (bf16_t*)(wsb + ACT_OFF); unsigned* EDGE = (unsigned*)(wsb + EDGE_OFF);
        const float* rs = (const float*)(wsb + RS_OFF); const float* sv = (const float*)(wsb + SV_OFF); const float* cv = (const float*)(wsb + CV_OFF);
        const float* cw = (const float*)(wsb + CW_OFF); const float* cb = (const float*)(wsb + CB_OFF);
        int frl = fr, colt = wc * 32 + 8 * fq; asm volatile("" : "+v"(frl), "+v"(colt));
        const int row0 = u.pm * BM + wr * 64 + frl;
        u32x2 P[2][2][4][2];
#pragma unroll
        for (int ai = 0; ai < 2; ++ai) { float mean[4], rstd[4];
#pragma unroll
            for (int m = 0; m < 4; ++m) { const f32x2 st = *(const f32x2*)(rs + (size_t)(row0 + ai * HALF + m * 16) * 2); mean[m] = st.x * (1.0f / D); rstd[m] = rsqrtf(st.y * (1.0f / D) - mean[m] * mean[m] + LN_EPS); }
#pragma unroll
            for (int bj = 0; bj < 2; ++bj) { f32x4 s4[2], c4[2];
#pragma unroll
                for (int n = 0; n < 2; ++n) { s4[n] = *(const f32x4*)(sv + u.pn * BM + bj * HALF + colt + 4 * n); c4[n] = *(const f32x4*)(cv + u.pn * BM + bj * HALF + colt + 4 * n); }
#pragma unroll
                for (int m = 0; m < 4; ++m)
#pragma unroll
                    for (int n = 0; n < 2; ++n) { const f32x4 v = (acc[ai][bj][m][n] - s4[n] * mean[m]) * rstd[m] + c4[n]; P[ai][bj][m][n].x = cvt_pk_bf16(v[0], v[1]); P[ai][bj][m][n].y = cvt_pk_bf16(v[2], v[3]); }
                __builtin_amdgcn_sched_barrier(0); } }
        if (frl == 0 || frl == 15) { const int tb = frl == 15 ? 1 : 0;
#pragma unroll
            for (int ai = 0; ai < 2; ++ai)
#pragma unroll
                for (int bj = 0; bj < 2; ++bj)
#pragma unroll
                    for (int n = 0; n < 2; ++n) { const int hp = (bj * HALF + colt + 4 * n) >> 1, blk = 2 * ai + wr; const unsigned mk = 0u - (unsigned)tb; u32x2 v; v.x = (P[ai][bj][0][n].x & ~mk) | (P[ai][bj][3][n].x & mk); v.y = (P[ai][bj][0][n].y & ~mk) | (P[ai][bj][3][n].y & mk);
                        *(LAS u32x2*)(H + (blk * 2 + tb) * 128 + hp) = v; } }
        if (wr == 0 ? frl < 2 : frl >= 14) { const int e = wr == 0 ? frl : frl - 12;
#pragma unroll
            for (int bj = 0; bj < 2; ++bj)
#pragma unroll
                for (int n = 0; n < 2; ++n) { const int hp = (bj * HALF + colt + 4 * n) >> 1; const unsigned mk = wr == 0 ? 0u : ~0u; u32x2 v; v.x = (P[0][bj][0][n].x & ~mk) | (P[1][bj][3][n].x & mk); v.y = (P[0][bj][0][n].y & ~mk) | (P[1][bj][3][n].y & mk);
                    *(u32x2*)(EDGE + (size_t)(u.pm * 4 + e) * (DFF2 / 2) + u.pn * (BM / 2) + hp) = v; } }
        asm volatile("s_waitcnt lgkmcnt(0)" ::: "memory"); __builtin_amdgcn_s_barrier(); asm volatile("" ::: "memory");
#pragma unroll
        for (int n = 0; n < 2; ++n) {
            f32x4 W[2][4];
#pragma unroll
            for (int bj = 0; bj < 2; ++bj) { const int c_ = bj * DFF + u.pn * 128 + colt + 4 * n;
                W[bj][0] = *(const f32x4*)(cw + c_); W[bj][1] = *(const f32x4*)(cw + DFF2 + c_); W[bj][2] = *(const f32x4*)(cw + 2 * (size_t)DFF2 + c_); W[bj][3] = *(const f32x4*)(cb + c_); }
            asm volatile("" ::: "memory");
#pragma unroll
            for (int ai = 0; ai < 2; ++ai) { int frb = frl, colb = colt; asm volatile("" : "+v"(frb), "+v"(colb));
                const int ch = u.pn * 128 + colb + 4 * n, blk = 2 * ai + wr, bup = blk > 0 ? blk - 1 : 0, bdn = blk < 3 ? blk + 1 : 3;
                const bool first = frb == 0, lastl = frb == 15;
                u32x2 ht[2], hb[2];
#pragma unroll
                for (int bj = 0; bj < 2; ++bj) { const int hp = (bj * HALF + colb + 4 * n) >> 1; ht[bj] = *(const LAS u32x2*)(H + (bup * 2 + 1) * 128 + hp); hb[bj] = *(const LAS u32x2*)(H + (bdn * 2 + 0) * 128 + hp); }
                unsigned wlo[4];
#pragma unroll
                for (int jp = 0; jp < 2; ++jp) { float cu0[4], cu1[4];
#pragma unroll
                    for (int bj = 0; bj < 2; ++bj) {
                        const f32x2 w0 = {W[bj][0][2 * jp], W[bj][0][2 * jp + 1]}, w1 = {W[bj][1][2 * jp], W[bj][1][2 * jp + 1]}, w2 = {W[bj][2][2 * jp], W[bj][2][2 * jp + 1]}, bb = {W[bj][3][2 * jp], W[bj][3][2 * jp + 1]};
                        unsigned a[4], b[4];
#pragma unroll
                        for (int m = 0; m < 4; ++m) { a[m] = dpp_ror1u(P[ai][bj][m][n][jp]); b[m] = dpp_ror15u(P[ai][bj][m][n][jp]); }
#pragma unroll
                        for (int m = 0; m < 4; ++m) { const unsigned xc = P[ai][bj][m][n][jp];
                            const unsigned pv = first ? (m > 0 ? a[m > 0 ? m - 1 : 0] : ht[bj][jp]) : a[m];
                            const unsigned nx = lastl ? (m < 3 ? b[m < 3 ? m + 1 : 3] : hb[bj][jp]) : b[m];
                            const float r0 = bf_lo(pv) * w0[0] + bf_lo(xc) * w1[0] + bf_lo(nx) * w2[0] + bb[0];
                            const float r1 = bf_hi(pv) * w0[1] + bf_hi(xc) * w1[1] + bf_hi(nx) * w2[1] + bb[1];
                            if (bj == 0) { cu0[m] = r0; cu1[m] = r1; }
                            else { cu0[m] = siluf_(r0) * cu0[m]; cu1[m] = siluf_(r1) * cu1[m]; } } }
#pragma unroll
                    for (int m = 0; m < 4; ++m) { const unsigned w_ = cvt_pk_bf16(cu0[m], cu1[m]);
                        if (jp == 0) wlo[m] = w_;
                        else { const int rt = ai * HALF + wr * 64 + m * 16 + frb; u32x2 w; w.x = wlo[m]; w.y = w_;
                               *(u32x2*)(ACT + (size_t)(u.pm * BM + rt) * DFF + ch) = w; } } }
                asm volatile("" ::: "memory"); __builtin_amdgcn_sched_barrier(0); } }
    }
};
struct EpiRetS {
    static constexpr bool PERM = true;
    bf16_t* O; const float* dec;
    __device__ __forceinline__ void operator()(const Acc& acc, const Unit& u, int wr, int wc, int fr, int fq) const {
        const int h = u.z & 7; const float lf = dec[h], lb = dec[8 + h];
        bf16_t* base = O + (size_t)u.z * SEQ * SEQ;
        int frl = fr, cwl = wc * 32 + 8 * fq; asm volatile("" : "+v"(frl), "+v"(cwl));
        const int rl0 = wr * 64 + frl, row0 = u.pm * BM + rl0, col0 = u.pn * BM + cwl;
        if (u.pm != u.pn) {
            const bool below = u.pm > u.pn; const float lg = below ? lf : lb;
            const float cb0 = below ? (float)((u.pm - u.pn) * BM) : (float)((u.pn - u.pm) * BM - 255);
            float R[2][4]; f32x4 C[2][2];
#pragma unroll
            for (int ai = 0; ai < 2; ++ai)
#pragma unroll
                for (int m = 0; m < 4; ++m) { const float r_ = (float)(rl0 + ai * HALF + m * 16); R[ai][m] = __builtin_amdgcn_exp2f((below ? r_ : 255.0f - r_) * lg); }
#pragma unroll
            for (int bj = 0; bj < 2; ++bj)
#pragma unroll
                for (int n = 0; n < 2; ++n)
#pragma unroll
                    for (int j = 0; j < 4; ++j) { const float c_ = (float)(cwl + bj * HALF + 4 * n + j); C[bj][n][j] = __builtin_amdgcn_exp2f((below ? cb0 - c_ : cb0 + c_) * lg); }
#pragma unroll
            for (int ai = 0; ai < 2; ++ai)
#pragma unroll
                for (int m = 0; m < 4; ++m) { const int row = row0 + ai * HALF + m * 16;
#pragma unroll
                    for (int bj = 0; bj < 2; ++bj) *(u32x4*)(base + (size_t)row * SEQ + col0 + bj * HALF) = pack8(acc[ai][bj][m][0] * C[bj][0] * R[ai][m], acc[ai][bj][m][1] * C[bj][1] * R[ai][m]); }
        } else {
#pragma unroll
            for (int ai = 0; ai < 2; ++ai)
#pragma unroll
                for (int m = 0; m < 4; ++m) { const int row = row0 + ai * HALF + m * 16;
#pragma unroll
                    for (int bj = 0; bj < 2; ++bj) { const int col = col0 + bj * HALF; f32x4 v[2];
#pragma unroll
                        for (int n = 0; n < 2; ++n)
#pragma unroll
                            for (int j = 0; j < 4; ++j) { const int dd = row - (col + 4 * n + j); const float e = dd >= 0 ? (float)dd * lf : (float)(-dd) * lb; v[n][j] = acc[ai][bj][m][n][j] * __builtin_amdgcn_exp2f(e); }
                        *(u32x4*)(base + (size_t)row * SEQ + col) = pack8(v[0], v[1]); } }
        }
    }
};
struct EpiQ {
    static constexpr bool PERM = true;
    bf16_t* Q; const float* rss; const int* pos;
    __device__ __forceinline__ void operator()(const Acc& acc, const Unit& u, int wr, int wc, int fr, int fq) const {
        const int row0 = u.pm * BM + wr * 64 + fr;
        float rs[2][4]; int ps[2][4];
#pragma unroll
        for (int ai = 0; ai < 2; ++ai)
#pragma unroll
            for (int m = 0; m < 4; ++m) { rs[ai][m] = rss[row0 + ai * HALF + m * 16]; ps[ai][m] = pos[row0 + ai * HALF + m * 16]; }
        asm volatile("" ::: "memory");
        if (u.pn < 8) {
#pragma unroll
            for (int ai = 0; ai < 2; ++ai)
#pragma unroll
                for (int m = 0; m < 4; ++m) { const int row = row0 + ai * HALF + m * 16; const float sc = rsqrtf(rs[ai][m] * (1.0f / 1024.0f) + RMS_EPS); bf16_t* qrow = Q + (size_t)row * 3072;
#pragma unroll
                    for (int bj = 0; bj < 2; ++bj) *(u32x4*)(qrow + (2 * u.pn + bj) * 192 + wc * 32 + 8 * fq) = pack8(acc[ai][bj][m][0] * sc, acc[ai][bj][m][1] * sc); }
        } else {
            const int head = 4 * (u.pn - 8) + wc; float invr[8]; int fql = fq; asm volatile("" : "+v"(fql));
#pragma unroll
            for (int i = 0; i < 8; ++i) invr[i] = rope_invr(8 * fql + i, 1.0f / 32.0f);
#pragma unroll
            for (int ai = 0; ai < 2; ++ai)
#pragma unroll
                for (int m = 0; m < 4; ++m) { const int row = row0 + ai * HALF + m * 16; const float sc = rsqrtf(rs[ai][m] * (1.0f / 1024.0f) + RMS_EPS), pf = (float)ps[ai][m]; bf16_t* qrow = Q + (size_t)row * 3072; f32x4 o1[2], o2[2];
#pragma unroll
                    for (int n = 0; n < 2; ++n)
#pragma unroll
                        for (int j = 0; j < 4; ++j) { float c, sn; rope_cs(pf, invr[4 * n + j], c, sn); const float t1 = acc[ai][0][m][n][j] * sc, t2 = acc[ai][1][m][n][j] * sc; o1[n][j] = t1 * c - t2 * sn; o2[n][j] = t2 * c + t1 * sn; }
                    *(u32x4*)(qrow + head * 192 + 128 + 8 * fq) = pack8(o1[0], o1[1]); *(u32x4*)(qrow + head * 192 + 160 + 8 * fq) = pack8(o2[0], o2[1]); }
        }
    }
};
struct EpiProj {
    static constexpr bool PERM = true;
    bf16_t *CQ, *CKV, *KPE, *RQ, *RK, *RVT, *RG, *GT; float* rss; const int* pos; const float* gbias; LAS unsigned char* lds;
    __device__ __forceinline__ void operator()(const Acc& acc, const Unit& u, int wr, int wc, int fr, int fq) const {
        int fql = fq; asm volatile("" : "+v"(fql));
        const int pn = u.pn, row0 = u.pm * BM + wr * 64 + fr, cw = wc * 32 + 8 * fq, cwl = wc * 32 + 8 * fql;
        if (pn < 6) {
            bf16_t* O = pn < 4 ? CQ : CKV; const int ldc = pn < 4 ? 1024 : 512, colt = pn < 4 ? pn * BM : (pn - 4) * BM; float* ss = rss + (pn < 4 ? 0 : T);
#pragma unroll
            for (int ai = 0; ai < 2; ++ai)
#pragma unroll
                for (int m = 0; m < 4; ++m) { const int row = row0 + ai * HALF + m * 16; float s = 0.f;
#pragma unroll
                    for (int bj = 0; bj < 2; ++bj) { const f32x4 a = acc[ai][bj][m][0], b = acc[ai][bj][m][1];
                        s += (a[0] * a[0] + a[1] * a[1]) + (a[2] * a[2] + a[3] * a[3]) + (b[0] * b[0] + b[1] * b[1]) + (b[2] * b[2] + b[3] * b[3]);
                        *(u32x4*)(O + (size_t)row * ldc + colt + bj * HALF + cw) = pack8(a, b); }
                    s += __shfl_xor(s, 16); s += __shfl_xor(s, 32);
                    if (fq == 0) atomicAdd(ss + row, s); }
        } else if (pn == 6) {
            if (wc == 0) {
                int ps[2][4]; float invr[8];
#pragma unroll
                for (int ai = 0; ai < 2; ++ai)
#pragma unroll
                    for (int m = 0; m < 4; ++m) ps[ai][m] = pos[row0 + ai * HALF + m * 16];
                asm volatile("" ::: "memory");
#pragma unroll
                for (int i = 0; i < 8; ++i) invr[i] = rope_invr(8 * fql + i, 1.0f / 32.0f);
#pragma unroll
                for (int ai = 0; ai < 2; ++ai)
#pragma unroll
                    for (int m = 0; m < 4; ++m) { const int row = row0 + ai * HALF + m * 16; const float pf = (float)ps[ai][m]; f32x4 o1[2], o2[2];
#pragma unroll
                        for (int n = 0; n < 2; ++n)
#pragma unroll
                            for (int j = 0; j < 4; ++j) { float c, sn; rope_cs(pf, invr[4 * n + j], c, sn); const float t1 = acc[ai][0][m][n][j], t2 = acc[ai][1][m][n][j]; o1[n][j] = t1 * c - t2 * sn; o2[n][j] = t2 * c + t1 * sn; }
                        *(u32x4*)(KPE + (size_t)row * 64 + 8 * fq) = pack8(o1[0], o1[1]); *(u32x4*)(KPE + (size_t)row * 64 + 32 + 8 * fq) = pack8(o2[0], o2[1]); }
            }
        } else if (pn < 23) {
            const bool isk = pn >= 15; const int head = isk ? pn - 15 : pn - 7; bf16_t* O = isk ? RK : RQ; const float sc = isk ? 0.0625f : 1.0f;
            int ps[2][4]; float invr[8];
#pragma unroll
            for (int ai = 0; ai < 2; ++ai)
#pragma unroll
                for (int m = 0; m < 4; ++m) ps[ai][m] = pos[row0 + ai * HALF + m * 16];
            asm volatile("" ::: "memory");
#pragma unroll
            for (int i = 0; i < 8; ++i) invr[i] = rope_invr(cwl + i, 1.0f / 128.0f);
#pragma unroll
            for (int ai = 0; ai < 2; ++ai)
#pragma unroll
                for (int m = 0; m < 4; ++m) { const int row = row0 + ai * HALF + m * 16; const float pf = (float)ps[ai][m]; f32x4 o1[2], o2[2];
#pragma unroll
                    for (int n = 0; n < 2; ++n)
#pragma unroll
                        for (int j = 0; j < 4; ++j) { float c, sn; rope_cs(pf, invr[4 * n + j], c, sn); const float t1 = acc[ai][0][m][n][j] * sc, t2 = acc[ai][1][m][n][j] * sc; o1[n][j] = t1 * c - t2 * sn; o2[n][j] = t2 * c + t1 * sn; }
                    bf16_t* op = O + (size_t)row * 2048 + head * 256 + cw;
                    *(u32x4*)op = pack8(o1[0], o1[1]); *(u32x4*)(op + 128) = pack8(o2[0], o2[1]); }
        } else if (pn < 39) {
            const int t = pn - 23, head = t >> 1, e0 = (t & 1) * 256, lane = fq * 16 + fr;
            LAS unsigned char* tb = lds + TR_OFF + (wr * 4 + wc) * 2048;
            const int b = (u.pm * BM) >> 11, s0 = (u.pm * BM) & 2047;
#pragma unroll
            for (int ai = 0; ai < 2; ++ai)
#pragma unroll
                for (int bj = 0; bj < 2; ++bj)
#pragma unroll
                    for (int n = 0; n < 2; ++n) {
#pragma unroll
                        for (int m = 0; m < 4; ++m)
#pragma unroll
                            for (int j = 0; j < 4; ++j) { const unsigned w = cvt_pk_bf16(acc[ai][bj][m][n][j], 0.f); *(LAS bf16_t*)(tb + (4 * fq + j) * 128 + (16 * m + fr) * 2) = (bf16_t)(w & 0xffffu); }
#pragma unroll
                        for (int i = 0; i < 2; ++i) { const int q = lane + 64 * i, lc = q >> 3, rc = q & 7; const u32x4 v = *(const LAS u32x4*)(tb + lc * 128 + rc * 16);
                            const int e = e0 + bj * HALF + wc * 32 + 8 * (lc >> 2) + 4 * n + (lc & 3), sp = s0 + ai * HALF + wr * 64 + rc * 8;
                            *(u32x4*)(RVT + ((size_t)(b * 8 + head) * 512 + e) * SEQ + sp) = v; }
                    }
        } else if (pn < 55) {
            const int colt = (pn - 39) * BM;
#pragma unroll
            for (int ai = 0; ai < 2; ++ai)
#pragma unroll
                for (int m = 0; m < 4; ++m) { const int row = row0 + ai * HALF + m * 16;
#pragma unroll
                    for (int bj = 0; bj < 2; ++bj) { f32x4 v[2];
#pragma unroll
                        for (int n = 0; n < 2; ++n)
#pragma unroll
                            for (int j = 0; j < 4; ++j) v[n][j] = siluf_(acc[ai][bj][m][n][j]);
                        *(u32x4*)(RG + (size_t)row * RGP + colt + bj * HALF + cw) = pack8(v[0], v[1]); } }
        } else {
            const int colt = (pn - 55) * BM;
#pragma unroll
            for (int ai = 0; ai < 2; ++ai)
#pragma unroll
                for (int m = 0; m < 4; ++m) { const int row = row0 + ai * HALF + m * 16;
#pragma unroll
                    for (int bj = 0; bj < 2; ++bj) { const int col = colt + bj * HALF + cw; const f32x4 b0 = *(const f32x4*)(gbias + col), b1 = *(const f32x4*)(gbias + col + 4); f32x4 v[2];
#pragma unroll
                        for (int j = 0; j < 4; ++j) { v[0][j] = sigmoidf_(acc[ai][bj][m][0][j] + b0[j]); v[1][j] = sigmoidf_(acc[ai][bj][m][1][j] + b1[j]); }
                        *(u32x4*)(GT + (size_t)row * GTP + col) = pack8(v[0], v[1]); } }
        }
    }
};
}

namespace att {
constexpr int NW = 8, QBLK = 32, KVBLK = 64;
constexpr float SCALE = 0.07216878364870323f;
constexpr float THR = 8.f;
constexpr int LDQ = 3072, LDKV = 4096, LDKR = 64, LDO = 2048;
constexpr int SHM_V = KVBLK * 128 * 2, SHM_K = KVBLK * 128 * 2, SHM_KR = KVBLK * 64 * 2;
constexpr int OFF_V = 0, OFF_K = 2 * SHM_V, OFF_KR = OFF_K + 2 * SHM_K, OFF_WS = OFF_KR + 2 * SHM_KR, OFF_QR = OFF_WS + NW * 64 * 4, ATT_LDS = OFF_QR + NW * 4096;
#define KSWZ(row, colB) ((row) * 256 + ((colB) ^ (((row) & 7) << 4)))
#define KRSWZ(row, colB) ((row) * 128 + ((colB) ^ ((((row) >> 1) & 7) << 4)))
#define SBAR() __builtin_amdgcn_sched_barrier(0)
typedef LAS char* lptr;
__device__ __forceinline__ int crow(int r, int hi) { return (r & 3) + 8 * (r >> 2) + 4 * hi; }
__device__ __forceinline__ void partialSM(f32x16& p0, f32x16& p1, float& m_reg, float& mn, float& alpha) {
    constexpr float C = SCALE * 1.4426950408889634f;
    float pmax = p0[0];
#pragma unroll
    for (int r = 1; r < 16; ++r) pmax = fmaxf(pmax, p0[r]);
#pragma unroll
    for (int r = 0; r < 16; ++r) pmax = fmaxf(pmax, p1[r]);
    { auto rr = __builtin_amdgcn_permlane32_swap(__float_as_uint(pmax), __float_as_uint(pmax), false, false);
      pmax = fmaxf(__uint_as_float(rr[0]), __uint_as_float(rr[1])); }
    if (__builtin_expect(__all(pmax - m_reg <= THR / SCALE), 1)) { mn = m_reg; alpha = 1.f; }
    else { mn = fmaxf(m_reg, pmax); alpha = __builtin_amdgcn_exp2f((m_reg - mn) * C); m_reg = mn; }
    const float mnC = -mn * C;
#pragma unroll
    for (int r = 0; r < 16; ++r) p0[r] = fmaf(p0[r], C, mnC);
#pragma unroll
    for (int r = 0; r < 16; ++r) p1[r] = fmaf(p1[r], C, mnC);
#pragma unroll
    for (int r = 0; r < 16; ++r) p0[r] = __builtin_amdgcn_exp2f(p0[r]);
}
__device__ __forceinline__ void finishSM(f32x16& p0, f32x16& p1, float alpha, float& l_reg, bf16x8& pa0, bf16x8& pa1, bf16x8& pa2, bf16x8& pa3) {
#pragma unroll
    for (int r = 0; r < 16; ++r) p1[r] = __builtin_amdgcn_exp2f(p1[r]);
    float ps = 0;
#pragma unroll
    for (int r = 0; r < 16; ++r) ps += p0[r];
#pragma unroll
    for (int r = 0; r < 16; ++r) ps += p1[r];
    { auto rr = __builtin_amdgcn_permlane32_swap(__float_as_uint(ps), __float_as_uint(ps), false, false);
      ps = __uint_as_float(rr[0]) + __uint_as_float(rr[1]); }
    l_reg = l_reg * alpha + ps;
#define PK4(P, BASE, OUT) do { unsigned a0 = cvt_pk_bf16(P[BASE + 0], P[BASE + 1]), a1 = cvt_pk_bf16(P[BASE + 2], P[BASE + 3]);   \
    unsigned b0 = cvt_pk_bf16(P[BASE + 4], P[BASE + 5]), b1 = cvt_pk_bf16(P[BASE + 6], P[BASE + 7]);                              \
    auto r0 = __builtin_amdgcn_permlane32_swap(a0, b0, false, false); auto r1 = __builtin_amdgcn_permlane32_swap(a1, b1, false, false); \
    u32x4 w = {r0[0], r1[0], r0[1], r1[1]}; OUT = *reinterpret_cast<bf16x8*>(&w); } while (0)
    PK4(p0, 0, pa0); PK4(p0, 8, pa1); PK4(p1, 0, pa2); PK4(p1, 8, pa3);
#undef PK4
}
__device__ __forceinline__ void qkt(f32x16& p0, f32x16& p1, lptr Ks, lptr Krs, const bf16x8* qr, const LAS bf16x8* qsp, int r32, int hi) {
    p0 = f32x16{}; p1 = f32x16{};
#pragma unroll
    for (int d0 = 0; d0 < 8; ++d0) { const int cb = (d0 * 16 + hi * 8) * 2;
        const bf16x8 b0 = *(const LAS bf16x8*)(Ks + KSWZ(r32, cb));
        const bf16x8 b1 = *(const LAS bf16x8*)(Ks + KSWZ(32 + r32, cb));
        p0 = __builtin_amdgcn_mfma_f32_32x32x16_bf16(b0, qr[d0], p0, 0, 0, 0);
        p1 = __builtin_amdgcn_mfma_f32_32x32x16_bf16(b1, qr[d0], p1, 0, 0, 0); }
#pragma unroll
    for (int d0 = 0; d0 < 4; ++d0) { const int cb = (d0 * 16 + hi * 8) * 2;
        const bf16x8 b0 = *(const LAS bf16x8*)(Krs + KRSWZ(r32, cb));
        const bf16x8 b1 = *(const LAS bf16x8*)(Krs + KRSWZ(32 + r32, cb));
        const bf16x8 q = qsp[d0 * 64];
        p0 = __builtin_amdgcn_mfma_f32_32x32x16_bf16(b0, q, p0, 0, 0, 0);
        p1 = __builtin_amdgcn_mfma_f32_32x32x16_bf16(b1, q, p1, 0, 0, 0); }
}
__device__ __forceinline__ int v_st(int k, int c) { const int kk = (k & ~0xC) | ((k & 4) << 1) | ((k & 8) >> 1); return ((kk >> 3) * 4 + (c >> 5)) * 512 + ((kk & 7) * 32 + (c & 31)) * 2; }
__device__ __forceinline__ int v_rd_base(int lane) { return ((lane & 3) << 3) | (((lane >> 2) & 3) << 6) | (((lane >> 4) & 1) << 5) | (((lane >> 5) & 1) << 8); }
constexpr int v_rd_off(int d0, int ks, int half) { return d0 * 512 + ks * 4096 + half * 2048; }
template <int OFF> __device__ __forceinline__ s16x4 tr_read(int vb) {
    s16x4 r; asm volatile("ds_read_b64_tr_b16 %0, %1 offset:%2" : "=&v"(r) : "v"(vb), "i"(OFF) : "memory"); return r;
}
template <int D0> __device__ __forceinline__ void pv_one(f32x16& od, int vb, bf16x8 pa0, bf16x8 pa1, bf16x8 pa2, bf16x8 pa3) {
    const s16x4 l0 = tr_read<v_rd_off(D0, 0, 0)>(vb), h0 = tr_read<v_rd_off(D0, 0, 1)>(vb), l1 = tr_read<v_rd_off(D0, 1, 0)>(vb), h1 = tr_read<v_rd_off(D0, 1, 1)>(vb);
    const s16x4 l2 = tr_read<v_rd_off(D0, 2, 0)>(vb), h2 = tr_read<v_rd_off(D0, 2, 1)>(vb), l3 = tr_read<v_rd_off(D0, 3, 0)>(vb), h3 = tr_read<v_rd_off(D0, 3, 1)>(vb);
    asm volatile("s_waitcnt lgkmcnt(0)" ::: "memory"); SBAR();
#define PK(L, H) (bf16x8){L[0], L[1], L[2], L[3], H[0], H[1], H[2], H[3]}
    od = __builtin_amdgcn_mfma_f32_32x32x16_bf16(pa0, PK(l0, h0), od, 0, 0, 0);
    od = __builtin_amdgcn_mfma_f32_32x32x16_bf16(pa1, PK(l1, h1), od, 0, 0, 0);
    od = __builtin_amdgcn_mfma_f32_32x32x16_bf16(pa2, PK(l2, h2), od, 0, 0, 0);
    od = __builtin_amdgcn_mfma_f32_32x32x16_bf16(pa3, PK(l3, h3), od, 0, 0, 0);
#undef PK
}
__device__ __forceinline__ void pv_d0(f32x16* o, int vb, bf16x8 pa0, bf16x8 pa1, bf16x8 pa2, bf16x8 pa3) {
    pv_one<0>(o[0], vb, pa0, pa1, pa2, pa3); pv_one<1>(o[1], vb, pa0, pa1, pa2, pa3); pv_one<2>(o[2], vb, pa0, pa1, pa2, pa3); pv_one<3>(o[3], vb, pa0, pa1, pa2, pa3);
}
__device__ __forceinline__ void attn_unit(const bf16_t* __restrict__ Qb, const bf16_t* __restrict__ Kh, const bf16_t* __restrict__ Vh, const bf16_t* __restrict__ Krb,
                                          bf16_t* __restrict__ Ob, int seq, lptr lds, const int wid) {
    const int lane = lane_id(), tid = wid * 64 + lane, r32 = lane & 31, hi = lane >> 5;
    (void)Vh; lptr V_lds = lds + OFF_V; lptr K_lds = lds + OFF_K; lptr KR_lds = lds + OFF_KR;
    LAS float* ws = (LAS float*)(lds + OFF_WS) + wid * 64; LAS float* li_l = ws; LAS float* al_l = ws + 32;
    float m_reg = -1e30f, l_reg = 0; f32x16 o[4] = {}; bf16x8 qr[8];
    LAS bf16x8* qsp = (LAS bf16x8*)(lds + OFF_QR + wid * 4096) + lane;
    { const char* Qw = (const char*)Qb + (size_t)(wid * QBLK) * LDQ * 2; const unsigned qoff = (unsigned)(r32 * LDQ + hi * 8) * 2u;
#pragma unroll
      for (int d0 = 0; d0 < 8; ++d0) qr[d0] = *reinterpret_cast<const bf16x8*>(Qw + qoff + d0 * 32);
#pragma unroll
      for (int d0 = 0; d0 < 4; ++d0) qsp[d0 * 64] = *reinterpret_cast<const bf16x8*>(Qw + qoff + (8 + d0) * 32); }
    const int sr = tid >> 4, sc = (tid & 15) * 8, vst0 = v_st(sr, sc), vst1 = v_st(32 + sr, sc);
    const int kr_r = tid >> 3, kr_c = (tid & 7) * 8, krst = KRSWZ(kr_r, kr_c * 2);
    const int vb0 = (int)(uintptr_t)V_lds + v_rd_base(lane);
    const unsigned kvoff = (unsigned)(sr * LDKV + sc) * 2u, kroff = (unsigned)(kr_r * LDKR + kr_c) * 2u;
    bf16x8 vs0, vs1, ks0, ks1, krs;
#define SLOAD(k0) do { const char* kb_ = (const char*)Kh + (size_t)(k0) * LDKV * 2; const char* rb_ = (const char*)Krb + (size_t)(k0) * LDKR * 2; \
    ks0 = *reinterpret_cast<const bf16x8*>(kb_ + kvoff); vs0 = *reinterpret_cast<const bf16x8*>(kb_ + kvoff + 256); \
    ks1 = *reinterpret_cast<const bf16x8*>(kb_ + (size_t)32 * LDKV * 2 + kvoff); vs1 = *reinterpret_cast<const bf16x8*>(kb_ + (size_t)32 * LDKV * 2 + kvoff + 256); \
    krs = *reinterpret_cast<const bf16x8*>(rb_ + kroff); } while (0)
#define SWRITE(b) do { *(LAS bf16x8*)(V_lds + (b) * SHM_V + vst0) = vs0; *(LAS bf16x8*)(V_lds + (b) * SHM_V + vst1) = vs1; const int kc = sc * 2; \
    *(LAS bf16x8*)(K_lds + (b) * SHM_K + KSWZ(sr, kc)) = ks0; *(LAS bf16x8*)(K_lds + (b) * SHM_K + KSWZ(32 + sr, kc)) = ks1; \
    *(LAS bf16x8*)(KR_lds + (b) * SHM_KR + krst) = krs; } while (0)
#define SWAIT() asm volatile("s_waitcnt vmcnt(0)" ::: "memory")
#define RESC(a) do { if (__any((a) < 1.f)) { if (hi == 0) al_l[r32] = (a); asm volatile("s_waitcnt lgkmcnt(0)" ::: "memory"); \
    _Pragma("unroll") for (int d = 0; d < 4; ++d) _Pragma("unroll") for (int r = 0; r < 16; ++r) o[d][r] *= al_l[crow(r, hi)]; } } while (0)
    f32x16 pA0, pA1, pB0, pB1; float mnA, mnB, alA, alB; bf16x8 pa0, pa1, pa2, pa3; const int NT = seq / KVBLK;
    SLOAD(0); SWAIT(); SWRITE(0); __syncthreads();
    qkt(pA0, pA1, K_lds, KR_lds, qr, qsp, r32, hi); partialSM(pA0, pA1, m_reg, mnA, alA);
    SLOAD(KVBLK);
    SWAIT(); SWRITE(1); __syncthreads();
    for (int j = 1; j + 1 < NT; j += 2) {
        SBAR(); qkt(pB0, pB1, K_lds + SHM_K, KR_lds + SHM_KR, qr, qsp, r32, hi);
        finishSM(pA0, pA1, alA, l_reg, pa0, pa1, pa2, pa3); SBAR();
        SLOAD((j + 1) * KVBLK); SBAR();
        pv_d0(o, vb0, pa0, pa1, pa2, pa3); partialSM(pB0, pB1, m_reg, mnB, alB);
        __syncthreads(); SWAIT(); SWRITE(0);
        RESC(alB); __syncthreads();
        SBAR(); qkt(pA0, pA1, K_lds, KR_lds, qr, qsp, r32, hi);
        finishSM(pB0, pB1, alB, l_reg, pa0, pa1, pa2, pa3); SBAR();
        SLOAD((j + 2) * KVBLK); SBAR();
        pv_d0(o, vb0 + SHM_V, pa0, pa1, pa2, pa3); partialSM(pA0, pA1, m_reg, mnA, alA);
        __syncthreads(); SWAIT(); SWRITE(1);
        RESC(alA); __syncthreads();
    }
    SBAR(); qkt(pB0, pB1, K_lds + SHM_K, KR_lds + SHM_KR, qr, qsp, r32, hi);
    finishSM(pA0, pA1, alA, l_reg, pa0, pa1, pa2, pa3); SBAR();
    pv_d0(o, vb0, pa0, pa1, pa2, pa3); partialSM(pB0, pB1, m_reg, mnB, alB);
    __syncthreads(); RESC(alB);
    finishSM(pB0, pB1, alB, l_reg, pa0, pa1, pa2, pa3); SBAR();
    pv_d0(o, vb0 + SHM_V, pa0, pa1, pa2, pa3);
    if (hi == 0) li_l[r32] = l_reg; asm volatile("s_waitcnt lgkmcnt(0)" ::: "memory");
    float rli[16];
#pragma unroll
    for (int r = 0; r < 16; ++r) rli[r] = __builtin_amdgcn_rcpf(li_l[crow(r, hi)]);
    char* Ow = (char*)Ob + (size_t)(wid * QBLK) * LDO * 2; const unsigned ooff = (unsigned)(4 * hi * LDO + r32) * 2u;
#pragma unroll
    for (int r = 0; r < 16; ++r) { const int orel = (r & 3) + 8 * (r >> 2);
#pragma unroll
        for (int d0 = 0; d0 < 4; ++d0) { const unsigned w = cvt_pk_bf16(o[d0][r] * rli[r], 0.f); *(bf16_t*)(Ow + ooff + (orel * LDO + d0 * 32) * 2) = (bf16_t)(w & 0xffffu); } }
    __syncthreads();
#undef SLOAD
#undef SWRITE
#undef SWAIT
#undef RESC
}
}

#define XB_TMO      128
#define XB_XCNT(j)  (256  + 64 * (j))
#define XB_XSUB(j)  (1280 + 64 * (j))
#define XB_XGEN(j)  (2304 + 64 * (j))
#define XB_TOP      3328
#define XB_TOPGEN   3392
#define XCD_BAR_WORDS 3456
#define XB_SPIN_CAP (1u << 18)
__device__ __forceinline__ unsigned xb_ld(unsigned* p)              { return __hip_atomic_load(p, __ATOMIC_RELAXED, __HIP_MEMORY_SCOPE_AGENT); }
__device__ __forceinline__ unsigned xb_add(unsigned* p, unsigned v) { return __hip_atomic_fetch_add(p, v, __ATOMIC_RELAXED, __HIP_MEMORY_SCOPE_AGENT); }
__device__ __forceinline__ unsigned xb_xcc_id() { return (unsigned)__builtin_amdgcn_s_getreg((3 << 11) | 20) & 0xFu; }
#define XB_SPIN(cond, bar) do { unsigned _sp = 0; while (cond) { __builtin_amdgcn_s_sleep(1); \
    if ((++_sp & 255u) == 0u) { if (xb_ld(&(bar)[XB_TMO])) break; if (_sp > XB_SPIN_CAP) { atomicAdd(&(bar)[XB_TMO], 1u); break; } } } } while (0)
struct XcdBarrier { unsigned* bar; unsigned x; volatile LAS unsigned* st; };
__device__ __forceinline__ XcdBarrier xcd_barrier_post(unsigned* bar, volatile LAS unsigned* st, const bool t0) {
    XcdBarrier b; b.bar = bar; b.x = xb_xcc_id(); b.st = st;
    if (t0) (void)xb_add(&bar[XB_XCNT(b.x)], 1u);
    return b;
}
__device__ __forceinline__ void xcd_barrier_complete(unsigned* bar, unsigned x, unsigned& nloc, unsigned& nx) {
    const unsigned G = gridDim.x * gridDim.y * gridDim.z;
    unsigned sum, cnt, mine, sp = 0u;
    for (;;) {
        sum = 0u; cnt = 0u; mine = 0u;
#pragma unroll
        for (unsigned j = 0; j < 16; ++j) { const unsigned c = xb_ld(&bar[XB_XCNT(j)]); sum += c; cnt += (c > 0u) ? 1u : 0u; mine = (j == x) ? c : mine; }
        if (sum == G) break;
        __builtin_amdgcn_s_sleep(1);
        if ((++sp & 255u) == 0u) { if (xb_ld(&bar[XB_TMO])) break; if (sp > XB_SPIN_CAP) { atomicAdd(&bar[XB_TMO], 1u); break; } }
    }
    nloc = mine > 0u ? mine : 1u; nx = cnt > 0u ? cnt : 1u;
}
__device__ __forceinline__ void xcd_barrier(const XcdBarrier& b, const bool t0) {
    asm volatile("s_waitcnt vmcnt(0)" ::: "memory");
    __syncthreads();
    if (t0) {
        unsigned* bar = b.bar;
        __builtin_amdgcn_s_waitcnt(0);
        unsigned nloc = b.st[0], nx = b.st[1];
        if (nloc == 0u) { xcd_barrier_complete(bar, b.x, nloc, nx); b.st[0] = nloc; b.st[1] = nx; }
        const unsigned old = xb_add(&bar[XB_XSUB(b.x)], 1u);
        const unsigned gen = old / nloc;
        if (old + 1u == (gen + 1u) * nloc) {
            __builtin_amdgcn_fence(__ATOMIC_RELEASE, "agent");
            asm volatile("s_waitcnt vmcnt(0)" ::: "memory");
            const unsigned og = xb_add(&bar[XB_TOP], 1u);
            const unsigned tg = og / nx;
            if (og + 1u == (tg + 1u) * nx) xb_add(&bar[XB_TOPGEN], 1u);
            else XB_SPIN(xb_ld(&bar[XB_TOPGEN]) == tg, bar);
            __builtin_amdgcn_fence(__ATOMIC_ACQUIRE, "agent");
            xb_add(&bar[XB_XGEN(b.x)], 1u);
            asm volatile("s_waitcnt vmcnt(0)" ::: "memory");
        } else {
            XB_SPIN(xb_ld(&bar[XB_XGEN(b.x)]) == gen, bar);
            __builtin_amdgcn_fence(__ATOMIC_ACQUIRE, "agent");
            asm volatile("s_waitcnt vmcnt(0)" ::: "memory");
        }
    }
    __syncthreads();
}

__device__ __forceinline__ int wfi_src(int nb) { const int pn = nb >> 3, q = nb & 7; return (q >> 2) * DFF + pn * 128 + (q & 3) * 32; }
__device__ __forceinline__ int win_src(int nb) { const int n0 = nb * 32; if (n0 < 1536) return n0; if (n0 < 1792) return n0 == 1536 ? 1536 : (n0 == 1664 ? 1568 : -1); return n0 - 192; }
__device__ __forceinline__ int wuq_src(int nb) { const int n0 = nb * 32; if (n0 < 2048) return (n0 >> 7) * 192 + (n0 & 127);
    const int w = n0 - 2048, t = w >> 8, wi = w & 255, bj = wi >> 7, hh = (wi & 127) >> 5; return (4 * t + hh) * 192 + 128 + 32 * bj; }
__device__ __forceinline__ void p0_item(const float* __restrict__ W, int ldw, int K, bf16_t* __restrict__ WT, int sc, int dn, int k0, const float* __restrict__ gk, LAS float* scr, int lane) {
    const int c = lane & 7;
    if (sc < 0) {
#pragma unroll
        for (int j = 0; j < 4; ++j) { const int n = (lane >> 3) + 8 * j; *(u32x4*)(WT + (size_t)(dn + n) * K + k0 + 8 * c) = (u32x4){0u, 0u, 0u, 0u}; }
        return;
    }
#pragma unroll 8
    for (int i = 0; i < 32; ++i) { const int kk = 2 * i + (lane >> 5); float v = __builtin_nontemporal_load(W + (size_t)(k0 + kk) * ldw + sc + (lane & 31)); if (gk) v *= gk[k0 + kk]; scr[kk * 33 + (lane & 31)] = v; }
    LDS_WAIT(); asm volatile("" ::: "memory");
#pragma unroll
    for (int j = 0; j < 4; ++j) { const int n = (lane >> 3) + 8 * j; const LAS float* s = scr + (8 * c) * 33 + n;
        u32x4 o; o.x = cvt_pk_bf16(s[0 * 33], s[1 * 33]); o.y = cvt_pk_bf16(s[2 * 33], s[3 * 33]); o.z = cvt_pk_bf16(s[4 * 33], s[5 * 33]); o.w = cvt_pk_bf16(s[6 * 33], s[7 * 33]);
        __builtin_nontemporal_store(o, (u32x4*)(WT + (size_t)(dn + n) * K + k0 + 8 * c)); }
    LDS_WAIT(); asm volatile("" ::: "memory");
}

__device__ __forceinline__ void p0_item_ln(const float* __restrict__ W, int ldw, int K, bf16_t* __restrict__ WT, int sc, int dn, int k0, const float* __restrict__ gk, const float* __restrict__ bk,
                                           float* sv, float* cv, LAS float* scr, int lane) {
    const int c = lane & 7;
#pragma unroll 8
    for (int i = 0; i < 32; ++i) { const int kk = 2 * i + (lane >> 5); scr[kk * 33 + (lane & 31)] = __builtin_nontemporal_load(W + (size_t)(k0 + kk) * ldw + sc + (lane & 31)); }
    const f32x4 ga = *(const f32x4*)(gk + k0 + 8 * c), gb = *(const f32x4*)(gk + k0 + 8 * c + 4), ba = *(const f32x4*)(bk + k0 + 8 * c), bb = *(const f32x4*)(bk + k0 + 8 * c + 4);
    LDS_WAIT(); asm volatile("" ::: "memory");
    float sk = 0.f, ck = 0.f;
#pragma unroll
    for (int j = 0; j < 4; ++j) { const int n = (lane >> 3) + 8 * j; const LAS float* sp = scr + (8 * c) * 33 + n;
        const float w0 = sp[0 * 33], w1 = sp[1 * 33], w2 = sp[2 * 33], w3 = sp[3 * 33], w4 = sp[4 * 33], w5 = sp[5 * 33], w6 = sp[6 * 33], w7 = sp[7 * 33];
        u32x4 o; o.x = cvt_pk_bf16(w0 * ga[0], w1 * ga[1]); o.y = cvt_pk_bf16(w2 * ga[2], w3 * ga[3]); o.z = cvt_pk_bf16(w4 * gb[0], w5 * gb[1]); o.w = cvt_pk_bf16(w6 * gb[2], w7 * gb[3]);
        __builtin_nontemporal_store(o, (u32x4*)(WT + (size_t)(dn + n) * K + k0 + 8 * c));
        float ss = ((bf_lo(o.x) + bf_hi(o.x)) + (bf_lo(o.y) + bf_hi(o.y))) + ((bf_lo(o.z) + bf_hi(o.z)) + (bf_lo(o.w) + bf_hi(o.w)));
        float cs = ((w0 * ba[0] + w1 * ba[1]) + (w2 * ba[2] + w3 * ba[3])) + ((w4 * bb[0] + w5 * bb[1]) + (w6 * bb[2] + w7 * bb[3]));
        ss += __shfl_xor(ss, 1); ss += __shfl_xor(ss, 2); ss += __shfl_xor(ss, 4); cs += __shfl_xor(cs, 1); cs += __shfl_xor(cs, 2); cs += __shfl_xor(cs, 4);
        if (c == j) { sk = ss; ck = cs; } }
    if (c < 4) { const int n = (lane >> 3) + 8 * c; atomicAdd(sv + dn + n, sk); atomicAdd(cv + dn + n, ck); }
    LDS_WAIT(); asm volatile("" ::: "memory");
}

__device__ __forceinline__ void p0_item_lnr(const float* __restrict__ W, int ldw, bf16_t* __restrict__ WR, int sc, int k0, const float* __restrict__ gk, const float* __restrict__ bk,
                                            float* sv, float* cv, int lane) {
    const int cp = lane & 15, r4 = lane >> 4;
    float s0 = 0.f, s1 = 0.f, c0 = 0.f, c1 = 0.f;
#pragma unroll 8
    for (int i = 0; i < 16; ++i) { const int k = k0 + 4 * i + r4; const f32x2 w = __builtin_nontemporal_load((const f32x2*)(W + (size_t)k * ldw + sc + 2 * cp)); const float g = gk[k], b = bk[k];
        const unsigned o = cvt_pk_bf16(w.x * g, w.y * g); *(unsigned*)(WR + (size_t)k * ldw + sc + 2 * cp) = o;
        s0 += bf_lo(o); s1 += bf_hi(o); c0 += w.x * b; c1 += w.y * b; }
    s0 += __shfl_xor(s0, 16); s0 += __shfl_xor(s0, 32); s1 += __shfl_xor(s1, 16); s1 += __shfl_xor(s1, 32);
    c0 += __shfl_xor(c0, 16); c0 += __shfl_xor(c0, 32); c1 += __shfl_xor(c1, 16); c1 += __shfl_xor(c1, 32);
    if (r4 == 0) { atomicAdd(sv + sc + 2 * cp, s0); atomicAdd(sv + sc + 2 * cp + 1, s1); atomicAdd(cv + sc + 2 * cp, c0); atomicAdd(cv + sc + 2 * cp + 1, c1); }
}

constexpr int NPHASE = 21;
struct Args { const void* in[28]; float* out; unsigned char* ws; int ph_lo, ph_hi; };
static_assert(WS_CONVB + (size_t)DFF2 * 4 <= WS_MISC && WS_CONVW >= CTL_ZERO_BYTES, "conv weight copy");
static_assert(WS_C2 + DFF2 * 4 <= CTL_ZERO_BYTES && WS_MISC >= CTL_ZERO_BYTES && WS_MISC + 64 <= WS_WIN, "control region");
static_assert(sizeof(Args) == 28 * 8 + 8 + 8 + 8, "Args has no padding");

__global__ void __launch_bounds__(NWAVES * 64, 2) mk_fwd(Args args) {
    extern __shared__ __attribute__((aligned(16))) unsigned char lds_raw[];
    LAS unsigned char* lds = (LAS unsigned char*)lds_raw;
    volatile LAS unsigned* MISC = (volatile LAS unsigned*)(lds + MISC_OFF);
    const int wave = __builtin_amdgcn_readfirstlane((int)threadIdx.x >> 6);
#define tid (wave * 64 + lane)
    const int G = gridDim.x, bx = blockIdx.x;
    const int vcu = (G % 8 == 0) ? (bx % 8) * (G / 8) + bx / 8 : bx;
    const int gw = vcu * NWAVES + wave, NGW = G * NWAVES;
    const int NGT = G * NWAVES * 64;
#define gtid (vcu * (NWAVES * 64) + wave * 64 + lane)
    unsigned char* ws = args.ws;
    unsigned* ctl = (unsigned*)(ws + WS_CTL);
    { const int lane = lane_id(); for (int u = tid; u < (LDS_BYTES - LDSCTL_OFF) / 4; u += NWAVES * 64) ((LAS unsigned*)(lds + LDSCTL_OFF))[u] = 0u; }
    __syncthreads();
    XcdBarrier bar; bar.bar = ctl + CW_BAR; bar.x = 0; bar.st = nullptr;
#if !MK_PER_PHASE
    bar = xcd_barrier_post(ctl + CW_BAR, MISC + 8, wave == 0 && lane_id() == 0);
#define GRID_BAR() xcd_barrier(bar, wave == 0 && lane_id() == 0)
#else
#define GRID_BAR() do {} while (0)
#endif
    const int lo = args.ph_lo, hi = args.ph_hi;
#ifndef DUP_MASK
#define DUP_MASK 0u
#endif
#define IN(k) (lo <= (k) && (k) < hi)
#define REP(k) for (int rep_ = 0; rep_ < (((DUP_MASK >> (k)) & 1u) ? 2 : 1); ++rep_)
#define SEAM(k) do { if (IN(k) && IN((k) + 1)) GRID_BAR(); } while (0)

#define in_x ((const float*)args.in[0])
#define in_mem ((const float*)args.in[1])
#define in_positions ((const int*)args.in[2])
#define in_w_in ((const float*)args.in[3])
#define in_gate_bias ((const float*)args.in[4])
#define in_q_norm_g ((const float*)args.in[5])
#define in_w_uq ((const float*)args.in[6])
#define in_kv_norm_g ((const float*)args.in[7])
#define in_w_ukv ((const float*)args.in[8])
#define in_dec_f ((const float*)args.in[9])
#define in_dec_b ((const float*)args.in[10])
#define in_w_br_mla ((const float*)args.in[11])
#define in_w_br_ret ((const float*)args.in[12])
#define in_w_o ((const float*)args.in[13])
#define in_ln1_g ((const float*)args.in[14])
#define in_ln1_b ((const float*)args.in[15])
#define in_w_cq ((const float*)args.in[16])
#define in_w_ck ((const float*)args.in[17])
#define in_w_cv ((const float*)args.in[18])
#define in_w_co ((const float*)args.in[19])
#define in_ln2_g ((const float*)args.in[20])
#define in_ln2_b ((const float*)args.in[21])
#define in_w_ffn_in ((const float*)args.in[22])
#define in_conv_w ((const float*)args.in[23])
#define in_conv_b ((const float*)args.in[24])
#define in_w_ffn_out ((const float*)args.in[25])
#define in_ln3_g ((const float*)args.in[26])
#define in_ln3_b ((const float*)args.in[27])
#define Win_t ((bf16_t*)(ws + WS_WIN))
#define Wfi_t ((bf16_t*)(ws + WS_WFI))
#define Wfo_t ((bf16_t*)(ws + WS_WFO))
#define Wbr_t ((bf16_t*)(ws + WS_WBR))
#define Wo_t ((bf16_t*)(ws + WS_WO))
#define Wcq_r ((bf16_t*)(ws + WS_WCQ))
#define Wck_t ((bf16_t*)(ws + WS_WCK))
#define Wcv_t ((bf16_t*)(ws + WS_WCV))
#define Wco_t ((bf16_t*)(ws + WS_WCO))
#define Wbm_t ((bf16_t*)(ws + WS_WBM))
#define Wuq_t ((bf16_t*)(ws + WS_WUQ))
#define Wukv_t ((bf16_t*)(ws + WS_WUKV))
#define MEMB ((bf16_t*)(ws + WS_MEMB))
#define ROPER ((f32x2*)(ws + WS_ROPER))
#define ROPEA ((f32x2*)(ws + WS_ROPEA))
#define RSS ((float*)(ws + WS_RSS))
#define RS1 ((float*)(ws + WS_RS1))
#define RS2 ((float*)(ws + WS_RS2))
#define RS3 ((float*)(ws + WS_RS3))
#define S1V ((float*)(ws + WS_S1))
#define C1V ((float*)(ws + WS_C1))
#define S2V ((float*)(ws + WS_S2))
#define C2V ((float*)(ws + WS_C2))
#define ZB ((bf16_t*)(ws + WS_ZB))
#define DEC ((float*)(ws + WS_MISC))
#define XB ((bf16_t*)(ws + WS_XB))
#define CQM ((bf16_t*)(ws + WS_CQM))
#define CKV ((bf16_t*)(ws + WS_CKV))
#define KPE ((bf16_t*)(ws + WS_KPE))
#define RQ ((bf16_t*)(ws + WS_RQ))
#define RK ((bf16_t*)(ws + WS_RK))
#define RVT ((bf16_t*)(ws + WS_RVT))
#define RG ((bf16_t*)(ws + WS_RG))
#define GT ((bf16_t*)(ws + WS_GT))
#define SC ((bf16_t*)(ws + WS_SC))
#define AO ((bf16_t*)(ws + WS_AO))
#define QB ((bf16_t*)(ws + WS_Q))
#define KVB ((bf16_t*)(ws + WS_KV))
#define ORET ((bf16_t*)(ws + WS_ORET))
#define ROUT ((bf16_t*)(ws + WS_ROUT))
#define TMP ((bf16_t*)(ws + WS_TMP))
#define MIXED ((bf16_t*)(ws + WS_MIXED))
#define Z ((float*)(ws + WS_Z))
#define MQT ((bf16_t*)(ws + WS_MQT))
#define VWT ((bf16_t*)(ws + WS_VWT))
#define CK ((bf16_t*)(ws + WS_CK))
#define CV ((bf16_t*)(ws + WS_CV))
#define SXV ((float*)(ws + WS_SX))
#define CXV ((float*)(ws + WS_CX))
#define XS ((float*)(ws + WS_XS))
#define XP ((bf16_t*)(ws + WS_XP))
#define EDGE ((unsigned*)(ws + WS_EDGE))
#define ACT ((bf16_t*)(ws + WS_ACT))

#define GEMM_CALL(EpiT, Ev, Aptr, Bptr, lda_, ldb_, K_, nM_, nN_, nZ_, nh_, sAb_, sAh_, sBb_, sBh_) do { \
        pg8::Gemm g_{(Aptr), (Bptr), (lda_), (ldb_), (K_), (nh_), (long)(sAb_), (long)(sAh_), (long)(sBb_), (long)(sBh_)}; \
        pg8::Order S_; S_.init((nM_), (nN_), (nZ_), G, bx); pg8::gemm_phase<EpiT>(lds, g_, S_, (Ev), wave); } while (0)

    constexpr int I_IN = (INP / 32) * (D / 64), I_UQ = (3072 / 32) * (1024 / 64), I_UKV = (4096 / 32) * (512 / 64), I_BM = (4096 / 32) * (2048 / 64), I_SQ = (4096 / 32) * (4096 / 64);
    constexpr int I_FI = (DFF2 / 32) * (D / 64), I_FO = (4096 / 32) * (DFF / 64);
    const bool split = (G == 256);
#define CONV_WCO(lo_, hi_, w_, nw_) do { LAS float* scr_ = (LAS float*)(lds + wave * 16384); for (int r = (lo_) + (w_); r < (hi_); r += (nw_)) { const int nblk = 4096 / 32, kb = r / nblk, nb = r % nblk; \
        p0_item(in_w_co, 4096, 4096, Wco_t, nb * 32, nb * 32, kb * 64, nullptr, scr_, lane); } } while (0)
#define CONV_WFI2(w_, nw_) do { LAS float* scr_ = (LAS float*)(lds + wave * 16384); for (int r = I_FI / 2 + (w_); r < I_FI; r += (nw_)) { const int nblk = DFF2 / 32, kb = r / nblk, nb = r % nblk; \
        p0_item_ln(in_w_ffn_in, DFF2, D, Wfi_t, wfi_src(nb), nb * 32, kb * 64, in_ln2_g, in_ln2_b, S2V, C2V, scr_, lane); } } while (0)
#define CONV_WFO(w_, nw_) do { LAS float* scr_ = (LAS float*)(lds + wave * 16384); for (int r = (w_); r < I_FO; r += (nw_)) { const int nblk = 4096 / 32, kb = r / nblk, nb = r % nblk; \
        p0_item(in_w_ffn_out, 4096, DFF, Wfo_t, nb * 32, nb * 32, kb * 64, nullptr, scr_, lane); } } while (0)
    if (IN(0)) REP(0) { const int lane = lane_id();
        LAS float* scr = (LAS float*)(lds + wave * 16384);
        constexpr int NITEMS = I_IN + I_UQ + I_UKV + I_BM + 5 * I_SQ + I_FI / 2;
        for (int it = gw; it < NITEMS; it += NGW) {
            int r = it;
            if (r < I_IN) { const int nblk = INP / 32, kb = r / nblk, nb = r % nblk; p0_item(in_w_in, INW, D, Win_t, win_src(nb), nb * 32, kb * 64, nullptr, scr, lane); continue; } r -= I_IN;
            if (r < I_UQ) { const int nblk = 3072 / 32, kb = r / nblk, nb = r % nblk; p0_item(in_w_uq, 3072, 1024, Wuq_t, wuq_src(nb), nb * 32, kb * 64, in_q_norm_g, scr, lane); continue; } r -= I_UQ;
            if (r < I_UKV) { const int nblk = 4096 / 32, kb = r / nblk, nb = r % nblk; p0_item(in_w_ukv, 4096, 512, Wukv_t, nb * 32, nb * 32, kb * 64, in_kv_norm_g, scr, lane); continue; } r -= I_UKV;
            if (r < I_BM) { const int nblk = 4096 / 32, kb = r / nblk, nb = r % nblk; p0_item(in_w_br_mla, 4096, 2048, Wbm_t, nb * 32, nb * 32, kb * 64, nullptr, scr, lane); continue; } r -= I_BM;
            if (r < 5 * I_SQ) { const int wsel = r / I_SQ; r -= wsel * I_SQ; const int nblk = 4096 / 32, kb = r / nblk, nb = r % nblk;
                const float* W = wsel == 0 ? in_w_br_ret : wsel == 1 ? in_w_o : wsel == 2 ? in_w_cq : wsel == 3 ? in_w_ck : in_w_cv;
                bf16_t* WT = wsel == 0 ? Wbr_t : wsel == 1 ? Wo_t : wsel == 2 ? Wcq_r : wsel == 3 ? Wck_t : Wcv_t;
                if (wsel == 2) p0_item_lnr(W, 4096, WT, nb * 32, kb * 64, in_ln1_g, in_ln1_b, S1V, C1V, lane);
                else p0_item(W, 4096, 4096, WT, nb * 32, nb * 32, kb * 64, nullptr, scr, lane);
                continue; } r -= 5 * I_SQ;
            { const int nblk = DFF2 / 32, kb = r / nblk, nb = r % nblk; p0_item_ln(in_w_ffn_in, DFF2, D, Wfi_t, wfi_src(nb), nb * 32, kb * 64, in_ln2_g, in_ln2_b, S2V, C2V, scr, lane); }
        }
        if (!split) { CONV_WCO(0, I_SQ, gw, NGW); CONV_WFI2(gw, NGW); CONV_WFO(gw, NGW); }
        for (long i = gtid; i < (long)T * D / 8; i += NGT) { const f32x4 a = __builtin_nontemporal_load((const f32x4*)(in_x + i * 8)), b = __builtin_nontemporal_load((const f32x4*)(in_x + i * 8 + 4)); *(u32x4*)(XB + i * 8) = pg8::pack8(a, b); }
        for (long i = gtid; i < (long)TM * D / 8; i += NGT) { const f32x4 a = *(const f32x4*)(in_mem + i * 8), b = *(const f32x4*)(in_mem + i * 8 + 4); *(u32x4*)(MEMB + i * 8) = pg8::pack8(a, b); }
        for (int i = gtid; i < 3 * DFF2 / 4; i += NGT) ((f32x4*)(ws + WS_CONVW))[i] = ((const f32x4*)in_conv_w)[i];
        for (int i = gtid; i < DFF2 / 4; i += NGT) ((f32x4*)(ws + WS_CONVB))[i] = ((const f32x4*)in_conv_b)[i];
        if (gtid < 16) { const float e = gtid < 8 ? in_dec_f[gtid] : in_dec_b[gtid - 8]; DEC[gtid] = log1pf(-exp2f(-e)) * 1.4426950408889634f; }
        __syncthreads();
    }
    SEAM(0);

    if (IN(1)) REP(1) {
        pg8::EpiProj E{CQM, CKV, KPE, RQ, RK, RVT, RG, GT, RSS, in_positions, in_gate_bias, lds};
        GEMM_CALL(pg8::EpiProj, E, XB, Win_t, D, D, D, 32, 87, 1, 1, 0, 0, 0, 0);
        const int lane = lane_id();
        if (split && bx >= 224) CONV_WCO(0, I_SQ / 2, (bx - 224) * NWAVES + wave, 32 * NWAVES);
    }
    SEAM(1);

    if (IN(2)) REP(2) {
        { pg8::EpiQ E{QB, RSS, in_positions}; GEMM_CALL(pg8::EpiQ, E, CQM, Wuq_t, 1024, 1024, 1024, 32, 12, 1, 1, 0, 0, 0, 0); }
        { pg8::EpiBf16 E{KVB, 4096, 1.0f, 1, 0, 0, RSS + T, 1.0f / 512.0f}; GEMM_CALL(pg8::EpiBf16, E, CKV, Wukv_t, 512, 512, 512, 32, 16, 1, 1, 0, 0, 0, 0); }
    }
    SEAM(2);

    if (IN(3)) REP(3) {
        for (int idx = vcu; idx < 512; idx += G) {
            const int bh = idx >> 3, qb = idx & 7, b = bh >> 4, h = bh & 15;
            const size_t row0 = (size_t)b * SEQ + qb * 256, key0 = (size_t)b * SEQ;
            att::attn_unit(QB + row0 * 3072 + h * 192, KVB + key0 * 4096 + h * 256, KVB + key0 * 4096 + h * 256 + 128, KPE + key0 * 64, AO + row0 * 2048 + h * 128, SEQ, (att::lptr)lds, wave);
        }
    }
    if (IN(3) && IN(4)) __syncthreads();

    if (IN(4)) REP(4) {
        pg8::EpiRetS E{SC, DEC};
        GEMM_CALL(pg8::EpiRetS, E, RQ, RK, 2048, 2048, 256, 8, 8, 32, 8, (long)SEQ * 2048, 256, (long)SEQ * 2048, 256);
    }
    SEAM(4);

    if (IN(5)) REP(5) {
        pg8::EpiBf16 E{ORET, D, 1.0f, 8, (long)SEQ * D, 512, nullptr, 0.f};
        GEMM_CALL(pg8::EpiBf16, E, SC, RVT, 2048, 2048, 2048, 8, 2, 32, 8, (long)8 * SEQ * SEQ, (long)SEQ * SEQ, (long)8 * 512 * SEQ, (long)512 * SEQ);
    }
    SEAM(5);

    if (IN(6)) REP(6) { const int lane = lane_id();
        for (int it = gw; it < T * 8; it += NGW) {
            const size_t off = (size_t)it * 512;
            const u32x2 aw = __builtin_nontemporal_load((const u32x2*)(ORET + off + lane * 4)), bw = __builtin_nontemporal_load((const u32x2*)(ORET + off + 256 + lane * 4));
            const f32x4 a = {bf_lo(aw.x), bf_hi(aw.x), bf_lo(aw.y), bf_hi(aw.y)}, b = {bf_lo(bw.x), bf_hi(bw.x), bf_lo(bw.y), bf_hi(bw.y)};
            const float mean = wave_sum((a[0] + a[1]) + (a[2] + a[3]) + (b[0] + b[1]) + (b[2] + b[3])) * (1.0f / 512.0f);
            const f32x4 da = a - mean, db = b - mean;
            const float var = wave_sum((da[0] * da[0] + da[1] * da[1]) + (da[2] * da[2] + da[3] * da[3]) + (db[0] * db[0] + db[1] * db[1]) + (db[2] * db[2] + db[3] * db[3])) * (1.0f / 512.0f);
            const float rstd = rsqrtf(var + LN_EPS);
            const size_t goff = (size_t)(it >> 3) * RGP + (it & 7) * 512;
            const u32x2 ga = __builtin_nontemporal_load((const u32x2*)(RG + goff + lane * 4)), gb = __builtin_nontemporal_load((const u32x2*)(RG + goff + 256 + lane * 4));
            u32x2 oa, ob;
            oa.x = cvt_pk_bf16(da[0] * rstd * bf_lo(ga.x), da[1] * rstd * bf_hi(ga.x)); oa.y = cvt_pk_bf16(da[2] * rstd * bf_lo(ga.y), da[3] * rstd * bf_hi(ga.y));
            ob.x = cvt_pk_bf16(db[0] * rstd * bf_lo(gb.x), db[1] * rstd * bf_hi(gb.x)); ob.y = cvt_pk_bf16(db[2] * rstd * bf_lo(gb.y), db[3] * rstd * bf_hi(gb.y));
            *(u32x2*)(ROUT + off + lane * 4) = oa; *(u32x2*)(ROUT + off + 256 + lane * 4) = ob;
        }
    }
    if (IN(6) && IN(7)) __syncthreads();

    if (IN(7)) REP(7) { pg8::EpiBf16 E{TMP, D, 1.0f, 1, 0, 0, nullptr, 0.f}; GEMM_CALL(pg8::EpiBf16, E, AO, Wbm_t, 2048, 2048, 2048, 32, 16, 1, 1, 0, 0, 0, 0); }
    SEAM(7);
    if (IN(8)) REP(8) { pg8::EpiGate1 E{MIXED, TMP, GT}; GEMM_CALL(pg8::EpiGate1, E, ROUT, Wbr_t, D, D, D, 32, 16, 1, 1, 0, 0, 0, 0); }
    SEAM(8);
    if (IN(9)) REP(9) { typedef pg8::EpiResStat<WS_ZB, WS_RS1> EpiT9; EpiT9 E{ws, in_x}; GEMM_CALL(EpiT9, E, MIXED, Wo_t, D, D, D, 32, 16, 1, 1, 0, 0, 0, 0); }
    SEAM(9);

#define LN_PHASE(Zp, gp, bp, outF, outB) do { \
        for (int m = gw; m < T; m += NGW) { \
            const f32x4* zr = (const f32x4*)((Zp) + (size_t)m * D) + lane; f32x4 v[16]; float s = 0.f; \
            _Pragma("unroll") for (int j = 0; j < 16; ++j) { v[j] = zr[64 * j]; s += (v[j][0] + v[j][1]) + (v[j][2] + v[j][3]); } \
            const float mean = wave_sum(s) * (1.0f / D); float s2 = 0.f; \
            _Pragma("unroll") for (int j = 0; j < 16; ++j) { v[j] = v[j] - mean; s2 += (v[j][0] * v[j][0] + v[j][1] * v[j][1]) + (v[j][2] * v[j][2] + v[j][3] * v[j][3]); } \
            const float rstd = rsqrtf(wave_sum(s2) * (1.0f / D) + LN_EPS); \
            _Pragma("unroll") for (int j = 0; j < 16; ++j) { const f32x4 gg = ((const f32x4*)(gp))[64 * j + lane], bb = ((const f32x4*)(bp))[64 * j + lane]; const f32x4 y = v[j] * rstd * gg + bb; \
                if ((outF) != nullptr) ((f32x4*)((outF) + (size_t)m * D))[64 * j + lane] = y; \
                if ((outB) != nullptr) { u32x2 w; w.x = cvt_pk_bf16(y[0], y[1]); w.y = cvt_pk_bf16(y[2], y[3]); ((u32x2*)((outB) + (size_t)m * D))[64 * j + lane] = w; } } \
        } } while (0)

    if (IN(11)) REP(11) { const int lane = lane_id();
        if (bx < 64) { pg8::EpiBf16 E{CK, D, 1.0f, 1, 0, 0, nullptr, 0.f}; pg8::Gemm g_{MEMB, Wck_t, D, D, D, 1, 0, 0, 0, 0}; pg8::Order S_; S_.init(4, 16, 1, 64, bx); pg8::gemm_phase<pg8::EpiBf16>(lds, g_, S_, E, wave); }
        else if (bx >= 128) { if (split) { CONV_WFI2((bx - 128) * NWAVES + wave, 128 * NWAVES); CONV_WCO(I_SQ / 2, I_SQ, (bx - 128) * NWAVES + wave, 128 * NWAVES); } }
        else { pg8::EpiBf16 E{CV, D, 1.0f, 1, 0, 0, nullptr, 0.f}; pg8::Gemm g_{MEMB, Wcv_t, D, D, D, 1, 0, 0, 0, 0}; pg8::Order S_; S_.init(4, 16, 1, 64, bx - 64); pg8::gemm_phase<pg8::EpiBf16>(lds, g_, S_, E, wave); }
    }
    SEAM(11);

    if (IN(12)) REP(12) {
        { pg8::EpiBf16 E{MQT, D, 1.0f, 4, (long)1024 * D, (long)256 * D, nullptr, 0.f}; GEMM_CALL(pg8::EpiBf16, E, CK, Wcq_r, D, D, 1024, 1, 16, 16, 4, (long)MEM * D, 1024, 0, 1024); }
        { pg8::EpiBf16 E{VWT, 1024, 1.0f, 4, (long)D * 1024, 256, nullptr, 0.f}; GEMM_CALL(pg8::EpiBf16, E, Wco_t, CV, D, D, 1024, 16, 1, 16, 4, 0, 1024, (long)MEM * D, 1024); }
        const int lane = lane_id();
        for (int it = gw; it < TM * 4; it += NGW) { const int row = it >> 2, h = it & 3;
            const bf16_t* cr = CK + (size_t)row * D + h * 1024 + lane * 8; const float* sp = S1V + h * 1024 + lane * 8; const float* cp = C1V + h * 1024 + lane * 8;
            float sa = 0.f, ca = 0.f;
#pragma unroll
            for (int j = 0; j < 2; ++j) { const u32x4 w_ = *(const u32x4*)(cr + j * 512); const f32x4 s0 = *(const f32x4*)(sp + j * 512), s1 = *(const f32x4*)(sp + j * 512 + 4), c0 = *(const f32x4*)(cp + j * 512), c1 = *(const f32x4*)(cp + j * 512 + 4);
                const f32x4 k0 = {bf_lo(w_.x), bf_hi(w_.x), bf_lo(w_.y), bf_hi(w_.y)}, k1 = {bf_lo(w_.z), bf_hi(w_.z), bf_lo(w_.w), bf_hi(w_.w)};
                sa += ((k0[0] * s0[0] + k0[1] * s0[1]) + (k0[2] * s0[2] + k0[3] * s0[3])) + ((k1[0] * s1[0] + k1[1] * s1[1]) + (k1[2] * s1[2] + k1[3] * s1[3]));
                ca += ((k0[0] * c0[0] + k0[1] * c0[1]) + (k0[2] * c0[2] + k0[3] * c0[3])) + ((k1[0] * c1[0] + k1[1] * c1[1]) + (k1[2] * c1[2] + k1[3] * c1[3])); }
            sa = wave_sum(sa); ca = wave_sum(ca);
            if (lane == 0) { const int o = (row >> 8) * 1024 + h * 256 + (row & 255); SXV[o] = sa; CXV[o] = ca; } }
    }
    SEAM(12);

    if (IN(13)) REP(13) { pg8::EpiF32 E{XS, 1024, 2, (long)SEQ * 1024, (long)T * 1024}; GEMM_CALL(pg8::EpiF32, E, ZB, MQT, D, D, 2048, 8, 4, 8, 2, (long)SEQ * D, 2048, (long)1024 * D, 2048); }
    SEAM(13);

    if (IN(14)) REP(14) { const int lane = lane_id();
        for (int it = gw; it < T * 4; it += NGW) {
            const size_t off = (size_t)it * 256 + lane * 4; const int tok = it >> 2, fo = (tok >> 11) * 1024 + (it & 3) * 256 + lane * 4;
            const f32x4 a0 = __builtin_nontemporal_load((const f32x4*)(XS + off)), a1 = __builtin_nontemporal_load((const f32x4*)(XS + (size_t)T * 1024 + off)), sx = *(const f32x4*)(SXV + fo), cx = *(const f32x4*)(CXV + fo);
            const f32x2 st = *(const f32x2*)(RS1 + (size_t)tok * 2);
            const float mean = st.x * (1.0f / D), rstd = rsqrtf(st.y * (1.0f / D) - mean * mean + LN_EPS);
            const f32x4 a = (((a0 + a1) - sx * mean) * rstd + cx) * 0.03125f;
            const float mx = wave_max(fmaxf(fmaxf(a[0], a[1]), fmaxf(a[2], a[3])));
            f32x4 e; e[0] = __expf(a[0] - mx); e[1] = __expf(a[1] - mx); e[2] = __expf(a[2] - mx); e[3] = __expf(a[3] - mx);
            const float inv = 1.0f / wave_sum((e[0] + e[1]) + (e[2] + e[3]));
            u32x2 w; w.x = cvt_pk_bf16(e[0] * inv, e[1] * inv); w.y = cvt_pk_bf16(e[2] * inv, e[3] * inv);
            *(u32x2*)(XP + off) = w;
        }
    }
    SEAM(14);
    if (IN(15)) REP(15) { typedef pg8::EpiResLN<WS_ZB, WS_RS1, WS_RS2, true, SEQ> EpiT15; EpiT15 E{ws, in_ln1_g, in_ln1_b}; GEMM_CALL(EpiT15, E, XP, VWT, 1024, 1024, 1024, 8, 16, 4, 1, (long)SEQ * 1024, 0, (long)D * 1024, 0); }
    SEAM(15);
    if (IN(17)) REP(17) { typedef pg8::EpiFfnConv<WS_ACT, WS_EDGE, WS_RS2, WS_S2, WS_C2, WS_CONVW, WS_CONVB> EpiT17; EpiT17 E{ws, (LAS unsigned*)(lds + TR_OFF)};
        GEMM_CALL(EpiT17, E, ZB, Wfi_t, D, D, D, 32, 86, 1, 1, 0, 0, 0, 0);
        const int lane = lane_id();
        if (split && bx >= 192) CONV_WFO((bx - 192) * NWAVES + wave, 64 * NWAVES); }
    SEAM(17);

    if (IN(18)) REP(18) { const int lane = lane_id();
        constexpr int CU8 = DFF / 8, NIT = 64 * CU8;
        for (int it = gtid; it < NIT; it += NGT) {
            const int pe = it / CU8, cu = it - pe * CU8, c0 = cu * 8, pmi = pe >> 1, bot = pe & 1;
            const int tp = ((c0 >> 7) * 256 + (c0 & 127)) >> 1;
            const unsigned* e0 = EDGE + (size_t)(pmi * 4) * (DFF2 / 2) + tp;
            const bool hasp = bot ? true : (pmi & 7) != 0, hasn = bot ? (pmi & 7) != 7 : true;
            const unsigned* pp = bot ? e0 + 2 * (size_t)(DFF2 / 2) : e0 - (size_t)(DFF2 / 2);
            const unsigned* pc = bot ? e0 + 3 * (size_t)(DFF2 / 2) : e0;
            const unsigned* pn_ = bot ? e0 + 4 * (size_t)(DFF2 / 2) : e0 + (size_t)(DFF2 / 2);
            const u32x4 z4 = {0u, 0u, 0u, 0u};
            const u32x4 up = hasp ? *(const u32x4*)pp : z4, uc = *(const u32x4*)pc, un = hasn ? *(const u32x4*)pn_ : z4;
            const u32x4 gp = hasp ? *(const u32x4*)(pp + 64) : z4, gc = *(const u32x4*)(pc + 64), gn = hasn ? *(const u32x4*)(pn_ + 64) : z4;
            float o[8];
#pragma unroll
            for (int q = 0; q < 4; ++q) { const int c = c0 + 2 * q;
                const float u0 = bf_lo(up[q]) * in_conv_w[c] + bf_lo(uc[q]) * in_conv_w[DFF2 + c] + bf_lo(un[q]) * in_conv_w[2 * (size_t)DFF2 + c] + in_conv_b[c];
                const float u1 = bf_hi(up[q]) * in_conv_w[c + 1] + bf_hi(uc[q]) * in_conv_w[DFF2 + c + 1] + bf_hi(un[q]) * in_conv_w[2 * (size_t)DFF2 + c + 1] + in_conv_b[c + 1];
                const float g0 = bf_lo(gp[q]) * in_conv_w[DFF + c] + bf_lo(gc[q]) * in_conv_w[DFF2 + DFF + c] + bf_lo(gn[q]) * in_conv_w[2 * (size_t)DFF2 + DFF + c] + in_conv_b[DFF + c];
                const float g1 = bf_hi(gp[q]) * in_conv_w[DFF + c + 1] + bf_hi(gc[q]) * in_conv_w[DFF2 + DFF + c + 1] + bf_hi(gn[q]) * in_conv_w[2 * (size_t)DFF2 + DFF + c + 1] + in_conv_b[DFF + c + 1];
                o[2 * q] = siluf_(g0) * u0; o[2 * q + 1] = siluf_(g1) * u1; }
            u32x4 w; w.x = cvt_pk_bf16(o[0], o[1]); w.y = cvt_pk_bf16(o[2], o[3]); w.z = cvt_pk_bf16(o[4], o[5]); w.w = cvt_pk_bf16(o[6], o[7]);
            *(u32x4*)(ACT + (size_t)(pmi * 256 + (bot ? 255 : 0)) * DFF + c0) = w;
        }
    }
    SEAM(18);
    if (IN(19)) REP(19) { typedef pg8::EpiResLN<WS_ZB, WS_RS2, WS_RS3, false> EpiT19; EpiT19 E{ws, in_ln2_g, in_ln2_b}; GEMM_CALL(EpiT19, E, ACT, Wfo_t, DFF, DFF, DFF, 32, 16, 1, 1, 0, 0, 0, 0); }
    SEAM(19);
    if (IN(20)) REP(20) { const int lane = lane_id();
        for (int m = gw; m < T; m += NGW) {
            const u32x4* zr = (const u32x4*)(ZB + (size_t)m * D) + lane; f32x4* orow = (f32x4*)(args.out + (size_t)m * D);
            f32x4 z[16]; float s_ = 0.f;
#pragma unroll
            for (int j = 0; j < 8; ++j) { const u32x4 zw = __builtin_nontemporal_load(zr + 64 * j); z[2 * j] = (f32x4){bf_lo(zw.x), bf_hi(zw.x), bf_lo(zw.y), bf_hi(zw.y)}; z[2 * j + 1] = (f32x4){bf_lo(zw.z), bf_hi(zw.z), bf_lo(zw.w), bf_hi(zw.w)};
                s_ += ((z[2 * j][0] + z[2 * j][1]) + (z[2 * j][2] + z[2 * j][3])) + ((z[2 * j + 1][0] + z[2 * j + 1][1]) + (z[2 * j + 1][2] + z[2 * j + 1][3])); }
            const float mean = wave_sum(s_) * (1.0f / D); float q_ = 0.f;
#pragma unroll
            for (int j = 0; j < 16; ++j) { z[j] = z[j] - mean; q_ += (z[j][0] * z[j][0] + z[j][1] * z[j][1]) + (z[j][2] * z[j][2] + z[j][3] * z[j][3]); }
            const float rstd = rsqrtf(wave_sum(q_) * (1.0f / D) + LN_EPS);
#pragma unroll
            for (int j = 0; j < 8; ++j) { const int c4 = (64 * j + lane) * 2;
                const f32x4 g0 = ((const f32x4*)in_ln3_g)[c4], g1 = ((const f32x4*)in_ln3_g)[c4 + 1], b0 = ((const f32x4*)in_ln3_b)[c4], b1 = ((const f32x4*)in_ln3_b)[c4 + 1];
                __builtin_nontemporal_store(z[2 * j] * rstd * g0 + b0, orow + c4); __builtin_nontemporal_store(z[2 * j + 1] * rstd * g1 + b1, orow + c4 + 1); }
        }
    }
#undef IN
#undef SEAM
}

extern "C" void kernel_launch(void* const* d_in, const int* in_sizes, int n_in, void* d_out, int out_size, void* d_ws, size_t ws_size, hipStream_t stream) {
    static int grid = 0;
    if (grid == 0) {
        if (n_in != 28 || in_sizes[0] != T * D || out_size != T * D || ws_size < WS_END) { fprintf(stderr, "kernel_launch: unexpected shapes (n_in %d, in0 %d, out %d, ws %zu < %zu)\n", n_in, n_in > 0 ? in_sizes[0] : -1, out_size, ws_size, (size_t)WS_END); grid = -1; return; }
        int dev = 0, cus = 0, per_cu = 0;
        if (hipGetDevice(&dev) != hipSuccess || hipDeviceGetAttribute(&cus, hipDeviceAttributeMultiprocessorCount, dev) != hipSuccess) { grid = -1; return; }
        if (hipFuncSetAttribute((const void*)mk_fwd, hipFuncAttributeMaxDynamicSharedMemorySize, LDS_BYTES) != hipSuccess) { fprintf(stderr, "kernel_launch: hipFuncSetAttribute failed\n"); grid = -1; return; }
        if (hipOccupancyMaxActiveBlocksPerMultiprocessor(&per_cu, (const void*)mk_fwd, NWAVES * 64, LDS_BYTES) != hipSuccess || per_cu < 1) fprintf(stderr, "kernel_launch: occupancy query says %d\n", per_cu);
        (void)hipGetLastError();
        grid = cus;
    }
    if (grid < 0) return;
    (void)hipMemsetAsync((char*)d_ws + WS_CTL, 0, CTL_ZERO_BYTES, stream);
    Args a{};
    for (int i = 0; i < 28; ++i) a.in[i] = d_in[i];
    a.out = (float*)d_out; a.ws = (unsigned char*)d_ws;
#if MK_PER_PHASE
    for (int p = 0; p < NPHASE; ++p) { a.ph_lo = p; a.ph_hi = p + 1; hipLaunchKernelGGL(mk_fwd, dim3(grid), dim3(NWAVES * 64), LDS_BYTES, stream, a); }
#else
    a.ph_lo = 0; a.ph_hi = NPHASE; hipLaunchKernelGGL(mk_fwd, dim3(grid), dim3(NWAVES * 64), LDS_BYTES, stream, a);
#endif
    const hipError_t le = hipPeekAtLastError();
    if (le != hipSuccess) fprintf(stderr, "kernel_launch: launch failed: %s\n", hipGetErrorName(le));
}
```

```cpp
#include <hip/hip_runtime.h>
#include <cstdio>
#include <cstdint>

#ifndef MK_PER_PHASE
#define MK_PER_PHASE 0
#endif

#define LAS __attribute__((address_space(3)))
#define GAS __attribute__((address_space(1)))
typedef unsigned short bf16_t;
typedef short bf16x8 __attribute__((ext_vector_type(8)));
typedef short s16x4 __attribute__((ext_vector_type(4)));
typedef float f32x2 __attribute__((ext_vector_type(2)));
typedef float f32x4 __attribute__((ext_vector_type(4)));
typedef float f32x16 __attribute__((ext_vector_type(16)));
typedef unsigned u32x2 __attribute__((ext_vector_type(2)));
typedef unsigned u32x4 __attribute__((ext_vector_type(4)));

constexpr int NB = 4, SEQ = 2048, T = NB * SEQ, D = 4096;
constexpr int MEM = 256, TM = NB * MEM;
constexpr int INW = 22080, INP = 22272;
constexpr int DFF = 11008, DFF2 = 22016;
constexpr float ALPHA = 1.189207115002721f;
constexpr float LN_EPS = 1e-5f, RMS_EPS = 1e-6f;
constexpr int NWAVES = 8;
constexpr int GTP = 8192 + 128, RGP = 4096 + 64;

constexpr size_t MiB = 1u << 20;
constexpr size_t WS_CTL = 0, CTL_ZERO_BYTES = 640 * 1024;
constexpr size_t WS_RSS = 64 * 1024;
constexpr size_t WS_RS1 = 128 * 1024, WS_RS2 = 192 * 1024, WS_RS3 = 256 * 1024;
constexpr size_t WS_S1 = 320 * 1024, WS_C1 = 336 * 1024;
constexpr size_t WS_S2 = 352 * 1024, WS_C2 = 448 * 1024;
constexpr size_t WS_CONVW = 640 * 1024;
constexpr size_t WS_CONVB = WS_CONVW + 3 * (size_t)DFF2 * 4;
constexpr size_t WS_MISC = 1000 * 1024;
constexpr size_t WS_WIN = 1 * MiB;
constexpr size_t WS_WFI = 175 * MiB;
constexpr size_t WS_WFO = 347 * MiB;
constexpr size_t WS_WBR = 433 * MiB;
constexpr size_t WS_WO = 465 * MiB, WS_WCQ = 497 * MiB, WS_WCK = 529 * MiB, WS_WCV = 561 * MiB, WS_WCO = 593 * MiB;
constexpr size_t WS_WBM = 625 * MiB;
constexpr size_t WS_WUQ = 641 * MiB;
constexpr size_t WS_WUKV = 647 * MiB;
constexpr size_t WS_MEMB = 651 * MiB;
constexpr size_t WS_ROPER = 659 * MiB;
constexpr size_t WS_ROPEA = 667 * MiB;
constexpr size_t WS_XB = 670 * MiB;
constexpr size_t WS_ROUT = 670 * MiB;
constexpr size_t WS_CQM = 734 * MiB;
constexpr size_t WS_CKV = 750 * MiB;
constexpr size_t WS_KPE = 758 * MiB;
constexpr size_t WS_RQ = 759 * MiB;
constexpr size_t WS_RK = 791 * MiB;
constexpr size_t WS_RVT = 823 * MiB;
constexpr size_t WS_RG = 1335 * MiB;
constexpr size_t WS_GT = 887 * MiB;
constexpr size_t WS_SC = 1079 * MiB;
constexpr size_t WS_END = 1400 * MiB;
constexpr size_t WS_AO = 1 * MiB;
constexpr size_t WS_Q = 33 * MiB;
constexpr size_t WS_KV = 81 * MiB;
constexpr size_t WS_ORET = 33 * MiB;
constexpr size_t WS_TMP = 1079 * MiB;
constexpr size_t WS_MIXED = 1207 * MiB;
constexpr size_t WS_Z = 887 * MiB;
constexpr size_t WS_ZB = 1015 * MiB;
constexpr size_t WS_MQT = 1079 * MiB;
constexpr size_t WS_VWT = 1111 * MiB;
constexpr size_t WS_CK = 1143 * MiB;
constexpr size_t WS_CV = 1151 * MiB;
constexpr size_t WS_XS = 1159 * MiB;
constexpr size_t WS_XP = 1223 * MiB;
constexpr size_t WS_SX = 1239 * MiB, WS_CX = WS_SX + 16384;
constexpr size_t WS_EDGE = 433 * MiB;
constexpr size_t WS_ACT = 1 * MiB;

constexpr int CW_BAR = 4096;

constexpr int RING_BYTES = 131072;
constexpr int LDSCTL_OFF = RING_BYTES, MISC_OFF = LDSCTL_OFF + 320;
constexpr int TR_OFF = RING_BYTES + 1024, TR_BYTES = 8 * 2048;
constexpr int LDS_BYTES = 155648;
static_assert(TR_OFF + TR_BYTES <= LDS_BYTES && MISC_OFF + 128 <= TR_OFF, "LDS map");

#define LDS_WAIT() asm volatile("s_waitcnt lgkmcnt(0)" ::: "memory")
#define VM_WAIT() asm volatile("s_waitcnt vmcnt(0)" ::: "memory")

typedef __bf16 bf16x2_t __attribute__((ext_vector_type(2)));
__device__ __forceinline__ unsigned cvt_pk_bf16(float lo, float hi) { const f32x2 v = {lo, hi}; const bf16x2_t b = __builtin_convertvector(v, bf16x2_t); return __builtin_bit_cast(unsigned, b); }
__device__ __forceinline__ int lane_id() { int l; asm volatile("v_mbcnt_lo_u32_b32 %0, -1, 0\n\tv_mbcnt_hi_u32_b32 %0, -1, %0" : "=v"(l)); return l; }
__device__ __forceinline__ float bf_lo(unsigned w) { return __uint_as_float(w << 16); }
__device__ __forceinline__ float bf_hi(unsigned w) { return __uint_as_float(w & 0xffff0000u); }
__device__ __forceinline__ float sigmoidf_(float x) { return __builtin_amdgcn_rcpf(1.0f + __expf(-x)); }
__device__ __forceinline__ float siluf_(float x) { return x * __builtin_amdgcn_rcpf(1.0f + __expf(-x)); }
__device__ __forceinline__ void rope_cs(float pos, float invr, float& c, float& s_) { const float xr = __builtin_amdgcn_fractf(pos * invr); c = __builtin_amdgcn_cosf(xr); s_ = __builtin_amdgcn_sinf(xr); }
__device__ __forceinline__ float rope_invr(int i, float half_inv) { return exp2f(-(float)i * (13.287712379549449f * half_inv)) * 0.15915494309189535f; }
__device__ __forceinline__ float dpp_ror1(float x)  { return __builtin_bit_cast(float, __builtin_amdgcn_update_dpp(0, __builtin_bit_cast(int, x), 0x121, 0xf, 0xf, false)); }
__device__ __forceinline__ float dpp_ror15(float x) { return __builtin_bit_cast(float, __builtin_amdgcn_update_dpp(0, __builtin_bit_cast(int, x), 0x12f, 0xf, 0xf, false)); }
__device__ __forceinline__ float wave_sum(float v) {
#pragma unroll
    for (int o = 1; o < 64; o <<= 1) v += __shfl_xor(v, o);
    return v;
}
__device__ __forceinline__ float wave_max(float v) {
#pragma unroll
    for (int o = 1; o < 64; o <<= 1) v = fmaxf(v, __shfl_xor(v, o));
    return v;
}

#ifndef PG8_SP2
#define PG8_SP2 1
#endif
namespace pg8 {
constexpr int BM = 256, BK = 64, HALF = 128, HTB = HALF * BK * 2, STAGE_BYTES = 8 * HTB, NXCD = 8, WGM = 8;
__host__ __device__ __forceinline__ int lds_byte(int r, int c) { const int st = (r >> 4) * 2 + (c >> 5), rr = r & 15, cc = c & 31, ob = rr * 64 + cc * 2; return st * 1024 + (ob ^ (((ob >> 9) & 1) << 5)); }
__host__ __device__ __forceinline__ void stage_rc(int b, int& R, int& C) { const int st = b / 1024, sb = b % 1024, swz = sb ^ (((sb >> 9) & 1) << 5); R = (st >> 1) * 16 + swz / 64; C = (st & 1) * 32 + (swz % 64) / 2; }
__host__ __device__ __forceinline__ int perm32(int rho) { const int n = rho >> 4, i = rho & 15; return 8 * (i >> 2) + 4 * n + (i & 3); }

struct Unit { int pm, pn, z; };
struct Gemm { const bf16_t* A; const bf16_t* Bt; int lda, ldb, K, nh; long sAb, sAh, sBb, sBh; };

struct Order {
    int nM, nN, per, ntot, G, c;
    __device__ __forceinline__ void init(int nM_, int nN_, int nZ_, int G_, int c_) { nM = nM_; nN = nN_; per = nM_ * nN_; ntot = per * nZ_; G = G_; c = c_; }
    __device__ __forceinline__ bool next(int i, Unit& u) const {
        const long L = (long)i * G + c; if (L >= ntot) return false;
        int id = (int)L; { const int q = ntot / NXCD, r = ntot % NXCD, xcd = id % NXCD, off = id / NXCD; id = (xcd < r ? xcd * (q + 1) : r * (q + 1) + (xcd - r) * q) + off; }
        u.z = id / per; const int w = id % per;
        const int nig = WGM * nN, gid = w / nig, fm = gid * WGM, gsz = (nM - fm) < WGM ? (nM - fm) : WGM;
        u.pm = fm + ((w % nig) % gsz); u.pn = (w % nig) / gsz; return true;
    }
};

typedef f32x4 Acc[2][2][4][2];

template <class Epi>
__device__ __forceinline__ void gemm_phase(LAS unsigned char* lds, const Gemm g, const Order& S, const Epi& E, const int wid) {
    const int wr = wid >> 2, wc = wid & 3;
    const int K = g.K, nt = K / BK;
    const size_t kstep = (size_t)(BK * 2);
    const size_t hA = (size_t)HALF * g.lda * 2, hB = (size_t)HALF * g.ldb * 2;
    const unsigned ldsw = (unsigned)wid * 1024u;
    unsigned voffA[2], voffB[2]; int aoff, boff;
#define PG8_LANESETUP() do { const int lane_ = lane_id(), tid_ = wid * 64 + lane_; \
        _Pragma("unroll") for (int i = 0; i < 2; ++i) { int R, C; stage_rc(tid_ * 16 + i * 8192, R, C); const int Rb = Epi::PERM ? ((R & ~31) + perm32(R & 31)) : R; \
            voffA[i] = (unsigned)(R * g.lda + C) * 2u; voffB[i] = (unsigned)(Rb * g.ldb + C) * 2u; } \
        aoff = lds_byte(wr * 64 + (lane_ & 15), (lane_ >> 4) * 8); boff = lds_byte(wc * 32 + (lane_ & 15), (lane_ >> 4) * 8); } while (0)
    PG8_LANESETUP();
#define PG8_SA(b, h) (((b) * 2 + (h)) * HTB)
#define PG8_SB(b, h) ((4 + (b) * 2 + (h)) * HTB)
#define PG8_STAGE(bufoff, gbase, voff) do { _Pragma("unroll") for (int _i = 0; _i < 2; ++_i) \
        __builtin_amdgcn_global_load_lds((const unsigned*)((const char*)(gbase) + (voff)[_i]), (LAS unsigned*)(lds + (bufoff) + ldsw + _i * 8192), 16, 0, 0); } while (0)
#define PG8_LDA(dst, b, h) do { _Pragma("unroll") for (int m = 0; m < 4; ++m) _Pragma("unroll") for (int k = 0; k < 2; ++k) dst[m][k] = *(const LAS bf16x8*)(lds + PG8_SA(b, h) + aoff + m * 2048 + k * 1024); } while (0)
#define PG8_LDB(dst, b, h) do { _Pragma("unroll") for (int n = 0; n < 2; ++n) _Pragma("unroll") for (int k = 0; k < 2; ++k) dst[n][k] = *(const LAS bf16x8*)(lds + PG8_SB(b, h) + boff + n * 2048 + k * 1024); } while (0)
#define PG8_MMA(ai, bj, At, Bt) do { __builtin_amdgcn_s_setprio(1); _Pragma("unroll") for (int m = 0; m < 4; ++m) _Pragma("unroll") for (int n = 0; n < 2; ++n) _Pragma("unroll") for (int k = 0; k < 2; ++k) \
        acc[ai][bj][m][n] = __builtin_amdgcn_mfma_f32_16x16x32_bf16(Bt[n][k], At[m][k], acc[ai][bj][m][n], 0, 0, 0); __builtin_amdgcn_s_setprio(0); } while (0)
#define PG8_WAIT_V(n) asm volatile("s_waitcnt vmcnt(" #n ")" ::: "memory")
#define PG8_WAIT_L(n) asm volatile("s_waitcnt lgkmcnt(" #n ")" ::: "memory")
#define PG8_BAR __builtin_amdgcn_s_barrier()
#define PG8_SCHED __builtin_amdgcn_sched_barrier(0)
    Unit cur, nxt; int ui = 0;
    if (!S.next(0, cur)) return;
    Acc acc;
#pragma unroll
    for (int a = 0; a < 2; ++a)
#pragma unroll
        for (int b = 0; b < 2; ++b)
#pragma unroll
            for (int m = 0; m < 4; ++m)
#pragma unroll
                for (int n = 0; n < 2; ++n) acc[a][b][m][n] = (f32x4){0.f, 0.f, 0.f, 0.f};
    bf16x8 At[4][2], B0[2][2], B1[2][2];
#define PG8_APTR(u) ((const char*)g.A + ((size_t)((u).z / g.nh) * g.sAb + (size_t)((u).z % g.nh) * g.sAh + (size_t)(u).pm * BM * g.lda) * 2)
#define PG8_BPTR(u) ((const char*)g.Bt + ((size_t)((u).z / g.nh) * g.sBb + (size_t)((u).z % g.nh) * g.sBh + (size_t)(u).pn * BM * g.ldb) * 2)
    const char* cA = PG8_APTR(cur); const char* cB = PG8_BPTR(cur);
#if PG8_SP2
    PG8_STAGE(PG8_SB(0, 0), cB, voffB); PG8_STAGE(PG8_SB(0, 1), cB + hB, voffB); PG8_STAGE(PG8_SA(0, 0), cA, voffA); PG8_STAGE(PG8_SA(0, 1), cA + hA, voffA);
    if (wr == 1) PG8_BAR;
    PG8_WAIT_V(2); PG8_BAR;
    PG8_STAGE(PG8_SB(1, 0), cB + kstep, voffB); PG8_STAGE(PG8_SA(1, 0), cA + kstep, voffA); PG8_STAGE(PG8_SB(1, 1), cB + hB + kstep, voffB);
    PG8_WAIT_V(6); PG8_BAR;
#else
    PG8_STAGE(PG8_SB(0, 0), cB, voffB); PG8_STAGE(PG8_SA(0, 0), cA, voffA); PG8_STAGE(PG8_SB(0, 1), cB + hB, voffB); PG8_STAGE(PG8_SA(0, 1), cA + hA, voffA);
    if (wr == 1) PG8_BAR;
    PG8_WAIT_V(4); PG8_BAR;
    PG8_STAGE(PG8_SB(1, 0), cB + kstep, voffB); PG8_STAGE(PG8_SA(1, 0), cA + kstep, voffA); PG8_STAGE(PG8_SB(1, 1), cB + hB + kstep, voffB);
    PG8_WAIT_V(6); PG8_BAR;
#endif
    for (;;) {
        const bool has_next = S.next(ui + 1, nxt);
        const char* nA = has_next ? PG8_APTR(nxt) : cA; const char* nB = has_next ? PG8_BPTR(nxt) : cB;
        for (int t = 0; t < nt; t += 2) {
            const bool last = (t == nt - 2);
            const char* a1 = cA + (size_t)(t + 1) * kstep;
            const char* a2 = last ? nA : cA + (size_t)(t + 2) * kstep; const char* b2 = last ? nB : cB + (size_t)(t + 2) * kstep;
            const char* a3 = a2 + kstep; const char* b3 = b2 + kstep;
#if PG8_SP2
            PG8_LDB(B0, 0, 0); PG8_LDB(B1, 0, 1); PG8_SCHED; PG8_LDA(At, 0, 0); PG8_STAGE(PG8_SA(1, 1), a1 + hA, voffA);
            PG8_WAIT_V(8); PG8_WAIT_L(0); PG8_BAR; PG8_MMA(0, 0, At, B0); PG8_MMA(0, 1, At, B1); PG8_BAR; PG8_SCHED;
            PG8_LDA(At, 0, 1); PG8_STAGE(PG8_SB(0, 0), b2, voffB); PG8_STAGE(PG8_SB(0, 1), b2 + hB, voffB); PG8_STAGE(PG8_SA(0, 0), a2, voffA);
            PG8_WAIT_V(8); PG8_WAIT_L(0); PG8_BAR; PG8_MMA(1, 0, At, B0); PG8_MMA(1, 1, At, B1); PG8_BAR; PG8_SCHED;
            PG8_LDB(B0, 1, 0); PG8_LDB(B1, 1, 1); PG8_SCHED; PG8_LDA(At, 1, 0); PG8_STAGE(PG8_SA(0, 1), a2 + hA, voffA);
            PG8_WAIT_V(8); PG8_WAIT_L(0); PG8_BAR; PG8_MMA(0, 0, At, B0); PG8_MMA(0, 1, At, B1); PG8_BAR; PG8_SCHED;
            PG8_LDA(At, 1, 1); PG8_STAGE(PG8_SB(1, 0), b3, voffB); PG8_STAGE(PG8_SB(1, 1), b3 + hB, voffB); PG8_STAGE(PG8_SA(1, 0), a3, voffA);
            PG8_WAIT_V(8); PG8_WAIT_L(0); PG8_BAR; PG8_MMA(1, 0, At, B0); PG8_MMA(1, 1, At, B1); PG8_BAR; PG8_SCHED;
#else
            PG8_LDB(B0, 0, 0); PG8_SCHED; PG8_LDA(At, 0, 0); PG8_STAGE(PG8_SA(1, 1), a1 + hA, voffA);
            PG8_WAIT_L(8); PG8_BAR; PG8_WAIT_L(0); PG8_MMA(0, 0, At, B0); PG8_BAR; PG8_SCHED;
            PG8_LDB(B1, 0, 1); PG8_STAGE(PG8_SB(0, 0), b2, voffB);
            PG8_BAR; PG8_WAIT_L(0); PG8_MMA(0, 1, At, B1); PG8_BAR;
            PG8_LDA(At, 0, 1); PG8_STAGE(PG8_SA(0, 0), a2, voffA);
            PG8_BAR; PG8_WAIT_L(0); PG8_MMA(1, 0, At, B0); PG8_BAR; PG8_SCHED;
            PG8_STAGE(PG8_SB(0, 1), b2 + hB, voffB);
            PG8_WAIT_V(6); PG8_BAR; PG8_MMA(1, 1, At, B1); PG8_BAR;
            PG8_LDB(B0, 1, 0); PG8_SCHED; PG8_LDA(At, 1, 0); PG8_STAGE(PG8_SA(0, 1), a2 + hA, voffA);
            PG8_WAIT_L(8); PG8_BAR; PG8_WAIT_L(0); PG8_MMA(0, 0, At, B0); PG8_BAR; PG8_SCHED;
            PG8_LDB(B1, 1, 1); PG8_STAGE(PG8_SB(1, 0), b3, voffB);
            PG8_BAR; PG8_WAIT_L(0); PG8_MMA(0, 1, At, B1); PG8_BAR;
            PG8_LDA(At, 1, 1); PG8_STAGE(PG8_SA(1, 0), a3, voffA);
            PG8_BAR; PG8_WAIT_L(0); PG8_MMA(1, 0, At, B0); PG8_BAR; PG8_SCHED;
            PG8_STAGE(PG8_SB(1, 1), b3 + hB, voffB);
            PG8_WAIT_V(6); PG8_BAR; PG8_MMA(1, 1, At, B1); PG8_BAR;
#endif
        }
        if (wr == 0) PG8_BAR;
        { const int le_ = lane_id(); E(acc, cur, wr, wc, le_ & 15, le_ >> 4); }
        if (!has_next) break;
#pragma unroll
        for (int a = 0; a < 2; ++a)
#pragma unroll
            for (int b = 0; b < 2; ++b)
#pragma unroll
                for (int m = 0; m < 4; ++m)
#pragma unroll
                    for (int n = 0; n < 2; ++n) acc[a][b][m][n] = (f32x4){0.f, 0.f, 0.f, 0.f};
        cur = nxt; cA = nA; cB = nB; ++ui;
        PG8_LANESETUP();
        if (wr == 1) PG8_BAR;
    }
    PG8_WAIT_V(0);
    PG8_BAR;
#undef PG8_LANESETUP
#undef PG8_APTR
#undef PG8_BPTR
#undef PG8_SA
#undef PG8_SB
#undef PG8_STAGE
#undef PG8_LDA
#undef PG8_LDB
#undef PG8_MMA
#undef PG8_WAIT_V
#undef PG8_WAIT_L
#undef PG8_BAR
#undef PG8_SCHED
}

__device__ __forceinline__ u32x4 pack8(const f32x4 v0, const f32x4 v1) { u32x4 w; w.x = cvt_pk_bf16(v0[0], v0[1]); w.y = cvt_pk_bf16(v0[2], v0[3]); w.z = cvt_pk_bf16(v1[0], v1[1]); w.w = cvt_pk_bf16(v1[2], v1[3]); return w; }

struct EpiBf16 {
    static constexpr bool PERM = true;
    bf16_t* O; int ldc; float scale; int nh; long sb, sh; const float* rss; float rinv;
    __device__ __forceinline__ void operator()(const Acc& acc, const Unit& u, int wr, int wc, int fr, int fq) const {
        bf16_t* base = O + (size_t)(u.z / nh) * sb + (size_t)(u.z % nh) * sh;
        const int row0 = u.pm * BM + wr * 64 + fr, col0 = u.pn * BM + wc * 32 + 8 * fq;
#pragma unroll
        for (int ai = 0; ai < 2; ++ai)
#pragma unroll
            for (int m = 0; m < 4; ++m) { const int row = row0 + ai * HALF + m * 16; float sc = scale; if (rss) sc *= rsqrtf(rss[row] * rinv + RMS_EPS);
                bf16_t* rowp = base + (size_t)row * ldc + col0;
#pragma unroll
                for (int bj = 0; bj < 2; ++bj) *(u32x4*)(rowp + bj * HALF) = pack8(acc[ai][bj][m][0] * sc, acc[ai][bj][m][1] * sc); }
    }
};
template <size_t O_OFF, int ldc, size_t RS_OFF, size_t SV_OFF, size_t CV_OFF> struct EpiBf16LN {
    static constexpr bool PERM = true;
    unsigned char* wsb; float scale;
    __device__ __forceinline__ void operator()(const Acc& acc, const Unit& u, int wr, int wc, int fr, int fq) const {
        bf16_t* O = (bf16_t*)(wsb + O_OFF); const float* rs = (const float*)(wsb + RS_OFF); const float* sv = (const float*)(wsb + SV_OFF); const float* cv = (const float*)(wsb + CV_OFF);
        const int row0 = u.pm * BM + wr * 64 + fr, col0 = u.pn * BM + wc * 32 + 8 * fq;
        f32x2 st[2][4]; f32x4 s4[2][2], c4[2][2];
#pragma unroll
        for (int ai = 0; ai < 2; ++ai)
#pragma unroll
            for (int m = 0; m < 4; ++m) st[ai][m] = *(const f32x2*)(rs + (size_t)(row0 + ai * HALF + m * 16) * 2);
#pragma unroll
        for (int bj = 0; bj < 2; ++bj)
#pragma unroll
            for (int n = 0; n < 2; ++n) { s4[bj][n] = *(const f32x4*)(sv + col0 + bj * HALF + 4 * n); c4[bj][n] = *(const f32x4*)(cv + col0 + bj * HALF + 4 * n); }
        asm volatile("" ::: "memory");
#pragma unroll
        for (int ai = 0; ai < 2; ++ai)
#pragma unroll
            for (int m = 0; m < 4; ++m) { const int row = row0 + ai * HALF + m * 16; const float mean = st[ai][m].x * (1.0f / D), rstd = rsqrtf(st[ai][m].y * (1.0f / D) - mean * mean + LN_EPS) * scale;
                bf16_t* rowp = O + (size_t)row * ldc + col0;
#pragma unroll
                for (int bj = 0; bj < 2; ++bj) *(u32x4*)(rowp + bj * HALF) = pack8((acc[ai][bj][m][0] - s4[bj][0] * mean) * rstd + c4[bj][0] * scale, (acc[ai][bj][m][1] - s4[bj][1] * mean) * rstd + c4[bj][1] * scale); }
    }
};
struct EpiF32 {
    static constexpr bool PERM = false;
    float* C; int ldc; int nh; long sb, sh;
    __device__ __forceinline__ void operator()(const Acc& acc, const Unit& u, int wr, int wc, int fr, int fq) const {
        float* base = C + (size_t)(u.z / nh) * sb + (size_t)(u.z % nh) * sh;
        const int row0 = u.pm * BM + wr * 64 + fr, col0 = u.pn * BM + wc * 32 + 4 * fq;
#pragma unroll
        for (int ai = 0; ai < 2; ++ai)
#pragma unroll
            for (int m = 0; m < 4; ++m) { float* rowp = base + (size_t)(row0 + ai * HALF + m * 16) * ldc + col0;
#pragma unroll
                for (int bj = 0; bj < 2; ++bj)
#pragma unroll
                    for (int n = 0; n < 2; ++n) *(f32x4*)(rowp + bj * HALF + n * 16) = acc[ai][bj][m][n]; }
    }
};
__device__ __forceinline__ void row_stat_add(float* rs, int row, float s_, float q_, int fq) {
    s_ += __shfl_xor(s_, 16); s_ += __shfl_xor(s_, 32); q_ += __shfl_xor(q_, 16); q_ += __shfl_xor(q_, 32);
    if (fq < 2) atomicAdd(rs + (size_t)row * 2 + fq, fq == 0 ? s_ : q_);
}
template <size_t ZB_OFF, size_t RS_OFF> struct EpiResStat {
    static constexpr bool PERM = true;
    unsigned char* wsb; const float* base;
    __device__ __forceinline__ void operator()(const Acc& acc, const Unit& u, int wr, int wc, int fr, int fq) const {
        bf16_t* ZB = (bf16_t*)(wsb + ZB_OFF); float* rs = (float*)(wsb + RS_OFF);
        const int row0 = u.pm * BM + wr * 64 + fr, col0 = u.pn * BM + wc * 32 + 8 * fq;
#pragma unroll
        for (int ah = 0; ah < 4; ++ah) { const int ai = ah >> 1, mh = ah & 1; f32x4 bs[2][2][2];
#pragma unroll
            for (int ml = 0; ml < 2; ++ml)
#pragma unroll
                for (int bj = 0; bj < 2; ++bj)
#pragma unroll
                    for (int n = 0; n < 2; ++n) bs[ml][bj][n] = *(const f32x4*)(base + (size_t)(row0 + ai * HALF + (2 * mh + ml) * 16) * D + col0 + bj * HALF + 4 * n);
            asm volatile("" ::: "memory");
#pragma unroll
            for (int ml = 0; ml < 2; ++ml) { const int m = 2 * mh + ml, row = row0 + ai * HALF + m * 16; const size_t off = (size_t)row * D + col0; float s_ = 0.f, q_ = 0.f;
#pragma unroll
                for (int bj = 0; bj < 2; ++bj) { f32x4 z[2];
#pragma unroll
                    for (int n = 0; n < 2; ++n) { z[n] = bs[ml][bj][n] * ALPHA + acc[ai][bj][m][n];
                        s_ += (z[n][0] + z[n][1]) + (z[n][2] + z[n][3]); q_ += (z[n][0] * z[n][0] + z[n][1] * z[n][1]) + (z[n][2] * z[n][2] + z[n][3] * z[n][3]); }
                    *(u32x4*)(ZB + off + bj * HALF) = pack8(z[0], z[1]); }
                row_stat_add(rs, row, s_, q_, fq); }
            asm volatile("" ::: "memory"); }
    }
};
template <size_t ZB_OFF, size_t RSIN_OFF, size_t RSOUT_OFF, bool STATS, int ZR = 0> struct EpiResLN {
    static constexpr bool PERM = true;
    unsigned char* wsb; const float* g; const float* b;
    __device__ __forceinline__ void operator()(const Acc& acc, const Unit& u, int wr, int wc, int fr, int fq) const {
        bf16_t* ZB = (bf16_t*)(wsb + ZB_OFF); const float* rsin = (const float*)(wsb + RSIN_OFF); float* rsout = (float*)(wsb + RSOUT_OFF);
        const int row0 = u.z * ZR + u.pm * BM + wr * 64 + fr, col0 = u.pn * BM + wc * 32 + 8 * fq;
        f32x4 g4[2][2], b4[2][2];
#pragma unroll
        for (int bj = 0; bj < 2; ++bj)
#pragma unroll
            for (int n = 0; n < 2; ++n) { g4[bj][n] = *(const f32x4*)(g + col0 + bj * HALF + 4 * n); b4[bj][n] = *(const f32x4*)(b + col0 + bj * HALF + 4 * n); }
#pragma unroll
        for (int ah = 0; ah < 4; ++ah) { const int ai = ah >> 1, mh = ah & 1; u32x4 zw[2][2]; f32x2 st[2];
#pragma unroll
            for (int ml = 0; ml < 2; ++ml) { const size_t row = (size_t)(row0 + ai * HALF + (2 * mh + ml) * 16); st[ml] = *(const f32x2*)(rsin + row * 2);
#pragma unroll
                for (int bj = 0; bj < 2; ++bj) zw[ml][bj] = *(const u32x4*)(ZB + row * D + col0 + bj * HALF); }
            asm volatile("" ::: "memory");
#pragma unroll
            for (int ml = 0; ml < 2; ++ml) { const int m = 2 * mh + ml, row = row0 + ai * HALF + m * 16; const size_t off = (size_t)row * D + col0; float s_ = 0.f, q_ = 0.f;
                const float mean = st[ml].x * (1.0f / D), rstd = rsqrtf(st[ml].y * (1.0f / D) - mean * mean + LN_EPS);
#pragma unroll
                for (int bj = 0; bj < 2; ++bj) { const u32x4 w_ = zw[ml][bj]; f32x4 z[2];
                    const f32x4 zo0 = {bf_lo(w_.x), bf_hi(w_.x), bf_lo(w_.y), bf_hi(w_.y)}, zo1 = {bf_lo(w_.z), bf_hi(w_.z), bf_lo(w_.w), bf_hi(w_.w)};
                    z[0] = ((zo0 - mean) * rstd * g4[bj][0] + b4[bj][0]) * ALPHA + acc[ai][bj][m][0]; z[1] = ((zo1 - mean) * rstd * g4[bj][1] + b4[bj][1]) * ALPHA + acc[ai][bj][m][1];
#pragma unroll
                    for (int n = 0; n < 2; ++n) { s_ += (z[n][0] + z[n][1]) + (z[n][2] + z[n][3]); q_ += (z[n][0] * z[n][0] + z[n][1] * z[n][1]) + (z[n][2] * z[n][2] + z[n][3] * z[n][3]); }
                    *(u32x4*)(ZB + off + bj * HALF) = pack8(z[0], z[1]); }
                if (STATS) row_stat_add(rsout, row, s_, q_, fq); }
            asm volatile("" ::: "memory"); }
    }
};
struct EpiGate0 {
    static constexpr bool PERM = true;
    bf16_t* C; const bf16_t* G;
    __device__ __forceinline__ void operator()(const Acc& acc, const Unit& u, int wr, int wc, int fr, int fq) const {
        const int row0 = u.pm * BM + wr * 64 + fr, col0 = u.pn * BM + wc * 32 + 8 * fq;
#pragma unroll
        for (int ai = 0; ai < 2; ++ai) { u32x4 gw[4][2];
#pragma unroll
            for (int m = 0; m < 4; ++m)
#pragma unroll
                for (int bj = 0; bj < 2; ++bj) gw[m][bj] = *(const u32x4*)(G + (size_t)(row0 + ai * HALF + m * 16) * GTP + col0 + bj * HALF);
            asm volatile("" ::: "memory");
#pragma unroll
            for (int m = 0; m < 4; ++m) { const int row = row0 + ai * HALF + m * 16;
#pragma unroll
                for (int bj = 0; bj < 2; ++bj) { const int col = col0 + bj * HALF; const u32x4 g = gw[m][bj];
                    const f32x4 g0 = {bf_lo(g.x), bf_hi(g.x), bf_lo(g.y), bf_hi(g.y)}, g1 = {bf_lo(g.z), bf_hi(g.z), bf_lo(g.w), bf_hi(g.w)};
                    *(u32x4*)(C + (size_t)row * D + col) = pack8(g0 * acc[ai][bj][m][0], g1 * acc[ai][bj][m][1]); } }
            asm volatile("" ::: "memory"); }
    }
};
struct EpiGate1 {
    static constexpr bool PERM = true;
    bf16_t* O; const bf16_t* TMP; const bf16_t* G;
    __device__ __forceinline__ void operator()(const Acc& acc, const Unit& u, int wr, int wc, int fr, int fq) const {
        const int row0 = u.pm * BM + wr * 64 + fr, col0 = u.pn * BM + wc * 32 + 8 * fq;
#pragma unroll
        for (int ah = 0; ah < 4; ++ah) { const int ai = ah >> 1, mh = ah & 1; u32x4 g0w[2][2], g1w[2][2], tw[2][2];
#pragma unroll
            for (int ml = 0; ml < 2; ++ml)
#pragma unroll
                for (int bj = 0; bj < 2; ++bj) { const size_t row = (size_t)(row0 + ai * HALF + (2 * mh + ml) * 16);
                    g0w[ml][bj] = *(const u32x4*)(G + row * GTP + col0 + bj * HALF); g1w[ml][bj] = *(const u32x4*)(G + row * GTP + 4096 + col0 + bj * HALF); tw[ml][bj] = *(const u32x4*)(TMP + row * D + col0 + bj * HALF); }
            asm volatile("" ::: "memory");
#pragma unroll
            for (int ml = 0; ml < 2; ++ml) { const int m = 2 * mh + ml, row = row0 + ai * HALF + m * 16;
#pragma unroll
                for (int bj = 0; bj < 2; ++bj) { const int col = col0 + bj * HALF; const u32x4 ga = g0w[ml][bj], gb = g1w[ml][bj], t = tw[ml][bj];
                    const f32x4 a0 = {bf_lo(ga.x), bf_hi(ga.x), bf_lo(ga.y), bf_hi(ga.y)}, a1 = {bf_lo(ga.z), bf_hi(ga.z), bf_lo(ga.w), bf_hi(ga.w)};
                    const f32x4 b0 = {bf_lo(gb.x), bf_hi(gb.x), bf_lo(gb.y), bf_hi(gb.y)}, b1 = {bf_lo(gb.z), bf_hi(gb.z), bf_lo(gb.w), bf_hi(gb.w)};
                    const f32x4 t0 = {bf_lo(t.x), bf_hi(t.x), bf_lo(t.y), bf_hi(t.y)}, t1 = {bf_lo(t.z), bf_hi(t.z), bf_lo(t.w), bf_hi(t.w)};
                    *(u32x4*)(O + (size_t)row * D + col) = pack8(a0 * t0 + b0 * acc[ai][bj][m][0], a1 * t1 + b1 * acc[ai][bj][m][1]); } }
            asm volatile("" ::: "memory"); }
    }
};
__device__ __forceinline__ unsigned dpp_ror1u(unsigned x)  { return (unsigned)__builtin_amdgcn_update_dpp(0, (int)x, 0x121, 0xf, 0xf, false); }
__device__ __forceinline__ unsigned dpp_ror15u(unsigned x) { return (unsigned)__builtin_amdgcn_update_dpp(0, (int)x, 0x12f, 0xf, 0xf, false); }
template <size_t ACT_OFF, size_t EDGE_OFF, size_t RS_OFF, size_t SV_OFF, size_t CV_OFF, size_t CW_OFF, size_t CB_OFF> struct EpiFfnConv {
    static constexpr bool PERM = true;
    unsigned char* wsb; LAS unsigned* H;
    __device__ __forceinline__ void operator()(const Acc& acc, const Unit& u, int wr, int wc, int fr, int fq) const {
        bf16_t* ACT = (bf16_t*)(wsb + ACT_OFF); unsigned* EDGE = (unsigned*)(wsb + EDGE_OFF);
        const float* rs = (const float*)(wsb + RS_OFF); const float* sv = (const float*)(wsb + SV_OFF); const float* cv = (const float*)(wsb + CV_OFF);
        const float* cw = (const float*)(wsb + CW_OFF); const float* cb = (const float*)(wsb + CB_OFF);
        int frl = fr, colt = wc * 32 + 8 * fq; asm volatile("" : "+v"(frl), "+v"(colt));
        const int row0 = u.pm * BM + wr * 64 + frl;
        u32x2 P[2][2][4][2];
#pragma unroll
        for (int ai = 0; ai < 2; ++ai) { float mean[4], rstd[4];
#pragma unroll
            for (int m = 0; m < 4; ++m) { const f32x2 st = *(const f32x2*)(rs + (size_t)(row0 + ai * HALF + m * 16) * 2); mean[m] = st.x * (1.0f / D); rstd[m] = rsqrtf(st.y * (1.0f / D) - mean[m] * mean[m] + LN_EPS); }
#pragma unroll
            for (int bj = 0; bj < 2; ++bj) { f32x4 s4[2], c4[2];
#pragma unroll
                for (int n = 0; n < 2; ++n) { s4[n] = *(const f32x4*)(sv + u.pn * BM + bj * HALF + colt + 4 * n); c4[n] = *(const f32x4*)(cv + u.pn * BM + bj * HALF + colt + 4 * n); }
#pragma unroll
                for (int m = 0; m < 4; ++m)
#pragma unroll
                    for (int n = 0; n < 2; ++n) { const f32x4 v = (acc[ai][bj][m][n] - s4[n] * mean[m]) * rstd[m] + c4[n]; P[ai][bj][m][n].x = cvt_pk_bf16(v[0], v[1]); P[ai][bj][m][n].y = cvt_pk_bf16(v[2], v[3]); }
                __builtin_amdgcn_sched_barrier(0); } }
        if (frl == 0 || frl == 15) { const int tb = frl == 15 ? 1 : 0;
#pragma unroll
            for (int ai = 0; ai < 2; ++ai)
#pragma unroll
                for (int bj = 0; bj < 2; ++bj)
#pragma unroll
                    for (int n = 0; n < 2; ++n) { const int hp = (bj * HALF + colt + 4 * n) >> 1, blk = 2 * ai + wr; const unsigned mk = 0u - (unsigned)tb; u32x2 v; v.x = (P[ai][bj][0][n].x & ~mk) | (P[ai][bj][3][n].x & mk); v.y = (P[ai][bj][0][n].y & ~mk) | (P[ai][bj][3][n].y & mk);
                        *(LAS u32x2*)(H + (blk * 2 + tb) * 128 + hp) = v; } }
        if (wr == 0 ? frl < 2 : frl >= 14) { const int e = wr == 0 ? frl : frl - 12;
#pragma unroll
            for (int bj = 0; bj < 2; ++bj)
#pragma unroll
                for (int n = 0; n < 2; ++n) { const int hp = (bj * HALF + colt + 4 * n) >> 1; const unsigned mk = wr == 0 ? 0u : ~0u; u32x2 v; v.x = (P[0][bj][0][n].x & ~mk) | (P[1][bj][3][n].x & mk); v.y = (P[0][bj][0][n].y & ~mk) | (P[1][bj][3][n].y & mk);
                    *(u32x2*)(EDGE + (size_t)(u.pm * 4 + e) * (DFF2 / 2) + u.pn * (BM / 2) + hp) = v; } }
        asm volatile("s_waitcnt lgkmcnt(0)" ::: "memory"); __builtin_amdgcn_s_barrier(); asm volatile("" ::: "memory");
#pragma unroll
        for (int n = 0; n < 2; ++n) {
            f32x4 W[2][4];
#pragma unroll
            for (int bj = 0; bj < 2; ++bj) { const int c_ = bj * DFF + u.pn * 128 + colt + 4 * n;
                W[bj][0] = *(const f32x4*)(cw + c_); W[bj][1] = *(const f32x4*)(cw + DFF2 + c_); W[bj][2] = *(const f32x4*)(cw + 2 * (size_t)DFF2 + c_); W[bj][3] = *(const f32x4*)(cb + c_); }
            asm volatile("" ::: "memory");
#pragma unroll
            for (int ai = 0; ai < 2; ++ai) { int frb = frl, colb = colt; asm volatile("" : "+v"(frb), "+v"(colb));
                const int ch = u.pn * 128 + colb + 4 * n, blk = 2 * ai + wr, bup = blk > 0 ? blk - 1 : 0, bdn = blk < 3 ? blk + 1 : 3;
                const bool first = frb == 0, lastl = frb == 15;
                u32x2 ht[2], hb[2];
#pragma unroll
                for (int bj = 0; bj < 2; ++bj) { const int hp = (bj * HALF + colb + 4 * n) >> 1; ht[bj] = *(const LAS u32x2*)(H + (bup * 2 + 1) * 128 + hp); hb[bj] = *(const LAS u32x2*)(H + (bdn * 2 + 0) * 128 + hp); }
                unsigned wlo[4];
#pragma unroll
                for (int jp = 0; jp < 2; ++jp) { float cu0[4], cu1[4];
#pragma unroll
                    for (int bj = 0; bj < 2; ++bj) {
                        const f32x2 w0 = {W[bj][0][2 * jp], W[bj][0][2 * jp + 1]}, w1 = {W[bj][1][2 * jp], W[bj][1][2 * jp + 1]}, w2 = {W[bj][2][2 * jp], W[bj][2][2 * jp + 1]}, bb = {W[bj][3][2 * jp], W[bj][3][2 * jp + 1]};
                        unsigned a[4], b[4];
#pragma unroll
                        for (int m = 0; m < 4; ++m) { a[m] = dpp_ror1u(P[ai][bj][m][n][jp]); b[m] = dpp_ror15u(P[ai][bj][m][n][jp]); }
#pragma unroll
                        for (int m = 0; m < 4; ++m) { const unsigned xc = P[ai][bj][m][n][jp];
                            const unsigned pv = first ? (m > 0 ? a[m > 0 ? m - 1 : 0] : ht[bj][jp]) : a[m];
                            const unsigned nx = lastl ? (m < 3 ? b[m < 3 ? m + 1 : 3] : hb[bj][jp]) : b[m];
                            const float r0 = bf_lo(pv) * w0[0] + bf_lo(xc) * w1[0] + bf_lo(nx) * w2[0] + bb[0];
                            const float r1 = bf_hi(pv) * w0[1] + bf_hi(xc) * w1[1] + bf_hi(nx) * w2[1] + bb[1];
                            if (bj == 0) { cu0[m] = r0; cu1[m] = r1; }
                            else { cu0[m] = siluf_(r0) * cu0[m]; cu1[m] = siluf_(r1) * cu1[m]; } } }
#pragma unroll
                    for (int m = 0; m < 4; ++m) { const unsigned w_ = cvt_pk_bf16(cu0[m], cu1[m]);
                        if (jp == 0) wlo[m] = w_;
                        else { const int rt = ai * HALF + wr * 64 + m * 16 + frb; u32x2 w; w.x = wlo[m]; w.y = w_;
                               *(u32x2*)(ACT + (size_t)(u.pm * BM + rt) * DFF + ch) = w; } } }
                asm volatile("" ::: "memory"); __builtin_amdgcn_sched_barrier(0); } }
    }
};
struct EpiRetS {
    static constexpr bool PERM = true;
    bf16_t* O; const float* dec;
    __device__ __forceinline__ void operator()(const Acc& acc, const Unit& u, int wr, int wc, int fr, int fq) const {
        const int h = u.z & 7; const float lf = dec[h], lb = dec[8 + h];
        bf16_t* base = O + (size_t)u.z * SEQ * SEQ;
        int frl = fr, cwl = wc * 32 + 8 * fq; asm volatile("" : "+v"(frl), "+v"(cwl));
        const int rl0 = wr * 64 + frl, row0 = u.pm * BM + rl0, col0 = u.pn * BM + cwl;
        if (u.pm != u.pn) {
            const bool below = u.pm > u.pn; const float lg = below ? lf : lb;
            const float cb0 = below ? (float)((u.pm - u.pn) * BM) : (float)((u.pn - u.pm) * BM - 255);
            float R[2][4]; f32x4 C[2][2];
#pragma unroll
            for (int ai = 0; ai < 2; ++ai)
#pragma unroll
                for (int m = 0; m < 4; ++m) { const float r_ = (float)(rl0 + ai * HALF + m * 16); R[ai][m] = __builtin_amdgcn_exp2f((below ? r_ : 255.0f - r_) * lg); }
#pragma unroll
            for (int bj = 0; bj < 2; ++bj)
#pragma unroll
                for (int n = 0; n < 2; ++n)
#pragma unroll
                    for (int j = 0; j < 4; ++j) { const float c_ = (float)(cwl + bj * HALF + 4 * n + j); C[bj][n][j] = __builtin_amdgcn_exp2f((below ? cb0 - c_ : cb0 + c_) * lg); }
#pragma unroll
            for (int ai = 0; ai < 2; ++ai)
#pragma unroll
                for (int m = 0; m < 4; ++m) { const int row = row0 + ai * HALF + m * 16;
#pragma unroll
                    for (int bj = 0; bj < 2; ++bj) *(u32x4*)(base + (size_t)row * SEQ + col0 + bj * HALF) = pack8(acc[ai][bj][m][0] * C[bj][0] * R[ai][m], acc[ai][bj][m][1] * C[bj][1] * R[ai][m]); }
        } else {
#pragma unroll
            for (int ai = 0; ai < 2; ++ai)
#pragma unroll
                for (int m = 0; m < 4; ++m) { const int row = row0 + ai * HALF + m * 16;
#pragma unroll
                    for (int bj = 0; bj < 2; ++bj) { const int col = col0 + bj * HALF; f32x4 v[2];
#pragma unroll
                        for (int n = 0; n < 2; ++n)
#pragma unroll
                            for (int j = 0; j < 4; ++j) { const int dd = row - (col + 4 * n + j); const float e = dd >= 0 ? (float)dd * lf : (float)(-dd) * lb; v[n][j] = acc[ai][bj][m][n][j] * __builtin_amdgcn_exp2f(e); }
                        *(u32x4*)(base + (size_t)row * SEQ + col) = pack8(v[0], v[1]); } }
        }
    }
};
struct EpiQ {
    static constexpr bool PERM = true;
    bf16_t* Q; const float* rss; const int* pos;
    __device__ __forceinline__ void operator()(const Acc& acc, const Unit& u, int wr, int wc, int fr, int fq) const {
        const int row0 = u.pm * BM + wr * 64 + fr;
        float rs[2][4]; int ps[2][4];
#pragma unroll
        for (int ai = 0; ai < 2; ++ai)
#pragma unroll
            for (int m = 0; m < 4; ++m) { rs[ai][m] = rss[row0 + ai * HALF + m * 16]; ps[ai][m] = pos[row0 + ai * HALF + m * 16]; }
        asm volatile("" ::: "memory");
        if (u.pn < 8) {
#pragma unroll
            for (int ai = 0; ai < 2; ++ai)
#pragma unroll
                for (int m = 0; m < 4; ++m) { const int row = row0 + ai * HALF + m * 16; const float sc = rsqrtf(rs[ai][m] * (1.0f / 1024.0f) + RMS_EPS); bf16_t* qrow = Q + (size_t)row * 3072;
#pragma unroll
                    for (int bj = 0; bj < 2; ++bj) *(u32x4*)(qrow + (2 * u.pn + bj) * 192 + wc * 32 + 8 * fq) = pack8(acc[ai][bj][m][0] * sc, acc[ai][bj][m][1] * sc); }
        } else {
            const int head = 4 * (u.pn - 8) + wc; float invr[8]; int fql = fq; asm volatile("" : "+v"(fql));
#pragma unroll
            for (int i = 0; i < 8; ++i) invr[i] = rope_invr(8 * fql + i, 1.0f / 32.0f);
#pragma unroll
            for (int ai = 0; ai < 2; ++ai)
#pragma unroll
                for (int m = 0; m < 4; ++m) { const int row = row0 + ai * HALF + m * 16; const float sc = rsqrtf(rs[ai][m] * (1.0f / 1024.0f) + RMS_EPS), pf = (float)ps[ai][m]; bf16_t* qrow = Q + (size_t)row * 3072; f32x4 o1[2], o2[2];
#pragma unroll
                    for (int n = 0; n < 2; ++n)
#pragma unroll
                        for (int j = 0; j < 4; ++j) { float c, sn; rope_cs(pf, invr[4 * n + j], c, sn); const float t1 = acc[ai][0][m][n][j] * sc, t2 = acc[ai][1][m][n][j] * sc; o1[n][j] = t1 * c - t2 * sn; o2[n][j] = t2 * c + t1 * sn; }
                    *(u32x4*)(qrow + head * 192 + 128 + 8 * fq) = pack8(o1[0], o1[1]); *(u32x4*)(qrow + head * 192 + 160 + 8 * fq) = pack8(o2[0], o2[1]); }
        }
    }
};
struct EpiProj {
    static constexpr bool PERM = true;
    bf16_t *CQ, *CKV, *KPE, *RQ, *RK, *RVT, *RG, *GT; float* rss; const int* pos; const float* gbias; LAS unsigned char* lds;
    __device__ __forceinline__ void operator()(const Acc& acc, const Unit& u, int wr, int wc, int fr, int fq) const {
        int fql = fq; asm volatile("" : "+v"(fql));
        const int pn = u.pn, row0 = u.pm * BM + wr * 64 + fr, cw = wc * 32 + 8 * fq, cwl = wc * 32 + 8 * fql;
        if (pn < 6) {
            bf16_t* O = pn < 4 ? CQ : CKV; const int ldc = pn < 4 ? 1024 : 512, colt = pn < 4 ? pn * BM : (pn - 4) * BM; float* ss = rss + (pn < 4 ? 0 : T);
#pragma unroll
            for (int ai = 0; ai < 2; ++ai)
#pragma unroll
                for (int m = 0; m < 4; ++m) { const int row = row0 + ai * HALF + m * 16; float s = 0.f;
#pragma unroll
                    for (int bj = 0; bj < 2; ++bj) { const f32x4 a = acc[ai][bj][m][0], b = acc[ai][bj][m][1];
                        s += (a[0] * a[0] + a[1] * a[1]) + (a[2] * a[2] + a[3] * a[3]) + (b[0] * b[0] + b[1] * b[1]) + (b[2] * b[2] + b[3] * b[3]);
                        *(u32x4*)(O + (size_t)row * ldc + colt + bj * HALF + cw) = pack8(a, b); }
                    s += __shfl_xor(s, 16); s += __shfl_xor(s, 32);
                    if (fq == 0) atomicAdd(ss + row, s); }
        } else if (pn == 6) {
            if (wc == 0) {
                int ps[2][4]; float invr[8];
#pragma unroll
                for (int ai = 0; ai < 2; ++ai)
#pragma unroll
                    for (int m = 0; m < 4; ++m) ps[ai][m] = pos[row0 + ai * HALF + m * 16];
                asm volatile("" ::: "memory");
#pragma unroll
                for (int i = 0; i < 8; ++i) invr[i] = rope_invr(8 * fql + i, 1.0f / 32.0f);
#pragma unroll
                for (int ai = 0; ai < 2; ++ai)
#pragma unroll
                    for (int m = 0; m < 4; ++m) { const int row = row0 + ai * HALF + m * 16; const float pf = (float)ps[ai][m]; f32x4 o1[2], o2[2];
#pragma unroll
                        for (int n = 0; n < 2; ++n)
#pragma unroll
                            for (int j = 0; j < 4; ++j) { float c, sn; rope_cs(pf, invr[4 * n + j], c, sn); const float t1 = acc[ai][0][m][n][j], t2 = acc[ai][1][m][n][j]; o1[n][j] = t1 * c - t2 * sn; o2[n][j] = t2 * c + t1 * sn; }
                        *(u32x4*)(KPE + (size_t)row * 64 + 8 * fq) = pack8(o1[0], o1[1]); *(u32x4*)(KPE + (size_t)row * 64 + 32 + 8 * fq) = pack8(o2[0], o2[1]); }
            }
        } else if (pn < 23) {
            const bool isk = pn >= 15; const int head = isk ? pn - 15 : pn - 7; bf16_t* O = isk ? RK : RQ; const float sc = isk ? 0.0625f : 1.0f;
            int ps[2][4]; float invr[8];
#pragma unroll
            for (int ai = 0; ai < 2; ++ai)
#pragma unroll
                for (int m = 0; m < 4; ++m) ps[ai][m] = pos[row0 + ai * HALF + m * 16];
            asm volatile("" ::: "memory");
#pragma unroll
            for (int i = 0; i < 8; ++i) invr[i] = rope_invr(cwl + i, 1.0f / 128.0f);
#pragma unroll
            for (int ai = 0; ai < 2; ++ai)
#pragma unroll
                for (int m = 0; m < 4; ++m) { const int row = row0 + ai * HALF + m * 16; const float pf = (float)ps[ai][m]; f32x4 o1[2], o2[2];
#pragma unroll
                    for (int n = 0; n < 2; ++n)
#pragma unroll
                        for (int j = 0; j < 4; ++j) { float c, sn; rope_cs(pf, invr[4 * n + j], c, sn); const float t1 = acc[ai][0][m][n][j] * sc, t2 = acc[ai][1][m][n][j] * sc; o1[n][j] = t1 * c - t2 * sn; o2[n][j] = t2 * c + t1 * sn; }
                    bf16_t* op = O + (size_t)row * 2048 + head * 256 + cw;
                    *(u32x4*)op = pack8(o1[0], o1[1]); *(u32x4*)(op + 128) = pack8(o2[0], o2[1]); }
        } else if (pn < 39) {
            const int t = pn - 23, head = t >> 1, e0 = (t & 1) * 256, lane = fq * 16 + fr;
            LAS unsigned char* tb = lds + TR_OFF + (wr * 4 + wc) * 2048;
            const int b = (u.pm * BM) >> 11, s0 = (u.pm * BM) & 2047;
#pragma unroll
            for (int ai = 0; ai < 2; ++ai)
#pragma unroll
                for (int bj = 0; bj < 2; ++bj)
#pragma unroll
                    for (int n = 0; n < 2; ++n) {
#pragma unroll
                        for (int m = 0; m < 4; ++m)
#pragma unroll
                            for (int j = 0; j < 4; ++j) { const unsigned w = cvt_pk_bf16(acc[ai][bj][m][n][j], 0.f); *(LAS bf16_t*)(tb + (4 * fq + j) * 128 + (16 * m + fr) * 2) = (bf16_t)(w & 0xffffu); }
#pragma unroll
                        for (int i = 0; i < 2; ++i) { const int q = lane + 64 * i, lc = q >> 3, rc = q & 7; const u32x4 v = *(const LAS u32x4*)(tb + lc * 128 + rc * 16);
                            const int e = e0 + bj * HALF + wc * 32 + 8 * (lc >> 2) + 4 * n + (lc & 3), sp = s0 + ai * HALF + wr * 64 + rc * 8;
                            *(u32x4*)(RVT + ((size_t)(b * 8 + head) * 512 + e) * SEQ + sp) = v; }
                    }
        } else if (pn < 55) {
            const int colt = (pn - 39) * BM;
#pragma unroll
            for (int ai = 0; ai < 2; ++ai)
#pragma unroll
                for (int m = 0; m < 4; ++m) { const int row = row0 + ai * HALF + m * 16;
#pragma unroll
                    for (int bj = 0; bj < 2; ++bj) { f32x4 v[2];
#pragma unroll
                        for (int n = 0; n < 2; ++n)
#pragma unroll
                            for (int j = 0; j < 4; ++j) v[n][j] = siluf_(acc[ai][bj][m][n][j]);
                        *(u32x4*)(RG + (size_t)row * RGP + colt + bj * HALF + cw) = pack8(v[0], v[1]); } }
        } else {
            const int colt = (pn - 55) * BM;
#pragma unroll
            for (int ai = 0; ai < 2; ++ai)
#pragma unroll
                for (int m = 0; m < 4; ++m) { const int row = row0 + ai * HALF + m * 16;
#pragma unroll
                    for (int bj = 0; bj < 2; ++bj) { const int col = colt + bj * HALF + cw; const f32x4 b0 = *(const f32x4*)(gbias + col), b1 = *(const f32x4*)(gbias + col + 4); f32x4 v[2];
#pragma unroll
                        for (int j = 0; j < 4; ++j) { v[0][j] = sigmoidf_(acc[ai][bj][m][0][j] + b0[j]); v[1][j] = sigmoidf_(acc[ai][bj][m][1][j] + b1[j]); }
                        *(u32x4*)(GT + (size_t)row * GTP + col) = pack8(v[0], v[1]); } }
        }
    }
};
}

namespace att {
constexpr int NW = 8, QBLK = 32, KVBLK = 64;
constexpr float SCALE = 0.07216878364870323f;
constexpr float THR = 8.f;
constexpr int LDQ = 3072, LDKV = 4096, LDKR = 64, LDO = 2048;
constexpr int SHM_V = KVBLK * 128 * 2, SHM_K = KVBLK * 128 * 2, SHM_KR = KVBLK * 64 * 2;
constexpr int OFF_V = 0, OFF_K = 2 * SHM_V, OFF_KR = OFF_K + 2 * SHM_K, OFF_WS = OFF_KR + 2 * SHM_KR, OFF_QR = OFF_WS + NW * 64 * 4, ATT_LDS = OFF_QR + NW * 4096;
#define KSWZ(row, colB) ((row) * 256 + ((colB) ^ (((row) & 7) << 4)))
#define KRSWZ(row, colB) ((row) * 128 + ((colB) ^ ((((row) >> 1) & 7) << 4)))
#define SBAR() __builtin_amdgcn_sched_barrier(0)
typedef LAS char* lptr;
__device__ __forceinline__ int crow(int r, int hi) { return (r & 3) + 8 * (r >> 2) + 4 * hi; }
__device__ __forceinline__ void partialSM(f32x16& p0, f32x16& p1, float& m_reg, float& mn, float& alpha) {
    constexpr float C = SCALE * 1.4426950408889634f;
    float pmax = p0[0];
#pragma unroll
    for (int r = 1; r < 16; ++r) pmax = fmaxf(pmax, p0[r]);
#pragma unroll
    for (int r = 0; r < 16; ++r) pmax = fmaxf(pmax, p1[r]);
    { auto rr = __builtin_amdgcn_permlane32_swap(__float_as_uint(pmax), __float_as_uint(pmax), false, false);
      pmax = fmaxf(__uint_as_float(rr[0]), __uint_as_float(rr[1])); }
    if (__builtin_expect(__all(pmax - m_reg <= THR / SCALE), 1)) { mn = m_reg; alpha = 1.f; }
    else { mn = fmaxf(m_reg, pmax); alpha = __builtin_amdgcn_exp2f((m_reg - mn) * C); m_reg = mn; }
    const float mnC = -mn * C;
#pragma unroll
    for (int r = 0; r < 16; ++r) p0[r] = fmaf(p0[r], C, mnC);
#pragma unroll
    for (int r = 0; r < 16; ++r) p1[r] = fmaf(p1[r], C, mnC);
#pragma unroll
    for (int r = 0; r < 16; ++r) p0[r] = __builtin_amdgcn_exp2f(p0[r]);
}
__device__ __forceinline__ void finishSM(f32x16& p0, f32x16& p1, float alpha, float& l_reg, bf16x8& pa0, bf16x8& pa1, bf16x8& pa2, bf16x8& pa3) {
#pragma unroll
    for (int r = 0; r < 16; ++r) p1[r] = __builtin_amdgcn_exp2f(p1[r]);
    float ps = 0;
#pragma unroll
    for (int r = 0; r < 16; ++r) ps += p0[r];
#pragma unroll
    for (int r = 0; r < 16; ++r) ps += p1[r];
    { auto rr = __builtin_amdgcn_permlane32_swap(__float_as_uint(ps), __float_as_uint(ps), false, false);
      ps = __uint_as_float(rr[0]) + __uint_as_float(rr[1]); }
    l_reg = l_reg * alpha + ps;
#define PK4(P, BASE, OUT) do { unsigned a0 = cvt_pk_bf16(P[BASE + 0], P[BASE + 1]), a1 = cvt_pk_bf16(P[BASE + 2], P[BASE + 3]);   \
    unsigned b0 = cvt_pk_bf16(P[BASE + 4], P[BASE + 5]), b1 = cvt_pk_bf16(P[BASE + 6], P[BASE + 7]);                              \
    auto r0 = __builtin_amdgcn_permlane32_swap(a0, b0, false, false); auto r1 = __builtin_amdgcn_permlane32_swap(a1, b1, false, false); \
    u32x4 w = {r0[0], r1[0], r0[1], r1[1]}; OUT = *reinterpret_cast<bf16x8*>(&w); } while (0)
    PK4(p0, 0, pa0); PK4(p0, 8, pa1); PK4(p1, 0, pa2); PK4(p1, 8, pa3);
#undef PK4
}
__device__ __forceinline__ void qkt(f32x16& p0, f32x16& p1, lptr Ks, lptr Krs, const bf16x8* qr, const LAS bf16x8* qsp, int r32, int hi) {
    p0 = f32x16{}; p1 = f32x16{};
#pragma unroll
    for (int d0 = 0; d0 < 8; ++d0) { const int cb = (d0 * 16 + hi * 8) * 2;
        const bf16x8 b0 = *(const LAS bf16x8*)(Ks + KSWZ(r32, cb));
        const bf16x8 b1 = *(const LAS bf16x8*)(Ks + KSWZ(32 + r32, cb));
        p0 = __builtin_amdgcn_mfma_f32_32x32x16_bf16(b0, qr[d0], p0, 0, 0, 0);
        p1 = __builtin_amdgcn_mfma_f32_32x32x16_bf16(b1, qr[d0], p1, 0, 0, 0); }
#pragma unroll
    for (int d0 = 0; d0 < 4; ++d0) { const int cb = (d0 * 16 + hi * 8) * 2;
        const bf16x8 b0 = *(const LAS bf16x8*)(Krs + KRSWZ(r32, cb));
        const bf16x8 b1 = *(const LAS bf16x8*)(Krs + KRSWZ(32 + r32, cb));
        const bf16x8 q = qsp[d0 * 64];
        p0 = __builtin_amdgcn_mfma_f32_32x32x16_bf16(b0, q, p0, 0, 0, 0);
        p1 = __builtin_amdgcn_mfma_f32_32x32x16_bf16(b1, q, p1, 0, 0, 0); }
}
__device__ __forceinline__ int v_st(int k, int c) { const int kk = (k & ~0xC) | ((k & 4) << 1) | ((k & 8) >> 1); return ((kk >> 3) * 4 + (c >> 5)) * 512 + ((kk & 7) * 32 + (c & 31)) * 2; }
__device__ __forceinline__ int v_rd_base(int lane) { return ((lane & 3) << 3) | (((lane >> 2) & 3) << 6) | (((lane >> 4) & 1) << 5) | (((lane >> 5) & 1) << 8); }
constexpr int v_rd_off(int d0, int ks, int half) { return d0 * 512 + ks * 4096 + half * 2048; }
template <int OFF> __device__ __forceinline__ s16x4 tr_read(int vb) {
    s16x4 r; asm volatile("ds_read_b64_tr_b16 %0, %1 offset:%2" : "=&v"(r) : "v"(vb), "i"(OFF) : "memory"); return r;
}
template <int D0> __device__ __forceinline__ void pv_one(f32x16& od, int vb, bf16x8 pa0, bf16x8 pa1, bf16x8 pa2, bf16x8 pa3) {
    const s16x4 l0 = tr_read<v_rd_off(D0, 0, 0)>(vb), h0 = tr_read<v_rd_off(D0, 0, 1)>(vb), l1 = tr_read<v_rd_off(D0, 1, 0)>(vb), h1 = tr_read<v_rd_off(D0, 1, 1)>(vb);
    const s16x4 l2 = tr_read<v_rd_off(D0, 2, 0)>(vb), h2 = tr_read<v_rd_off(D0, 2, 1)>(vb), l3 = tr_read<v_rd_off(D0, 3, 0)>(vb), h3 = tr_read<v_rd_off(D0, 3, 1)>(vb);
    asm volatile("s_waitcnt lgkmcnt(0)" ::: "memory"); SBAR();
#define PK(L, H) (bf16x8){L[0], L[1], L[2], L[3], H[0], H[1], H[2], H[3]}
    od = __builtin_amdgcn_mfma_f32_32x32x16_bf16(pa0, PK(l0, h0), od, 0, 0, 0);
    od = __builtin_amdgcn_mfma_f32_32x32x16_bf16(pa1, PK(l1, h1), od, 0, 0, 0);
    od = __builtin_amdgcn_mfma_f32_32x32x16_bf16(pa2, PK(l2, h2), od, 0, 0, 0);
    od = __builtin_amdgcn_mfma_f32_32x32x16_bf16(pa3, PK(l3, h3), od, 0, 0, 0);
#undef PK
}
__device__ __forceinline__ void pv_d0(f32x16* o, int vb, bf16x8 pa0, bf16x8 pa1, bf16x8 pa2, bf16x8 pa3) {
    pv_one<0>(o[0], vb, pa0, pa1, pa2, pa3); pv_one<1>(o[1], vb, pa0, pa1, pa2, pa3); pv_one<2>(o[2], vb, pa0, pa1, pa2, pa3); pv_one<3>(o[3], vb, pa0, pa1, pa2, pa3);
}
__device__ __forceinline__ void attn_unit(const bf16_t* __restrict__ Qb, const bf16_t* __restrict__ Kh, const bf16_t* __restrict__ Vh, const bf16_t* __restrict__ Krb,
                                          bf16_t* __restrict__ Ob, int seq, lptr lds, const int wid) {
    const int lane = lane_id(), tid = wid * 64 + lane, r32 = lane & 31, hi = lane >> 5;
    (void)Vh; lptr V_lds = lds + OFF_V; lptr K_lds = lds + OFF_K; lptr KR_lds = lds + OFF_KR;
    LAS float* ws = (LAS float*)(lds + OFF_WS) + wid * 64; LAS float* li_l = ws; LAS float* al_l = ws + 32;
    float m_reg = -1e30f, l_reg = 0; f32x16 o[4] = {}; bf16x8 qr[8];
    LAS bf16x8* qsp = (LAS bf16x8*)(lds + OFF_QR + wid * 4096) + lane;
    { const char* Qw = (const char*)Qb + (size_t)(wid * QBLK) * LDQ * 2; const unsigned qoff = (unsigned)(r32 * LDQ + hi * 8) * 2u;
#pragma unroll
      for (int d0 = 0; d0 < 8; ++d0) qr[d0] = *reinterpret_cast<const bf16x8*>(Qw + qoff + d0 * 32);
#pragma unroll
      for (int d0 = 0; d0 < 4; ++d0) qsp[d0 * 64] = *reinterpret_cast<const bf16x8*>(Qw + qoff + (8 + d0) * 32); }
    const int sr = tid >> 4, sc = (tid & 15) * 8, vst0 = v_st(sr, sc), vst1 = v_st(32 + sr, sc);
    const int kr_r = tid >> 3, kr_c = (tid & 7) * 8, krst = KRSWZ(kr_r, kr_c * 2);
    const int vb0 = (int)(uintptr_t)V_lds + v_rd_base(lane);
    const unsigned kvoff = (unsigned)(sr * LDKV + sc) * 2u, kroff = (unsigned)(kr_r * LDKR + kr_c) * 2u;
    bf16x8 vs0, vs1, ks0, ks1, krs;
#define SLOAD(k0) do { const char* kb_ = (const char*)Kh + (size_t)(k0) * LDKV * 2; const char* rb_ = (const char*)Krb + (size_t)(k0) * LDKR * 2; \
    ks0 = *reinterpret_cast<const bf16x8*>(kb_ + kvoff); vs0 = *reinterpret_cast<const bf16x8*>(kb_ + kvoff + 256); \
    ks1 = *reinterpret_cast<const bf16x8*>(kb_ + (size_t)32 * LDKV * 2 + kvoff); vs1 = *reinterpret_cast<const bf16x8*>(kb_ + (size_t)32 * LDKV * 2 + kvoff + 256); \
    krs = *reinterpret_cast<const bf16x8*>(rb_ + kroff); } while (0)
#define SWRITE(b) do { *(LAS bf16x8*)(V_lds + (b) * SHM_V + vst0) = vs0; *(LAS bf16x8*)(V_lds + (b) * SHM_V + vst1) = vs1; const int kc = sc * 2; \
    *(LAS bf16x8*)(K_lds + (b) * SHM_K + KSWZ(sr, kc)) = ks0; *(LAS bf16x8*)(K_lds + (b) * SHM_K + KSWZ(32 + sr, kc)) = ks1; \
    *(LAS bf16x8*)(KR_lds + (b) * SHM_KR + krst) = krs; } while (0)
#define SWAIT() asm volatile("s_waitcnt vmcnt(0)" ::: "memory")
#define RESC(a) do { if (__any((a) < 1.f)) { if (hi == 0) al_l[r32] = (a); asm volatile("s_waitcnt lgkmcnt(0)" ::: "memory"); \
    _Pragma("unroll") for (int d = 0; d < 4; ++d) _Pragma("unroll") for (int r = 0; r < 16; ++r) o[d][r] *= al_l[crow(r, hi)]; } } while (0)
    f32x16 pA0, pA1, pB0, pB1; float mnA, mnB, alA, alB; bf16x8 pa0, pa1, pa2, pa3; const int NT = seq / KVBLK;
    SLOAD(0); SWAIT(); SWRITE(0); __syncthreads();
    qkt(pA0, pA1, K_lds, KR_lds, qr, qsp, r32, hi); partialSM(pA0, pA1, m_reg, mnA, alA);
    SLOAD(KVBLK);
    SWAIT(); SWRITE(1); __syncthreads();
    for (int j = 1; j + 1 < NT; j += 2) {
        SBAR(); qkt(pB0, pB1, K_lds + SHM_K, KR_lds + SHM_KR, qr, qsp, r32, hi);
        finishSM(pA0, pA1, alA, l_reg, pa0, pa1, pa2, pa3); SBAR();
        SLOAD((j + 1) * KVBLK); SBAR();
        pv_d0(o, vb0, pa0, pa1, pa2, pa3); partialSM(pB0, pB1, m_reg, mnB, alB);
        __syncthreads(); SWAIT(); SWRITE(0);
        RESC(alB); __syncthreads();
        SBAR(); qkt(pA0, pA1, K_lds, KR_lds, qr, qsp, r32, hi);
        finishSM(pB0, pB1, alB, l_reg, pa0, pa1, pa2, pa3); SBAR();
        SLOAD((j + 2) * KVBLK); SBAR();
        pv_d0(o, vb0 + SHM_V, pa0, pa1, pa2, pa3); partialSM(pA0, pA1, m_reg, mnA, alA);
        __syncthreads(); SWAIT(); SWRITE(1);
        RESC(alA); __syncthreads();
    }
    SBAR(); qkt(pB0, pB1, K_lds + SHM_K, KR_lds + SHM_KR, qr, qsp, r32, hi);
    finishSM(pA0, pA1, alA, l_reg, pa0, pa1, pa2, pa3); SBAR();
    pv_d0(o, vb0, pa0, pa1, pa2, pa3); partialSM(pB0, pB1, m_reg, mnB, alB);
    __syncthreads(); RESC(alB);
    finishSM(pB0, pB1, alB, l_reg, pa0, pa1, pa2, pa3); SBAR();
    pv_d0(o, vb0 + SHM_V, pa0, pa1, pa2, pa3);
    if (hi == 0) li_l[r32] = l_reg; asm volatile("s_waitcnt lgkmcnt(0)" ::: "memory");
    float rli[16];
#pragma unroll
    for (int r = 0; r < 16; ++r) rli[r] = __builtin_amdgcn_rcpf(li_l[crow(r, hi)]);
    char* Ow = (char*)Ob + (size_t)(wid * QBLK) * LDO * 2; const unsigned ooff = (unsigned)(4 * hi * LDO + r32) * 2u;
#pragma unroll
    for (int r = 0; r < 16; ++r) { const int orel = (r & 3) + 8 * (r >> 2);
#pragma unroll
        for (int d0 = 0; d0 < 4; ++d0) { const unsigned w = cvt_pk_bf16(o[d0][r] * rli[r], 0.f); *(bf16_t*)(Ow + ooff + (orel * LDO + d0 * 32) * 2) = (bf16_t)(w & 0xffffu); } }
    __syncthreads();
#undef SLOAD
#undef SWRITE
#undef SWAIT
#undef RESC
}
}

#define XB_TMO      128
#define XB_XCNT(j)  (256  + 64 * (j))
#define XB_XSUB(j)  (1280 + 64 * (j))
#define XB_XGEN(j)  (2304 + 64 * (j))
#define XB_TOP      3328
#define XB_TOPGEN   3392
#define XCD_BAR_WORDS 3456
#define XB_SPIN_CAP (1u << 18)
__device__ __forceinline__ unsigned xb_ld(unsigned* p)              { return __hip_atomic_load(p, __ATOMIC_RELAXED, __HIP_MEMORY_SCOPE_AGENT); }
__device__ __forceinline__ unsigned xb_add(unsigned* p, unsigned v) { return __hip_atomic_fetch_add(p, v, __ATOMIC_RELAXED, __HIP_MEMORY_SCOPE_AGENT); }
__device__ __forceinline__ unsigned xb_xcc_id() { return (unsigned)__builtin_amdgcn_s_getreg((3 << 11) | 20) & 0xFu; }
#define XB_SPIN(cond, bar) do { unsigned _sp = 0; while (cond) { __builtin_amdgcn_s_sleep(1); \
    if ((++_sp & 255u) == 0u) { if (xb_ld(&(bar)[XB_TMO])) break; if (_sp > XB_SPIN_CAP) { atomicAdd(&(bar)[XB_TMO], 1u); break; } } } } while (0)
struct XcdBarrier { unsigned* bar; unsigned x; volatile LAS unsigned* st; };
__device__ __forceinline__ XcdBarrier xcd_barrier_post(unsigned* bar, volatile LAS unsigned* st, const bool t0) {
    XcdBarrier b; b.bar = bar; b.x = xb_xcc_id(); b.st = st;
    if (t0) (void)xb_add(&bar[XB_XCNT(b.x)], 1u);
    return b;
}
__device__ __forceinline__ void xcd_barrier_complete(unsigned* bar, unsigned x, unsigned& nloc, unsigned& nx) {
    const unsigned G = gridDim.x * gridDim.y * gridDim.z;
    unsigned sum, cnt, mine, sp = 0u;
    for (;;) {
        sum = 0u; cnt = 0u; mine = 0u;
#pragma unroll
        for (unsigned j = 0; j < 16; ++j) { const unsigned c = xb_ld(&bar[XB_XCNT(j)]); sum += c; cnt += (c > 0u) ? 1u : 0u; mine = (j == x) ? c : mine; }
        if (sum == G) break;
        __builtin_amdgcn_s_sleep(1);
        if ((++sp & 255u) == 0u) { if (xb_ld(&bar[XB_TMO])) break; if (sp > XB_SPIN_CAP) { atomicAdd(&bar[XB_TMO], 1u); break; } }
    }
    nloc = mine > 0u ? mine : 1u; nx = cnt > 0u ? cnt : 1u;
}
__device__ __forceinline__ void xcd_barrier(const XcdBarrier& b, const bool t0) {
    asm volatile("s_waitcnt vmcnt(0)" ::: "memory");
    __syncthreads();
    if (t0) {
        unsigned* bar = b.bar;
        __builtin_amdgcn_s_waitcnt(0);
        unsigned nloc = b.st[0], nx = b.st[1];
        if (nloc == 0u) { xcd_barrier_complete(bar, b.x, nloc, nx); b.st[0] = nloc; b.st[1] = nx; }
        const unsigned old = xb_add(&bar[XB_XSUB(b.x)], 1u);
        const unsigned gen = old / nloc;
        if (old + 1u == (gen + 1u) * nloc) {
            __builtin_amdgcn_fence(__ATOMIC_RELEASE, "agent");
            asm volatile("s_waitcnt vmcnt(0)" ::: "memory");
            const unsigned og = xb_add(&bar[XB_TOP], 1u);
            const unsigned tg = og / nx;
            if (og + 1u == (tg + 1u) * nx) xb_add(&bar[XB_TOPGEN], 1u);
            else XB_SPIN(xb_ld(&bar[XB_TOPGEN]) == tg, bar);
            __builtin_amdgcn_fence(__ATOMIC_ACQUIRE, "agent");
            xb_add(&bar[XB_XGEN(b.x)], 1u);
            asm volatile("s_waitcnt vmcnt(0)" ::: "memory");
        } else {
            XB_SPIN(xb_ld(&bar[XB_XGEN(b.x)]) == gen, bar);
            __builtin_amdgcn_fence(__ATOMIC_ACQUIRE, "agent");
            asm volatile("s_waitcnt vmcnt(0)" ::: "memory");
        }
    }
    __syncthreads();
}

__device__ __forceinline__ int wfi_src(int nb) { const int pn = nb >> 3, q = nb & 7; return (q >> 2) * DFF + pn * 128 + (q & 3) * 32; }
__device__ __forceinline__ int win_src(int nb) { const int n0 = nb * 32; if (n0 < 1536) return n0; if (n0 < 1792) return n0 == 1536 ? 1536 : (n0 == 1664 ? 1568 : -1); return n0 - 192; }
__device__ __forceinline__ int wuq_src(int nb) { const int n0 = nb * 32; if (n0 < 2048) return (n0 >> 7) * 192 + (n0 & 127);
    const int w = n0 - 2048, t = w >> 8, wi = w & 255, bj = wi >> 7, hh = (wi & 127) >> 5; return (4 * t + hh) * 192 + 128 + 32 * bj; }
__device__ __forceinline__ void p0_item(const float* __restrict__ W, int ldw, int K, bf16_t* __restrict__ WT, int sc, int dn, int k0, const float* __restrict__ gk, LAS float* scr, int lane) {
    const int c = lane & 7;
    if (sc < 0) {
#pragma unroll
        for (int j = 0; j < 4; ++j) { const int n = (lane >> 3) + 8 * j; *(u32x4*)(WT + (size_t)(dn + n) * K + k0 + 8 * c) = (u32x4){0u, 0u, 0u, 0u}; }
        return;
    }
#pragma unroll 8
    for (int i = 0; i < 32; ++i) { const int kk = 2 * i + (lane >> 5); float v = __builtin_nontemporal_load(W + (size_t)(k0 + kk) * ldw + sc + (lane & 31)); if (gk) v *= gk[k0 + kk]; scr[kk * 33 + (lane & 31)] = v; }
    LDS_WAIT(); asm volatile("" ::: "memory");
#pragma unroll
    for (int j = 0; j < 4; ++j) { const int n = (lane >> 3) + 8 * j; const LAS float* s = scr + (8 * c) * 33 + n;
        u32x4 o; o.x = cvt_pk_bf16(s[0 * 33], s[1 * 33]); o.y = cvt_pk_bf16(s[2 * 33], s[3 * 33]); o.z = cvt_pk_bf16(s[4 * 33], s[5 * 33]); o.w = cvt_pk_bf16(s[6 * 33], s[7 * 33]);
        __builtin_nontemporal_store(o, (u32x4*)(WT + (size_t)(dn + n) * K + k0 + 8 * c)); }
    LDS_WAIT(); asm volatile("" ::: "memory");
}

__device__ __forceinline__ void p0_item_ln(const float* __restrict__ W, int ldw, int K, bf16_t* __restrict__ WT, int sc, int dn, int k0, const float* __restrict__ gk, const float* __restrict__ bk,
                                           float* sv, float* cv, LAS float* scr, int lane) {
    const int c = lane & 7;
#pragma unroll 8
    for (int i = 0; i < 32; ++i) { const int kk = 2 * i + (lane >> 5); scr[kk * 33 + (lane & 31)] = __builtin_nontemporal_load(W + (size_t)(k0 + kk) * ldw + sc + (lane & 31)); }
    const f32x4 ga = *(const f32x4*)(gk + k0 + 8 * c), gb = *(const f32x4*)(gk + k0 + 8 * c + 4), ba = *(const f32x4*)(bk + k0 + 8 * c), bb = *(const f32x4*)(bk + k0 + 8 * c + 4);
    LDS_WAIT(); asm volatile("" ::: "memory");
    float sk = 0.f, ck = 0.f;
#pragma unroll
    for (int j = 0; j < 4; ++j) { const int n = (lane >> 3) + 8 * j; const LAS float* sp = scr + (8 * c) * 33 + n;
        const float w0 = sp[0 * 33], w1 = sp[1 * 33], w2 = sp[2 * 33], w3 = sp[3 * 33], w4 = sp[4 * 33], w5 = sp[5 * 33], w6 = sp[6 * 33], w7 = sp[7 * 33];
        u32x4 o; o.x = cvt_pk_bf16(w0 * ga[0], w1 * ga[1]); o.y = cvt_pk_bf16(w2 * ga[2], w3 * ga[3]); o.z = cvt_pk_bf16(w4 * gb[0], w5 * gb[1]); o.w = cvt_pk_bf16(w6 * gb[2], w7 * gb[3]);
        __builtin_nontemporal_store(o, (u32x4*)(WT + (size_t)(dn + n) * K + k0 + 8 * c));
        float ss = ((bf_lo(o.x) + bf_hi(o.x)) + (bf_lo(o.y) + bf_hi(o.y))) + ((bf_lo(o.z) + bf_hi(o.z)) + (bf_lo(o.w) + bf_hi(o.w)));
        float cs = ((w0 * ba[0] + w1 * ba[1]) + (w2 * ba[2] + w3 * ba[3])) + ((w4 * bb[0] + w5 * bb[1]) + (w6 * bb[2] + w7 * bb[3]));
        ss += __shfl_xor(ss, 1); ss += __shfl_xor(ss, 2); ss += __shfl_xor(ss, 4); cs += __shfl_xor(cs, 1); cs += __shfl_xor(cs, 2); cs += __shfl_xor(cs, 4);
        if (c == j) { sk = ss; ck = cs; } }
    if (c < 4) { const int n = (lane >> 3) + 8 * c; atomicAdd(sv + dn + n, sk); atomicAdd(cv + dn + n, ck); }
    LDS_WAIT(); asm volatile("" ::: "memory");
}

__device__ __forceinline__ void p0_item_lnr(const float* __restrict__ W, int ldw, bf16_t* __restrict__ WR, int sc, int k0, const float* __restrict__ gk, const float* __restrict__ bk,
                                            float* sv, float* cv, int lane) {
    const int cp = lane & 15, r4 = lane >> 4;
    float s0 = 0.f, s1 = 0.f, c0 = 0.f, c1 = 0.f;
#pragma unroll 8
    for (int i = 0; i < 16; ++i) { const int k = k0 + 4 * i + r4; const f32x2 w = __builtin_nontemporal_load((const f32x2*)(W + (size_t)k * ldw + sc + 2 * cp)); const float g = gk[k], b = bk[k];
        const unsigned o = cvt_pk_bf16(w.x * g, w.y * g); *(unsigned*)(WR + (size_t)k * ldw + sc + 2 * cp) = o;
        s0 += bf_lo(o); s1 += bf_hi(o); c0 += w.x * b; c1 += w.y * b; }
    s0 += __shfl_xor(s0, 16); s0 += __shfl_xor(s0, 32); s1 += __shfl_xor(s1, 16); s1 += __shfl_xor(s1, 32);
    c0 += __shfl_xor(c0, 16); c0 += __shfl_xor(c0, 32); c1 += __shfl_xor(c1, 16); c1 += __shfl_xor(c1, 32);
    if (r4 == 0) { atomicAdd(sv + sc + 2 * cp, s0); atomicAdd(sv + sc + 2 * cp + 1, s1); atomicAdd(cv + sc + 2 * cp, c0); atomicAdd(cv + sc + 2 * cp + 1, c1); }
}

constexpr int NPHASE = 21;
struct Args { const void* in[28]; float* out; unsigned char* ws; int ph_lo, ph_hi; };
static_assert(WS_CONVB + (size_t)DFF2 * 4 <= WS_MISC && WS_CONVW >= CTL_ZERO_BYTES, "conv weight copy");
static_assert(WS_C2 + DFF2 * 4 <= CTL_ZERO_BYTES && WS_MISC >= CTL_ZERO_BYTES && WS_MISC + 64 <= WS_WIN, "control region");
static_assert(sizeof(Args) == 28 * 8 + 8 + 8 + 8, "Args has no padding");

__global__ void __launch_bounds__(NWAVES * 64, 2) mk_fwd(Args args) {
    extern __shared__ __attribute__((aligned(16))) unsigned char lds_raw[];
    LAS unsigned char* lds = (LAS unsigned char*)lds_raw;
    volatile LAS unsigned* MISC = (volatile LAS unsigned*)(lds + MISC_OFF);
    const int wave = __builtin_amdgcn_readfirstlane((int)threadIdx.x >> 6);
#define tid (wave * 64 + lane)
    const int G = gridDim.x, bx = blockIdx.x;
    const int vcu = (G % 8 == 0) ? (bx % 8) * (G / 8) + bx / 8 : bx;
    const int gw = vcu * NWAVES + wave, NGW = G * NWAVES;
    const int NGT = G * NWAVES * 64;
#define gtid (vcu * (NWAVES * 64) + wave * 64 + lane)
    unsigned char* ws = args.ws;
    unsigned* ctl = (unsigned*)(ws + WS_CTL);
    { const int lane = lane_id(); for (int u = tid; u < (LDS_BYTES - LDSCTL_OFF) / 4; u += NWAVES * 64) ((LAS unsigned*)(lds + LDSCTL_OFF))[u] = 0u; }
    __syncthreads();
    XcdBarrier bar; bar.bar = ctl + CW_BAR; bar.x = 0; bar.st = nullptr;
#if !MK_PER_PHASE
    bar = xcd_barrier_post(ctl + CW_BAR, MISC + 8, wave == 0 && lane_id() == 0);
#define GRID_BAR() xcd_barrier(bar, wave == 0 && lane_id() == 0)
#else
#define GRID_BAR() do {} while (0)
#endif
    const int lo = args.ph_lo, hi = args.ph_hi;
#ifndef DUP_MASK
#define DUP_MASK 0u
#endif
#define IN(k) (lo <= (k) && (k) < hi)
#define REP(k) for (int rep_ = 0; rep_ < (((DUP_MASK >> (k)) & 1u) ? 2 : 1); ++rep_)
#define SEAM(k) do { if (IN(k) && IN((k) + 1)) GRID_BAR(); } while (0)

#define in_x ((const float*)args.in[0])
#define in_mem ((const float*)args.in[1])
#define in_positions ((const int*)args.in[2])
#define in_w_in ((const float*)args.in[3])
#define in_gate_bias ((const float*)args.in[4])
#define in_q_norm_g ((const float*)args.in[5])
#define in_w_uq ((const float*)args.in[6])
#define in_kv_norm_g ((const float*)args.in[7])
#define in_w_ukv ((const float*)args.in[8])
#define in_dec_f ((const float*)args.in[9])
#define in_dec_b ((const float*)args.in[10])
#define in_w_br_mla ((const float*)args.in[11])
#define in_w_br_ret ((const float*)args.in[12])
#define in_w_o ((const float*)args.in[13])
#define in_ln1_g ((const float*)args.in[14])
#define in_ln1_b ((const float*)args.in[15])
#define in_w_cq ((const float*)args.in[16])
#define in_w_ck ((const float*)args.in[17])
#define in_w_cv ((const float*)args.in[18])
#define in_w_co ((const float*)args.in[19])
#define in_ln2_g ((const float*)args.in[20])
#define in_ln2_b ((const float*)args.in[21])
#define in_w_ffn_in ((const float*)args.in[22])
#define in_conv_w ((const float*)args.in[23])
#define in_conv_b ((const float*)args.in[24])
#define in_w_ffn_out ((const float*)args.in[25])
#define in_ln3_g ((const float*)args.in[26])
#define in_ln3_b ((const float*)args.in[27])
#define Win_t ((bf16_t*)(ws + WS_WIN))
#define Wfi_t ((bf16_t*)(ws + WS_WFI))
#define Wfo_t ((bf16_t*)(ws + WS_WFO))
#define Wbr_t ((bf16_t*)(ws + WS_WBR))
#define Wo_t ((bf16_t*)(ws + WS_WO))
#define Wcq_r ((bf16_t*)(ws + WS_WCQ))
#define Wck_t ((bf16_t*)(ws + WS_WCK))
#define Wcv_t ((bf16_t*)(ws + WS_WCV))
#define Wco_t ((bf16_t*)(ws + WS_WCO))
#define Wbm_t ((bf16_t*)(ws + WS_WBM))
#define Wuq_t ((bf16_t*)(ws + WS_WUQ))
#define Wukv_t ((bf16_t*)(ws + WS_WUKV))
#define MEMB ((bf16_t*)(ws + WS_MEMB))
#define ROPER ((f32x2*)(ws + WS_ROPER))
#define ROPEA ((f32x2*)(ws + WS_ROPEA))
#define RSS ((float*)(ws + WS_RSS))
#define RS1 ((float*)(ws + WS_RS1))
#define RS2 ((float*)(ws + WS_RS2))
#define RS3 ((float*)(ws + WS_RS3))
#define S1V ((float*)(ws + WS_S1))
#define C1V ((float*)(ws + WS_C1))
#define S2V ((float*)(ws + WS_S2))
#define C2V ((float*)(ws + WS_C2))
#define ZB ((bf16_t*)(ws + WS_ZB))
#define DEC ((float*)(ws + WS_MISC))
#define XB ((bf16_t*)(ws + WS_XB))
#define CQM ((bf16_t*)(ws + WS_CQM))
#define CKV ((bf16_t*)(ws + WS_CKV))
#define KPE ((bf16_t*)(ws + WS_KPE))
#define RQ ((bf16_t*)(ws + WS_RQ))
#define RK ((bf16_t*)(ws + WS_RK))
#define RVT ((bf16_t*)(ws + WS_RVT))
#define RG ((bf16_t*)(ws + WS_RG))
#define GT ((bf16_t*)(ws + WS_GT))
#define SC ((bf16_t*)(ws + WS_SC))
#define AO ((bf16_t*)(ws + WS_AO))
#define QB ((bf16_t*)(ws + WS_Q))
#define KVB ((bf16_t*)(ws + WS_KV))
#define ORET ((bf16_t*)(ws + WS_ORET))
#define ROUT ((bf16_t*)(ws + WS_ROUT))
#define TMP ((bf16_t*)(ws + WS_TMP))
#define MIXED ((bf16_t*)(ws + WS_MIXED))
#define Z ((float*)(ws + WS_Z))
#define MQT ((bf16_t*)(ws + WS_MQT))
#define VWT ((bf16_t*)(ws + WS_VWT))
#define CK ((bf16_t*)(ws + WS_CK))
#define CV ((bf16_t*)(ws + WS_CV))
#define SXV ((float*)(ws + WS_SX))
#define CXV ((float*)(ws + WS_CX))
#define XS ((float*)(ws + WS_XS))
#define XP ((bf16_t*)(ws + WS_XP))
#define EDGE ((unsigned*)(ws + WS_EDGE))
#define ACT ((bf16_t*)(ws + WS_ACT))

#define GEMM_CALL(EpiT, Ev, Aptr, Bptr, lda_, ldb_, K_, nM_, nN_, nZ_, nh_, sAb_, sAh_, sBb_, sBh_) do { \
        pg8::Gemm g_{(Aptr), (Bptr), (lda_), (ldb_), (K_), (nh_), (long)(sAb_), (long)(sAh_), (long)(sBb_), (long)(sBh_)}; \
        pg8::Order S_; S_.init((nM_), (nN_), (nZ_), G, bx); pg8::gemm_phase<EpiT>(lds, g_, S_, (Ev), wave); } while (0)

    constexpr int I_IN = (INP / 32) * (D / 64), I_UQ = (3072 / 32) * (1024 / 64), I_UKV = (4096 / 32) * (512 / 64), I_BM = (4096 / 32) * (2048 / 64), I_SQ = (4096 / 32) * (4096 / 64);
    constexpr int I_FI = (DFF2 / 32) * (D / 64), I_FO = (4096 / 32) * (DFF / 64);
    const bool split = (G == 256);
    constexpr int I_FO_P2 = (I_FO / 3 / 1024) * 1024;
#define CONV_WCO(lo_, hi_, w_, nw_) do { LAS float* scr_ = (LAS float*)(lds + wave * 16384); for (int r = (lo_) + (w_); r < (hi_); r += (nw_)) { const int nblk = 4096 / 32, kb = r / nblk, nb = r % nblk; \
        p0_item(in_w_co, 4096, 4096, Wco_t, nb * 32, nb * 32, kb * 64, nullptr, scr_, lane); } } while (0)
#define CONV_WFI2(w_, nw_) do { LAS float* scr_ = (LAS float*)(lds + wave * 16384); for (int r = I_FI / 2 + (w_); r < I_FI; r += (nw_)) { const int nblk = DFF2 / 32, kb = r / nblk, nb = r % nblk; \
        p0_item_ln(in_w_ffn_in, DFF2, D, Wfi_t, wfi_src(nb), nb * 32, kb * 64, in_ln2_g, in_ln2_b, S2V, C2V, scr_, lane); } } while (0)
#define CONV_WFO(lo_, hi_, w_, nw_) do { LAS float* scr_ = (LAS float*)(lds + wave * 16384); for (int r = (lo_) + (w_); r < (hi_); r += (nw_)) { const int nblk = 4096 / 32, kb = r / nblk, nb = r % nblk; \
        p0_item(in_w_ffn_out, 4096, DFF, Wfo_t, nb * 32, nb * 32, kb * 64, nullptr, scr_, lane); } } while (0)
    if (IN(0)) REP(0) { const int lane = lane_id();
        LAS float* scr = (LAS float*)(lds + wave * 16384);
        constexpr int NITEMS = I_IN + I_UQ + I_UKV + I_BM + 5 * I_SQ + I_FI / 2;
        for (int it = gw; it < NITEMS; it += NGW) {
            int r = it;
            if (r < I_IN) { const int nblk = INP / 32, kb = r / nblk, nb = r % nblk; p0_item(in_w_in, INW, D, Win_t, win_src(nb), nb * 32, kb * 64, nullptr, scr, lane); continue; } r -= I_IN;
            if (r < I_UQ) { const int nblk = 3072 / 32, kb = r / nblk, nb = r % nblk; p0_item(in_w_uq, 3072, 1024, Wuq_t, wuq_src(nb), nb * 32, kb * 64, in_q_norm_g, scr, lane); continue; } r -= I_UQ;
            if (r < I_UKV) { const int nblk = 4096 / 32, kb = r / nblk, nb = r % nblk; p0_item(in_w_ukv, 4096, 512, Wukv_t, nb * 32, nb * 32, kb * 64, in_kv_norm_g, scr, lane); continue; } r -= I_UKV;
            if (r < I_BM) { const int nblk = 4096 / 32, kb = r / nblk, nb = r % nblk; p0_item(in_w_br_mla, 4096, 2048, Wbm_t, nb * 32, nb * 32, kb * 64, nullptr, scr, lane); continue; } r -= I_BM;
            if (r < 5 * I_SQ) { const int wsel = r / I_SQ; r -= wsel * I_SQ; const int nblk = 4096 / 32, kb = r / nblk, nb = r % nblk;
                const float* W = wsel == 0 ? in_w_br_ret : wsel == 1 ? in_w_o : wsel == 2 ? in_w_cq : wsel == 3 ? in_w_ck : in_w_cv;
                bf16_t* WT = wsel == 0 ? Wbr_t : wsel == 1 ? Wo_t : wsel == 2 ? Wcq_r : wsel == 3 ? Wck_t : Wcv_t;
                if (wsel == 2) p0_item_lnr(W, 4096, WT, nb * 32, kb * 64, in_ln1_g, in_ln1_b, S1V, C1V, lane);
                else p0_item(W, 4096, 4096, WT, nb * 32, nb * 32, kb * 64, nullptr, scr, lane);
                continue; } r -= 5 * I_SQ;
            { const int nblk = DFF2 / 32, kb = r / nblk, nb = r % nblk; p0_item_ln(in_w_ffn_in, DFF2, D, Wfi_t, wfi_src(nb), nb * 32, kb * 64, in_ln2_g, in_ln2_b, S2V, C2V, scr, lane); }
        }
        if (!split) { CONV_WCO(0, I_SQ, gw, NGW); CONV_WFI2(gw, NGW); CONV_WFO(0, I_FO, gw, NGW); }
        for (long i = gtid; i < (long)T * D / 8; i += NGT) { const f32x4 a = __builtin_nontemporal_load((const f32x4*)(in_x + i * 8)), b = __builtin_nontemporal_load((const f32x4*)(in_x + i * 8 + 4)); *(u32x4*)(XB + i * 8) = pg8::pack8(a, b); }
        for (long i = gtid; i < (long)TM * D / 8; i += NGT) { const f32x4 a = *(const f32x4*)(in_mem + i * 8), b = *(const f32x4*)(in_mem + i * 8 + 4); *(u32x4*)(MEMB + i * 8) = pg8::pack8(a, b); }
        for (int i = gtid; i < 3 * DFF2 / 4; i += NGT) ((f32x4*)(ws + WS_CONVW))[i] = ((const f32x4*)in_conv_w)[i];
        for (int i = gtid; i < DFF2 / 4; i += NGT) ((f32x4*)(ws + WS_CONVB))[i] = ((const f32x4*)in_conv_b)[i];
        if (gtid < 16) { const float e = gtid < 8 ? in_dec_f[gtid] : in_dec_b[gtid - 8]; DEC[gtid] = log1pf(-exp2f(-e)) * 1.4426950408889634f; }
        __syncthreads();
    }
    SEAM(0);

    if (IN(1)) REP(1) {
        pg8::EpiProj E{CQM, CKV, KPE, RQ, RK, RVT, RG, GT, RSS, in_positions, in_gate_bias, lds};
        GEMM_CALL(pg8::EpiProj, E, XB, Win_t, D, D, D, 32, 87, 1, 1, 0, 0, 0, 0);
        const int lane = lane_id();
        if (split && bx >= 224) CONV_WCO(0, I_SQ / 2, (bx - 224) * NWAVES + wave, 32 * NWAVES);
    }
    SEAM(1);

    if (IN(2)) REP(2) {
        { pg8::EpiQ E{QB, RSS, in_positions}; GEMM_CALL(pg8::EpiQ, E, CQM, Wuq_t, 1024, 1024, 1024, 32, 12, 1, 1, 0, 0, 0, 0); }
        { const int lane = lane_id(); if (split && bx >= 128) { CONV_WFO(0, I_FO_P2, (bx - 128) * NWAVES + wave, 128 * NWAVES); __syncthreads(); } }
        { pg8::EpiBf16 E{KVB, 4096, 1.0f, 1, 0, 0, RSS + T, 1.0f / 512.0f}; GEMM_CALL(pg8::EpiBf16, E, CKV, Wukv_t, 512, 512, 512, 32, 16, 1, 1, 0, 0, 0, 0); }
    }
    SEAM(2);

    if (IN(3)) REP(3) {
        for (int idx = vcu; idx < 512; idx += G) {
            const int bh = idx >> 3, qb = idx & 7, b = bh >> 4, h = bh & 15;
            const size_t row0 = (size_t)b * SEQ + qb * 256, key0 = (size_t)b * SEQ;
            att::attn_unit(QB + row0 * 3072 + h * 192, KVB + key0 * 4096 + h * 256, KVB + key0 * 4096 + h * 256 + 128, KPE + key0 * 64, AO + row0 * 2048 + h * 128, SEQ, (att::lptr)lds, wave);
        }
    }
    if (IN(3) && IN(4)) __syncthreads();

    if (IN(4)) REP(4) {
        pg8::EpiRetS E{SC, DEC};
        GEMM_CALL(pg8::EpiRetS, E, RQ, RK, 2048, 2048, 256, 8, 8, 32, 8, (long)SEQ * 2048, 256, (long)SEQ * 2048, 256);
    }
    SEAM(4);

    if (IN(5)) REP(5) {
        pg8::EpiBf16 E{ORET, D, 1.0f, 8, (long)SEQ * D, 512, nullptr, 0.f};
        GEMM_CALL(pg8::EpiBf16, E, SC, RVT, 2048, 2048, 2048, 8, 2, 32, 8, (long)8 * SEQ * SEQ, (long)SEQ * SEQ, (long)8 * 512 * SEQ, (long)512 * SEQ);
    }
    SEAM(5);

    if (IN(6)) REP(6) { const int lane = lane_id();
        for (int it = gw; it < T * 8; it += NGW) {
            const size_t off = (size_t)it * 512;
            const u32x2 aw = __builtin_nontemporal_load((const u32x2*)(ORET + off + lane * 4)), bw = __builtin_nontemporal_load((const u32x2*)(ORET + off + 256 + lane * 4));
            const f32x4 a = {bf_lo(aw.x), bf_hi(aw.x), bf_lo(aw.y), bf_hi(aw.y)}, b = {bf_lo(bw.x), bf_hi(bw.x), bf_lo(bw.y), bf_hi(bw.y)};
            const float mean = wave_sum((a[0] + a[1]) + (a[2] + a[3]) + (b[0] + b[1]) + (b[2] + b[3])) * (1.0f / 512.0f);
            const f32x4 da = a - mean, db = b - mean;
            const float var = wave_sum((da[0] * da[0] + da[1] * da[1]) + (da[2] * da[2] + da[3] * da[3]) + (db[0] * db[0] + db[1] * db[1]) + (db[2] * db[2] + db[3] * db[3])) * (1.0f / 512.0f);
            const float rstd = rsqrtf(var + LN_EPS);
            const size_t goff = (size_t)(it >> 3) * RGP + (it & 7) * 512;
            const u32x2 ga = __builtin_nontemporal_load((const u32x2*)(RG + goff + lane * 4)), gb = __builtin_nontemporal_load((const u32x2*)(RG + goff + 256 + lane * 4));
            u32x2 oa, ob;
            oa.x = cvt_pk_bf16(da[0] * rstd * bf_lo(ga.x), da[1] * rstd * bf_hi(ga.x)); oa.y = cvt_pk_bf16(da[2] * rstd * bf_lo(ga.y), da[3] * rstd * bf_hi(ga.y));
            ob.x = cvt_pk_bf16(db[0] * rstd * bf_lo(gb.x), db[1] * rstd * bf_hi(gb.x)); ob.y = cvt_pk_bf16(db[2] * rstd * bf_lo(gb.y), db[3] * rstd * bf_hi(gb.y));
            *(u32x2*)(ROUT + off + lane * 4) = oa; *(u32x2*)(ROUT + off + 256 + lane * 4) = ob;
        }
    }
    if (IN(6) && IN(7)) __syncthreads();

    if (IN(7)) REP(7) { pg8::EpiBf16 E{TMP, D, 1.0f, 1, 0, 0, nullptr, 0.f}; GEMM_CALL(pg8::EpiBf16, E, AO, Wbm_t, 2048, 2048, 2048, 32, 16, 1, 1, 0, 0, 0, 0); }
    SEAM(7);
    if (IN(8)) REP(8) { pg8::EpiGate1 E{MIXED, TMP, GT}; GEMM_CALL(pg8::EpiGate1, E, ROUT, Wbr_t, D, D, D, 32, 16, 1, 1, 0, 0, 0, 0); }
    SEAM(8);
    if (IN(9)) REP(9) { typedef pg8::EpiResStat<WS_ZB, WS_RS1> EpiT9; EpiT9 E{ws, in_x}; GEMM_CALL(EpiT9, E, MIXED, Wo_t, D, D, D, 32, 16, 1, 1, 0, 0, 0, 0); }
    SEAM(9);

#define LN_PHASE(Zp, gp, bp, outF, outB) do { \
        for (int m = gw; m < T; m += NGW) { \
            const f32x4* zr = (const f32x4*)((Zp) + (size_t)m * D) + lane; f32x4 v[16]; float s = 0.f; \
            _Pragma("unroll") for (int j = 0; j < 16; ++j) { v[j] = zr[64 * j]; s += (v[j][0] + v[j][1]) + (v[j][2] + v[j][3]); } \
            const float mean = wave_sum(s) * (1.0f / D); float s2 = 0.f; \
            _Pragma("unroll") for (int j = 0; j < 16; ++j) { v[j] = v[j] - mean; s2 += (v[j][0] * v[j][0] + v[j][1] * v[j][1]) + (v[j][2] * v[j][2] + v[j][3] * v[j][3]); } \
            const float rstd = rsqrtf(wave_sum(s2) * (1.0f / D) + LN_EPS); \
            _Pragma("unroll") for (int j = 0; j < 16; ++j) { const f32x4 gg = ((const f32x4*)(gp))[64 * j + lane], bb = ((const f32x4*)(bp))[64 * j + lane]; const f32x4 y = v[j] * rstd * gg + bb; \
                if ((outF) != nullptr) ((f32x4*)((outF) + (size_t)m * D))[64 * j + lane] = y; \
                if ((outB) != nullptr) { u32x2 w; w.x = cvt_pk_bf16(y[0], y[1]); w.y = cvt_pk_bf16(y[2], y[3]); ((u32x2*)((outB) + (size_t)m * D))[64 * j + lane] = w; } } \
        } } while (0)

    if (IN(11)) REP(11) { const int lane = lane_id();
        if (bx < 64) { pg8::EpiBf16 E{CK, D, 1.0f, 1, 0, 0, nullptr, 0.f}; pg8::Gemm g_{MEMB, Wck_t, D, D, D, 1, 0, 0, 0, 0}; pg8::Order S_; S_.init(4, 16, 1, 64, bx); pg8::gemm_phase<pg8::EpiBf16>(lds, g_, S_, E, wave); }
        else if (bx >= 128) { if (split) { CONV_WFI2((bx - 128) * NWAVES + wave, 128 * NWAVES); CONV_WCO(I_SQ / 2, I_SQ, (bx - 128) * NWAVES + wave, 128 * NWAVES); } }
        else { pg8::EpiBf16 E{CV, D, 1.0f, 1, 0, 0, nullptr, 0.f}; pg8::Gemm g_{MEMB, Wcv_t, D, D, D, 1, 0, 0, 0, 0}; pg8::Order S_; S_.init(4, 16, 1, 64, bx - 64); pg8::gemm_phase<pg8::EpiBf16>(lds, g_, S_, E, wave); }
    }
    SEAM(11);

    if (IN(12)) REP(12) {
        { pg8::EpiBf16 E{MQT, D, 1.0f, 4, (long)1024 * D, (long)256 * D, nullptr, 0.f}; GEMM_CALL(pg8::EpiBf16, E, CK, Wcq_r, D, D, 1024, 1, 16, 16, 4, (long)MEM * D, 1024, 0, 1024); }
        { pg8::EpiBf16 E{VWT, 1024, 1.0f, 4, (long)D * 1024, 256, nullptr, 0.f}; GEMM_CALL(pg8::EpiBf16, E, Wco_t, CV, D, D, 1024, 16, 1, 16, 4, 0, 1024, (long)MEM * D, 1024); }
        const int lane = lane_id();
        for (int it = gw; it < TM * 4; it += NGW) { const int row = it >> 2, h = it & 3;
            const bf16_t* cr = CK + (size_t)row * D + h * 1024 + lane * 8; const float* sp = S1V + h * 1024 + lane * 8; const float* cp = C1V + h * 1024 + lane * 8;
            float sa = 0.f, ca = 0.f;
#pragma unroll
            for (int j = 0; j < 2; ++j) { const u32x4 w_ = *(const u32x4*)(cr + j * 512); const f32x4 s0 = *(const f32x4*)(sp + j * 512), s1 = *(const f32x4*)(sp + j * 512 + 4), c0 = *(const f32x4*)(cp + j * 512), c1 = *(const f32x4*)(cp + j * 512 + 4);
                const f32x4 k0 = {bf_lo(w_.x), bf_hi(w_.x), bf_lo(w_.y), bf_hi(w_.y)}, k1 = {bf_lo(w_.z), bf_hi(w_.z), bf_lo(w_.w), bf_hi(w_.w)};
                sa += ((k0[0] * s0[0] + k0[1] * s0[1]) + (k0[2] * s0[2] + k0[3] * s0[3])) + ((k1[0] * s1[0] + k1[1] * s1[1]) + (k1[2] * s1[2] + k1[3] * s1[3]));
                ca += ((k0[0] * c0[0] + k0[1] * c0[1]) + (k0[2] * c0[2] + k0[3] * c0[3])) + ((k1[0] * c1[0] + k1[1] * c1[1]) + (k1[2] * c1[2] + k1[3] * c1[3])); }
            sa = wave_sum(sa); ca = wave_sum(ca);
            if (lane == 0) { const int o = (row >> 8) * 1024 + h * 256 + (row & 255); SXV[o] = sa; CXV[o] = ca; } }
    }
    SEAM(12);

    if (IN(13)) REP(13) { pg8::EpiF32 E{XS, 1024, 2, (long)SEQ * 1024, (long)T * 1024}; GEMM_CALL(pg8::EpiF32, E, ZB, MQT, D, D, 2048, 8, 4, 8, 2, (long)SEQ * D, 2048, (long)1024 * D, 2048); }
    SEAM(13);

    if (IN(14)) REP(14) { const int lane = lane_id();
        for (int it = gw; it < T * 4; it += NGW) {
            const size_t off = (size_t)it * 256 + lane * 4; const int tok = it >> 2, fo = (tok >> 11) * 1024 + (it & 3) * 256 + lane * 4;
            const f32x4 a0 = __builtin_nontemporal_load((const f32x4*)(XS + off)), a1 = __builtin_nontemporal_load((const f32x4*)(XS + (size_t)T * 1024 + off)), sx = *(const f32x4*)(SXV + fo), cx = *(const f32x4*)(CXV + fo);
            const f32x2 st = *(const f32x2*)(RS1 + (size_t)tok * 2);
            const float mean = st.x * (1.0f / D), rstd = rsqrtf(st.y * (1.0f / D) - mean * mean + LN_EPS);
            const f32x4 a = (((a0 + a1) - sx * mean) * rstd + cx) * 0.03125f;
            const float mx = wave_max(fmaxf(fmaxf(a[0], a[1]), fmaxf(a[2], a[3])));
            f32x4 e; e[0] = __expf(a[0] - mx); e[1] = __expf(a[1] - mx); e[2] = __expf(a[2] - mx); e[3] = __expf(a[3] - mx);
            const float inv = 1.0f / wave_sum((e[0] + e[1]) + (e[2] + e[3]));
            u32x2 w; w.x = cvt_pk_bf16(e[0] * inv, e[1] * inv); w.y = cvt_pk_bf16(e[2] * inv, e[3] * inv);
            *(u32x2*)(XP + off) = w;
        }
    }
    SEAM(14);
    if (IN(15)) REP(15) { typedef pg8::EpiResLN<WS_ZB, WS_RS1, WS_RS2, true, SEQ> EpiT15; EpiT15 E{ws, in_ln1_g, in_ln1_b}; GEMM_CALL(EpiT15, E, XP, VWT, 1024, 1024, 1024, 8, 16, 4, 1, (long)SEQ * 1024, 0, (long)D * 1024, 0); }
    SEAM(15);
    if (IN(17)) REP(17) { typedef pg8::EpiFfnConv<WS_ACT, WS_EDGE, WS_RS2, WS_S2, WS_C2, WS_CONVW, WS_CONVB> EpiT17; EpiT17 E{ws, (LAS unsigned*)(lds + TR_OFF)};
        GEMM_CALL(EpiT17, E, ZB, Wfi_t, D, D, D, 32, 86, 1, 1, 0, 0, 0, 0);
        const int lane = lane_id();
        if (split && bx >= 192) CONV_WFO(I_FO_P2, I_FO, (bx - 192) * NWAVES + wave, 64 * NWAVES); }
    SEAM(17);

    if (IN(18)) REP(18) { const int lane = lane_id();
        constexpr int CU8 = DFF / 8, NIT = 64 * CU8;
        for (int it = gtid; it < NIT; it += NGT) {
            const int pe = it / CU8, cu = it - pe * CU8, c0 = cu * 8, pmi = pe >> 1, bot = pe & 1;
            const int tp = ((c0 >> 7) * 256 + (c0 & 127)) >> 1;
            const unsigned* e0 = EDGE + (size_t)(pmi * 4) * (DFF2 / 2) + tp;
            const bool hasp = bot ? true : (pmi & 7) != 0, hasn = bot ? (pmi & 7) != 7 : true;
            const unsigned* pp = bot ? e0 + 2 * (size_t)(DFF2 / 2) : e0 - (size_t)(DFF2 / 2);
            const unsigned* pc = bot ? e0 + 3 * (size_t)(DFF2 / 2) : e0;
            const unsigned* pn_ = bot ? e0 + 4 * (size_t)(DFF2 / 2) : e0 + (size_t)(DFF2 / 2);
            const u32x4 z4 = {0u, 0u, 0u, 0u};
            const u32x4 up = hasp ? *(const u32x4*)pp : z4, uc = *(const u32x4*)pc, un = hasn ? *(const u32x4*)pn_ : z4;
            const u32x4 gp = hasp ? *(const u32x4*)(pp + 64) : z4, gc = *(const u32x4*)(pc + 64), gn = hasn ? *(const u32x4*)(pn_ + 64) : z4;
            float o[8];
#pragma unroll
            for (int q = 0; q < 4; ++q) { const int c = c0 + 2 * q;
                const float u0 = bf_lo(up[q]) * in_conv_w[c] + bf_lo(uc[q]) * in_conv_w[DFF2 + c] + bf_lo(un[q]) * in_conv_w[2 * (size_t)DFF2 + c] + in_conv_b[c];
                const float u1 = bf_hi(up[q]) * in_conv_w[c + 1] + bf_hi(uc[q]) * in_conv_w[DFF2 + c + 1] + bf_hi(un[q]) * in_conv_w[2 * (size_t)DFF2 + c + 1] + in_conv_b[c + 1];
                const float g0 = bf_lo(gp[q]) * in_conv_w[DFF + c] + bf_lo(gc[q]) * in_conv_w[DFF2 + DFF + c] + bf_lo(gn[q]) * in_conv_w[2 * (size_t)DFF2 + DFF + c] + in_conv_b[DFF + c];
                const float g1 = bf_hi(gp[q]) * in_conv_w[DFF + c + 1] + bf_hi(gc[q]) * in_conv_w[DFF2 + DFF + c + 1] + bf_hi(gn[q]) * in_conv_w[2 * (size_t)DFF2 + DFF + c + 1] + in_conv_b[DFF + c + 1];
                o[2 * q] = siluf_(g0) * u0; o[2 * q + 1] = siluf_(g1) * u1; }
            u32x4 w; w.x = cvt_pk_bf16(o[0], o[1]); w.y = cvt_pk_bf16(o[2], o[3]); w.z = cvt_pk_bf16(o[4], o[5]); w.w = cvt_pk_bf16(o[6], o[7]);
            *(u32x4*)(ACT + (size_t)(pmi * 256 + (bot ? 255 : 0)) * DFF + c0) = w;
        }
    }
    SEAM(18);
    if (IN(19)) REP(19) { typedef pg8::EpiResLN<WS_ZB, WS_RS2, WS_RS3, false> EpiT19; EpiT19 E{ws, in_ln2_g, in_ln2_b}; GEMM_CALL(EpiT19, E, ACT, Wfo_t, DFF, DFF, DFF, 32, 16, 1, 1, 0, 0, 0, 0); }
    SEAM(19);
    if (IN(20)) REP(20) { const int lane = lane_id();
        for (int m = gw; m < T; m += NGW) {
            const u32x4* zr = (const u32x4*)(ZB + (size_t)m * D) + lane; f32x4* orow = (f32x4*)(args.out + (size_t)m * D);
            f32x4 z[16]; float s_ = 0.f;
#pragma unroll
            for (int j = 0; j < 8; ++j) { const u32x4 zw = __builtin_nontemporal_load(zr + 64 * j); z[2 * j] = (f32x4){bf_lo(zw.x), bf_hi(zw.x), bf_lo(zw.y), bf_hi(zw.y)}; z[2 * j + 1] = (f32x4){bf_lo(zw.z), bf_hi(zw.z), bf_lo(zw.w), bf_hi(zw.w)};
                s_ += ((z[2 * j][0] + z[2 * j][1]) + (z[2 * j][2] + z[2 * j][3])) + ((z[2 * j + 1][0] + z[2 * j + 1][1]) + (z[2 * j + 1][2] + z[2 * j + 1][3])); }
            const float mean = wave_sum(s_) * (1.0f / D); float q_ = 0.f;
#pragma unroll
            for (int j = 0; j < 16; ++j) { z[j] = z[j] - mean; q_ += (z[j][0] * z[j][0] + z[j][1] * z[j][1]) + (z[j][2] * z[j][2] + z[j][3] * z[j][3]); }
            const float rstd = rsqrtf(wave_sum(q_) * (1.0f / D) + LN_EPS);
#pragma unroll
            for (int j = 0; j < 8; ++j) { const int c4 = (64 * j + lane) * 2;
                const f32x4 g0 = ((const f32x4*)in_ln3_g)[c4], g1 = ((const f32x4*)in_ln3_g)[c4 + 1], b0 = ((const f32x4*)in_ln3_b)[c4], b1 = ((const f32x4*)in_ln3_b)[c4 + 1];
                __builtin_nontemporal_store(z[2 * j] * rstd * g0 + b0, orow + c4); __builtin_nontemporal_store(z[2 * j + 1] * rstd * g1 + b1, orow + c4 + 1); }
        }
    }
#undef IN
#undef SEAM
}

extern "C" void kernel_launch(void* const* d_in, const int* in_sizes, int n_in, void* d_out, int out_size, void* d_ws, size_t ws_size, hipStream_t stream) {
    static int grid = 0;
    if (grid == 0) {
        if (n_in != 28 || in_sizes[0] != T * D || out_size != T * D || ws_size < WS_END) { fprintf(stderr, "kernel_launch: unexpected shapes (n_in %d, in0 %d, out %d, ws %zu < %zu)\n", n_in, n_in > 0 ? in_sizes[0] : -1, out_size, ws_size, (size_t)WS_END); grid = -1; return; }
        int dev = 0, cus = 0, per_cu = 0;
        if (hipGetDevice(&dev) != hipSuccess || hipDeviceGetAttribute(&cus, hipDeviceAttributeMultiprocessorCount, dev) != hipSuccess) { grid = -1; return; }
        if (hipFuncSetAttribute((const void*)mk_fwd, hipFuncAttributeMaxDynamicSharedMemorySize, LDS_BYTES) != hipSuccess) { fprintf(stderr, "kernel_launch: hipFuncSetAttribute failed\n"); grid = -1; return; }
        if (hipOccupancyMaxActiveBlocksPerMultiprocessor(&per_cu, (const void*)mk_fwd, NWAVES * 64, LDS_BYTES) != hipSuccess || per_cu < 1) fprintf(stderr, "kernel_launch: occupancy query says %d\n", per_cu);
        (void)hipGetLastError();
        grid = cus;
    }
    if (grid < 0) return;
    (void)hipMemsetAsync((char*)d_ws + WS_CTL, 0, CTL_ZERO_BYTES, stream);
    Args a{};
    for (int i = 0; i < 28; ++i) a.in[i] = d_in[i];
    a.out = (float*)d_out; a.ws = (unsigned char*)d_ws;
#if MK_PER_PHASE
    for (int p = 0; p < NPHASE; ++p) { a.ph_lo = p; a.ph_hi = p + 1; hipLaunchKernelGGL(mk_fwd, dim3(grid), dim3(NWAVES * 64), LDS_BYTES, stream, a); }
#else
    a.ph_lo = 0; a.ph_hi = NPHASE; hipLaunchKernelGGL(mk_fwd, dim3(grid), dim3(NWAVES * 64), LDS_BYTES, stream, a);
#endif
    const hipError_t le = hipPeekAtLastError();
    if (le != hipSuccess) fprintf(stderr, "kernel_launch: launch failed: %s\n", hipGetErrorName(le));
}
```

```cpp
#include <hip/hip_runtime.h>
#include <cstdio>
#include <cstdint>

#ifndef MK_PER_PHASE
#define MK_PER_PHASE 0
#endif

#define LAS __attribute__((address_space(3)))
#define GAS __attribute__((address_space(1)))
typedef unsigned short bf16_t;
typedef short bf16x8 __attribute__((ext_vector_type(8)));
typedef short s16x4 __attribute__((ext_vector_type(4)));
typedef float f32x2 __attribute__((ext_vector_type(2)));
typedef float f32x4 __attribute__((ext_vector_type(4)));
typedef float f32x16 __attribute__((ext_vector_type(16)));
typedef unsigned u32x2 __attribute__((ext_vector_type(2)));
typedef unsigned u32x4 __attribute__((ext_vector_type(4)));

constexpr int NB = 4, SEQ = 2048, T = NB * SEQ, D = 4096;
constexpr int MEM = 256, TM = NB * MEM;
constexpr int INW = 22080, INP = 22272;
constexpr int DFF = 11008, DFF2 = 22016;
constexpr float ALPHA = 1.189207115002721f;
constexpr float LN_EPS = 1e-5f, RMS_EPS = 1e-6f;
constexpr int NWAVES = 8;
constexpr int GTP = 8192 + 128, RGP = 4096 + 64;

constexpr size_t MiB = 1u << 20;
constexpr size_t WS_CTL = 0, CTL_ZERO_BYTES = 640 * 1024;
constexpr size_t WS_RSS = 64 * 1024;
constexpr size_t WS_RS1 = 128 * 1024, WS_RS2 = 192 * 1024, WS_RS3 = 256 * 1024;
constexpr size_t WS_S1 = 320 * 1024, WS_C1 = 336 * 1024;
constexpr size_t WS_S2 = 352 * 1024, WS_C2 = 448 * 1024;
constexpr size_t WS_CONVW = 640 * 1024;
constexpr size_t WS_CONVB = WS_CONVW + 3 * (size_t)DFF2 * 4;
constexpr size_t WS_MISC = 1000 * 1024;
constexpr size_t WS_WIN = 1 * MiB;
constexpr size_t WS_WFI = 175 * MiB;
constexpr size_t WS_WFO = 347 * MiB;
constexpr size_t WS_WBR = 433 * MiB;
constexpr size_t WS_WO = 465 * MiB, WS_WCQ = 497 * MiB, WS_WCK = 529 * MiB, WS_WCV = 561 * MiB, WS_WCO = 593 * MiB;
constexpr size_t WS_WBM = 625 * MiB;
constexpr size_t WS_WUQ = 641 * MiB;
constexpr size_t WS_WUKV = 647 * MiB;
constexpr size_t WS_MEMB = 651 * MiB;
constexpr size_t WS_ROPER = 659 * MiB;
constexpr size_t WS_ROPEA = 667 * MiB;
constexpr size_t WS_XB = 670 * MiB;
constexpr size_t WS_ROUT = 670 * MiB;
constexpr size_t WS_CQM = 734 * MiB;
constexpr size_t WS_CKV = 750 * MiB;
constexpr size_t WS_KPE = 758 * MiB;
constexpr size_t WS_RQ = 759 * MiB;
constexpr size_t WS_RK = 791 * MiB;
constexpr size_t WS_RVT = 823 * MiB;
constexpr size_t WS_RG = 1335 * MiB;
constexpr size_t WS_GT = 887 * MiB;
constexpr size_t WS_SC = 1079 * MiB;
constexpr size_t WS_END = 1400 * MiB;
constexpr size_t WS_AO = 1 * MiB;
constexpr size_t WS_Q = 33 * MiB;
constexpr size_t WS_KV = 81 * MiB;
constexpr size_t WS_ORET = 33 * MiB;
constexpr size_t WS_TMP = 1079 * MiB;
constexpr size_t WS_MIXED = 1207 * MiB;
constexpr size_t WS_Z = 887 * MiB;
constexpr size_t WS_ZB = 1015 * MiB;
constexpr size_t WS_MQT = 1079 * MiB;
constexpr size_t WS_VWT = 1111 * MiB;
constexpr size_t WS_CK = 1143 * MiB;
constexpr size_t WS_CV = 1151 * MiB;
constexpr size_t WS_XS = 1159 * MiB;
constexpr size_t WS_XP = 1223 * MiB;
constexpr size_t WS_SX = 1239 * MiB, WS_CX = WS_SX + 16384;
constexpr size_t WS_EDGE = 433 * MiB;
constexpr size_t WS_ACT = 1 * MiB;

constexpr int CW_BAR = 4096;

constexpr int RING_BYTES = 131072;
constexpr int LDSCTL_OFF = RING_BYTES, MISC_OFF = LDSCTL_OFF + 320;
constexpr int TR_OFF = RING_BYTES + 1024, TR_BYTES = 8 * 2048;
constexpr int LDS_BYTES = 155648;
static_assert(TR_OFF + TR_BYTES <= LDS_BYTES && MISC_OFF + 128 <= TR_OFF, "LDS map");

#define LDS_WAIT() asm volatile("s_waitcnt lgkmcnt(0)" ::: "memory")
#define VM_WAIT() asm volatile("s_waitcnt vmcnt(0)" ::: "memory")

typedef __bf16 bf16x2_t __attribute__((ext_vector_type(2)));
__device__ __forceinline__ unsigned cvt_pk_bf16(float lo, float hi) { const f32x2 v = {lo, hi}; const bf16x2_t b = __builtin_convertvector(v, bf16x2_t); return __builtin_bit_cast(unsigned, b); }
__device__ __forceinline__ int lane_id() { int l; asm volatile("v_mbcnt_lo_u32_b32 %0, -1, 0\n\tv_mbcnt_hi_u32_b32 %0, -1, %0" : "=v"(l)); return l; }
__device__ __forceinline__ float bf_lo(unsigned w) { return __uint_as_float(w << 16); }
__device__ __forceinline__ float bf_hi(unsigned w) { return __uint_as_float(w & 0xffff0000u); }
__device__ __forceinline__ float sigmoidf_(float x) { return __builtin_amdgcn_rcpf(1.0f + __expf(-x)); }
__device__ __forceinline__ float siluf_(float x) { return x * __builtin_amdgcn_rcpf(1.0f + __expf(-x)); }
__device__ __forceinline__ void rope_cs(float pos, float invr, float& c, float& s_) { const float xr = __builtin_amdgcn_fractf(pos * invr); c = __builtin_amdgcn_cosf(xr); s_ = __builtin_amdgcn_sinf(xr); }
__device__ __forceinline__ float rope_invr(int i, float half_inv) { return exp2f(-(float)i * (13.287712379549449f * half_inv)) * 0.15915494309189535f; }
__device__ __forceinline__ float dpp_ror1(float x)  { return __builtin_bit_cast(float, __builtin_amdgcn_update_dpp(0, __builtin_bit_cast(int, x), 0x121, 0xf, 0xf, false)); }
__device__ __forceinline__ float dpp_ror15(float x) { return __builtin_bit_cast(float, __builtin_amdgcn_update_dpp(0, __builtin_bit_cast(int, x), 0x12f, 0xf, 0xf, false)); }
__device__ __forceinline__ float wave_sum(float v) {
#pragma unroll
    for (int o = 1; o < 64; o <<= 1) v += __shfl_xor(v, o);
    return v;
}
__device__ __forceinline__ float wave_max(float v) {
#pragma unroll
    for (int o = 1; o < 64; o <<= 1) v = fmaxf(v, __shfl_xor(v, o));
    return v;
}

#ifndef PG8_SP2
#define PG8_SP2 1
#endif
namespace pg8 {
constexpr int BM = 256, BK = 64, HALF = 128, HTB = HALF * BK * 2, STAGE_BYTES = 8 * HTB, NXCD = 8, WGM = 8;
__host__ __device__ __forceinline__ int lds_byte(int r, int c) { const int st = (r >> 4) * 2 + (c >> 5), rr = r & 15, cc = c & 31, ob = rr * 64 + cc * 2; return st * 1024 + (ob ^ (((ob >> 9) & 1) << 5)); }
__host__ __device__ __forceinline__ void stage_rc(int b, int& R, int& C) { const int st = b / 1024, sb = b % 1024, swz = sb ^ (((sb >> 9) & 1) << 5); R = (st >> 1) * 16 + swz / 64; C = (st & 1) * 32 + (swz % 64) / 2; }
__host__ __device__ __forceinline__ int perm32(int rho) { const int n = rho >> 4, i = rho & 15; return 8 * (i >> 2) + 4 * n + (i & 3); }

struct Unit { int pm, pn, z; };
struct Gemm { const bf16_t* A; const bf16_t* Bt; int lda, ldb, K, nh; long sAb, sAh, sBb, sBh; };

struct Order {
    int nM, nN, per, ntot, G, c, rowmode;
    __device__ __forceinline__ void init(int nM_, int nN_, int nZ_, int G_, int c_) { nM = nM_; nN = nN_; per = nM_ * nN_; ntot = per * nZ_; G = G_; c = c_; rowmode = 0; }
    __device__ __forceinline__ bool next(int i, Unit& u) const {
        if (rowmode) {
            if (i >= nN) return false;
            const int rho = (c % NXCD) * (G / NXCD) + c / NXCD; u.z = rho / nM; u.pm = rho % nM; u.pn = i; return true; }
        const long L = (long)i * G + c; if (L >= ntot) return false;
        int id = (int)L; { const int q = ntot / NXCD, r = ntot % NXCD, xcd = id % NXCD, off = id / NXCD; id = (xcd < r ? xcd * (q + 1) : r * (q + 1) + (xcd - r) * q) + off; }
        u.z = id / per; const int w = id % per;
        const int nig = WGM * nN, gid = w / nig, fm = gid * WGM, gsz = (nM - fm) < WGM ? (nM - fm) : WGM;
        u.pm = fm + ((w % nig) % gsz); u.pn = (w % nig) / gsz; return true;
    }
};

typedef f32x4 Acc[2][2][4][2];

template <class Epi>
__device__ __forceinline__ void gemm_phase(LAS unsigned char* lds, const Gemm g, const Order& S, const Epi& E, const int wid) {
    const int wr = wid >> 2, wc = wid & 3;
    const int K = g.K, nt = K / BK;
    const size_t kstep = (size_t)(BK * 2);
    const size_t hA = (size_t)HALF * g.lda * 2, hB = (size_t)HALF * g.ldb * 2;
    const unsigned ldsw = (unsigned)wid * 1024u;
    unsigned voffA[2], voffB[2]; int aoff, boff;
#define PG8_LANESETUP() do { const int lane_ = lane_id(), tid_ = wid * 64 + lane_; \
        _Pragma("unroll") for (int i = 0; i < 2; ++i) { int R, C; stage_rc(tid_ * 16 + i * 8192, R, C); const int Rb = Epi::PERM ? ((R & ~31) + perm32(R & 31)) : R; \
            voffA[i] = (unsigned)(R * g.lda + C) * 2u; voffB[i] = (unsigned)(Rb * g.ldb + C) * 2u; } \
        aoff = lds_byte(wr * 64 + (lane_ & 15), (lane_ >> 4) * 8); boff = lds_byte(wc * 32 + (lane_ & 15), (lane_ >> 4) * 8); } while (0)
    PG8_LANESETUP();
#define PG8_SA(b, h) (((b) * 2 + (h)) * HTB)
#define PG8_SB(b, h) ((4 + (b) * 2 + (h)) * HTB)
#define PG8_STAGE(bufoff, gbase, voff) do { _Pragma("unroll") for (int _i = 0; _i < 2; ++_i) \
        __builtin_amdgcn_global_load_lds((const unsigned*)((const char*)(gbase) + (voff)[_i]), (LAS unsigned*)(lds + (bufoff) + ldsw + _i * 8192), 16, 0, 0); } while (0)
#define PG8_LDA(dst, b, h) do { _Pragma("unroll") for (int m = 0; m < 4; ++m) _Pragma("unroll") for (int k = 0; k < 2; ++k) dst[m][k] = *(const LAS bf16x8*)(lds + PG8_SA(b, h) + aoff + m * 2048 + k * 1024); } while (0)
#define PG8_LDB(dst, b, h) do { _Pragma("unroll") for (int n = 0; n < 2; ++n) _Pragma("unroll") for (int k = 0; k < 2; ++k) dst[n][k] = *(const LAS bf16x8*)(lds + PG8_SB(b, h) + boff + n * 2048 + k * 1024); } while (0)
#define PG8_MMA(ai, bj, At, Bt) do { __builtin_amdgcn_s_setprio(1); _Pragma("unroll") for (int m = 0; m < 4; ++m) _Pragma("unroll") for (int n = 0; n < 2; ++n) _Pragma("unroll") for (int k = 0; k < 2; ++k) \
        acc[ai][bj][m][n] = __builtin_amdgcn_mfma_f32_16x16x32_bf16(Bt[n][k], At[m][k], acc[ai][bj][m][n], 0, 0, 0); __builtin_amdgcn_s_setprio(0); } while (0)
#define PG8_WAIT_V(n) asm volatile("s_waitcnt vmcnt(" #n ")" ::: "memory")
#define PG8_WAIT_L(n) asm volatile("s_waitcnt lgkmcnt(" #n ")" ::: "memory")
#define PG8_BAR __builtin_amdgcn_s_barrier()
#define PG8_SCHED __builtin_amdgcn_sched_barrier(0)
    Unit cur, nxt; int ui = 0;
    if (!S.next(0, cur)) return;
    Acc acc;
#pragma unroll
    for (int a = 0; a < 2; ++a)
#pragma unroll
        for (int b = 0; b < 2; ++b)
#pragma unroll
            for (int m = 0; m < 4; ++m)
#pragma unroll
                for (int n = 0; n < 2; ++n) acc[a][b][m][n] = (f32x4){0.f, 0.f, 0.f, 0.f};
    bf16x8 At[4][2], B0[2][2], B1[2][2];
#define PG8_APTR(u) ((const char*)g.A + ((size_t)((u).z / g.nh) * g.sAb + (size_t)((u).z % g.nh) * g.sAh + (size_t)(u).pm * BM * g.lda) * 2)
#define PG8_BPTR(u) ((const char*)g.Bt + ((size_t)((u).z / g.nh) * g.sBb + (size_t)((u).z % g.nh) * g.sBh + (size_t)(u).pn * BM * g.ldb) * 2)
    const char* cA = PG8_APTR(cur); const char* cB = PG8_BPTR(cur);
#if PG8_SP2
    PG8_STAGE(PG8_SB(0, 0), cB, voffB); PG8_STAGE(PG8_SB(0, 1), cB + hB, voffB); PG8_STAGE(PG8_SA(0, 0), cA, voffA); PG8_STAGE(PG8_SA(0, 1), cA + hA, voffA);
    if (wr == 1) PG8_BAR;
    PG8_WAIT_V(2); PG8_BAR;
    PG8_STAGE(PG8_SB(1, 0), cB + kstep, voffB); PG8_STAGE(PG8_SA(1, 0), cA + kstep, voffA); PG8_STAGE(PG8_SB(1, 1), cB + hB + kstep, voffB);
    PG8_WAIT_V(6); PG8_BAR;
#else
    PG8_STAGE(PG8_SB(0, 0), cB, voffB); PG8_STAGE(PG8_SA(0, 0), cA, voffA); PG8_STAGE(PG8_SB(0, 1), cB + hB, voffB); PG8_STAGE(PG8_SA(0, 1), cA + hA, voffA);
    if (wr == 1) PG8_BAR;
    PG8_WAIT_V(4); PG8_BAR;
    PG8_STAGE(PG8_SB(1, 0), cB + kstep, voffB); PG8_STAGE(PG8_SA(1, 0), cA + kstep, voffA); PG8_STAGE(PG8_SB(1, 1), cB + hB + kstep, voffB);
    PG8_WAIT_V(6); PG8_BAR;
#endif
    for (;;) {
        const bool has_next = S.next(ui + 1, nxt);
        const char* nA = has_next ? PG8_APTR(nxt) : cA; const char* nB = has_next ? PG8_BPTR(nxt) : cB;
        for (int t = 0; t < nt; t += 2) {
            const bool last = (t == nt - 2);
            const char* a1 = cA + (size_t)(t + 1) * kstep;
            const char* a2 = last ? nA : cA + (size_t)(t + 2) * kstep; const char* b2 = last ? nB : cB + (size_t)(t + 2) * kstep;
            const char* a3 = a2 + kstep; const char* b3 = b2 + kstep;
#if PG8_SP2
            PG8_LDB(B0, 0, 0); PG8_LDB(B1, 0, 1); PG8_SCHED; PG8_LDA(At, 0, 0); PG8_STAGE(PG8_SA(1, 1), a1 + hA, voffA);
            PG8_WAIT_V(8); PG8_WAIT_L(0); PG8_BAR; PG8_MMA(0, 0, At, B0); PG8_MMA(0, 1, At, B1); PG8_BAR; PG8_SCHED;
            PG8_LDA(At, 0, 1); PG8_STAGE(PG8_SB(0, 0), b2, voffB); PG8_STAGE(PG8_SB(0, 1), b2 + hB, voffB); PG8_STAGE(PG8_SA(0, 0), a2, voffA);
            PG8_WAIT_V(8); PG8_WAIT_L(0); PG8_BAR; PG8_MMA(1, 0, At, B0); PG8_MMA(1, 1, At, B1); PG8_BAR; PG8_SCHED;
            PG8_LDB(B0, 1, 0); PG8_LDB(B1, 1, 1); PG8_SCHED; PG8_LDA(At, 1, 0); PG8_STAGE(PG8_SA(0, 1), a2 + hA, voffA);
            PG8_WAIT_V(8); PG8_WAIT_L(0); PG8_BAR; PG8_MMA(0, 0, At, B0); PG8_MMA(0, 1, At, B1); PG8_BAR; PG8_SCHED;
            PG8_LDA(At, 1, 1); PG8_STAGE(PG8_SB(1, 0), b3, voffB); PG8_STAGE(PG8_SB(1, 1), b3 + hB, voffB); PG8_STAGE(PG8_SA(1, 0), a3, voffA);
            PG8_WAIT_V(8); PG8_WAIT_L(0); PG8_BAR; PG8_MMA(1, 0, At, B0); PG8_MMA(1, 1, At, B1); PG8_BAR; PG8_SCHED;
#else
            PG8_LDB(B0, 0, 0); PG8_SCHED; PG8_LDA(At, 0, 0); PG8_STAGE(PG8_SA(1, 1), a1 + hA, voffA);
            PG8_WAIT_L(8); PG8_BAR; PG8_WAIT_L(0); PG8_MMA(0, 0, At, B0); PG8_BAR; PG8_SCHED;
            PG8_LDB(B1, 0, 1); PG8_STAGE(PG8_SB(0, 0), b2, voffB);
            PG8_BAR; PG8_WAIT_L(0); PG8_MMA(0, 1, At, B1); PG8_BAR;
            PG8_LDA(At, 0, 1); PG8_STAGE(PG8_SA(0, 0), a2, voffA);
            PG8_BAR; PG8_WAIT_L(0); PG8_MMA(1, 0, At, B0); PG8_BAR; PG8_SCHED;
            PG8_STAGE(PG8_SB(0, 1), b2 + hB, voffB);
            PG8_WAIT_V(6); PG8_BAR; PG8_MMA(1, 1, At, B1); PG8_BAR;
            PG8_LDB(B0, 1, 0); PG8_SCHED; PG8_LDA(At, 1, 0); PG8_STAGE(PG8_SA(0, 1), a2 + hA, voffA);
            PG8_WAIT_L(8); PG8_BAR; PG8_WAIT_L(0); PG8_MMA(0, 0, At, B0); PG8_BAR; PG8_SCHED;
            PG8_LDB(B1, 1, 1); PG8_STAGE(PG8_SB(1, 0), b3, voffB);
            PG8_BAR; PG8_WAIT_L(0); PG8_MMA(0, 1, At, B1); PG8_BAR;
            PG8_LDA(At, 1, 1); PG8_STAGE(PG8_SA(1, 0), a3, voffA);
            PG8_BAR; PG8_WAIT_L(0); PG8_MMA(1, 0, At, B0); PG8_BAR; PG8_SCHED;
            PG8_STAGE(PG8_SB(1, 1), b3 + hB, voffB);
            PG8_WAIT_V(6); PG8_BAR; PG8_MMA(1, 1, At, B1); PG8_BAR;
#endif
        }
        if (wr == 0) PG8_BAR;
        { const int le_ = lane_id(); E(acc, cur, wr, wc, le_ & 15, le_ >> 4); }
        if (!has_next) break;
#pragma unroll
        for (int a = 0; a < 2; ++a)
#pragma unroll
            for (int b = 0; b < 2; ++b)
#pragma unroll
                for (int m = 0; m < 4; ++m)
#pragma unroll
                    for (int n = 0; n < 2; ++n) acc[a][b][m][n] = (f32x4){0.f, 0.f, 0.f, 0.f};
        cur = nxt; cA = nA; cB = nB; ++ui;
        PG8_LANESETUP();
        if (wr == 1) PG8_BAR;
    }
    PG8_WAIT_V(0);
    PG8_BAR;
#undef PG8_LANESETUP
#undef PG8_APTR
#undef PG8_BPTR
#undef PG8_SA
#undef PG8_SB
#undef PG8_STAGE
#undef PG8_LDA
#undef PG8_LDB
#undef PG8_MMA
#undef PG8_WAIT_V
#undef PG8_WAIT_L
#undef PG8_BAR
#undef PG8_SCHED
}

__device__ __forceinline__ u32x4 pack8(const f32x4 v0, const f32x4 v1) { u32x4 w; w.x = cvt_pk_bf16(v0[0], v0[1]); w.y = cvt_pk_bf16(v0[2], v0[3]); w.z = cvt_pk_bf16(v1[0], v1[1]); w.w = cvt_pk_bf16(v1[2], v1[3]); return w; }

struct EpiBf16 {
    static constexpr bool PERM = true;
    bf16_t* O; int ldc; float scale; int nh; long sb, sh; const float* rss; float rinv;
    __device__ __forceinline__ void operator()(const Acc& acc, const Unit& u, int wr, int wc, int fr, int fq) const {
        bf16_t* base = O + (size_t)(u.z / nh) * sb + (size_t)(u.z % nh) * sh;
        const int row0 = u.pm * BM + wr * 64 + fr, col0 = u.pn * BM + wc * 32 + 8 * fq;
#pragma unroll
        for (int ai = 0; ai < 2; ++ai)
#pragma unroll
            for (int m = 0; m < 4; ++m) { const int row = row0 + ai * HALF + m * 16; float sc = scale; if (rss) sc *= rsqrtf(rss[row] * rinv + RMS_EPS);
                bf16_t* rowp = base + (size_t)row * ldc + col0;
#pragma unroll
                for (int bj = 0; bj < 2; ++bj) *(u32x4*)(rowp + bj * HALF) = pack8(acc[ai][bj][m][0] * sc, acc[ai][bj][m][1] * sc); }
    }
};
template <size_t O_OFF, int ldc, size_t RS_OFF, size_t SV_OFF, size_t CV_OFF> struct EpiBf16LN {
    static constexpr bool PERM = true;
    unsigned char* wsb; float scale;
    __device__ __forceinline__ void operator()(const Acc& acc, const Unit& u, int wr, int wc, int fr, int fq) const {
        bf16_t* O = (bf16_t*)(wsb + O_OFF); const float* rs = (const float*)(wsb + RS_OFF); const float* sv = (const float*)(wsb + SV_OFF); const float* cv = (const float*)(wsb + CV_OFF);
        const int row0 = u.pm * BM + wr * 64 + fr, col0 = u.pn * BM + wc * 32 + 8 * fq;
        f32x2 st[2][4]; f32x4 s4[2][2], c4[2][2];
#pragma unroll
        for (int ai = 0; ai < 2; ++ai)
#pragma unroll
            for (int m = 0; m < 4; ++m) st[ai][m] = *(const f32x2*)(rs + (size_t)(row0 + ai * HALF + m * 16) * 2);
#pragma unroll
        for (int bj = 0; bj < 2; ++bj)
#pragma unroll
            for (int n = 0; n < 2; ++n) { s4[bj][n] = *(const f32x4*)(sv + col0 + bj * HALF + 4 * n); c4[bj][n] = *(const f32x4*)(cv + col0 + bj * HALF + 4 * n); }
        asm volatile("" ::: "memory");
#pragma unroll
        for (int ai = 0; ai < 2; ++ai)
#pragma unroll
            for (int m = 0; m < 4; ++m) { const int row = row0 + ai * HALF + m * 16; const float mean = st[ai][m].x * (1.0f / D), rstd = rsqrtf(st[ai][m].y * (1.0f / D) - mean * mean + LN_EPS) * scale;
                bf16_t* rowp = O + (size_t)row * ldc + col0;
#pragma unroll
                for (int bj = 0; bj < 2; ++bj) *(u32x4*)(rowp + bj * HALF) = pack8((acc[ai][bj][m][0] - s4[bj][0] * mean) * rstd + c4[bj][0] * scale, (acc[ai][bj][m][1] - s4[bj][1] * mean) * rstd + c4[bj][1] * scale); }
    }
};
struct EpiF32 {
    static constexpr bool PERM = false;
    float* C; int ldc; int nh; long sb, sh;
    __device__ __forceinline__ void operator()(const Acc& acc, const Unit& u, int wr, int wc, int fr, int fq) const {
        float* base = C + (size_t)(u.z / nh) * sb + (size_t)(u.z % nh) * sh;
        const int row0 = u.pm * BM + wr * 64 + fr, col0 = u.pn * BM + wc * 32 + 4 * fq;
#pragma unroll
        for (int ai = 0; ai < 2; ++ai)
#pragma unroll
            for (int m = 0; m < 4; ++m) { float* rowp = base + (size_t)(row0 + ai * HALF + m * 16) * ldc + col0;
#pragma unroll
                for (int bj = 0; bj < 2; ++bj)
#pragma unroll
                    for (int n = 0; n < 2; ++n) *(f32x4*)(rowp + bj * HALF + n * 16) = acc[ai][bj][m][n]; }
    }
};
__device__ __forceinline__ void row_stat_add(float* rs, int row, float s_, float q_, int fq) {
    s_ += __shfl_xor(s_, 16); s_ += __shfl_xor(s_, 32); q_ += __shfl_xor(q_, 16); q_ += __shfl_xor(q_, 32);
    if (fq < 2) atomicAdd(rs + (size_t)row * 2 + fq, fq == 0 ? s_ : q_);
}
template <size_t ZB_OFF, size_t RS_OFF> struct EpiResStat {
    static constexpr bool PERM = true;
    unsigned char* wsb; const float* base;
    __device__ __forceinline__ void operator()(const Acc& acc, const Unit& u, int wr, int wc, int fr, int fq) const {
        bf16_t* ZB = (bf16_t*)(wsb + ZB_OFF); float* rs = (float*)(wsb + RS_OFF);
        const int row0 = u.pm * BM + wr * 64 + fr, col0 = u.pn * BM + wc * 32 + 8 * fq;
#pragma unroll
        for (int ah = 0; ah < 4; ++ah) { const int ai = ah >> 1, mh = ah & 1; f32x4 bs[2][2][2];
#pragma unroll
            for (int ml = 0; ml < 2; ++ml)
#pragma unroll
                for (int bj = 0; bj < 2; ++bj)
#pragma unroll
                    for (int n = 0; n < 2; ++n) bs[ml][bj][n] = *(const f32x4*)(base + (size_t)(row0 + ai * HALF + (2 * mh + ml) * 16) * D + col0 + bj * HALF + 4 * n);
            asm volatile("" ::: "memory");
#pragma unroll
            for (int ml = 0; ml < 2; ++ml) { const int m = 2 * mh + ml, row = row0 + ai * HALF + m * 16; const size_t off = (size_t)row * D + col0; float s_ = 0.f, q_ = 0.f;
#pragma unroll
                for (int bj = 0; bj < 2; ++bj) { f32x4 z[2];
#pragma unroll
                    for (int n = 0; n < 2; ++n) { z[n] = bs[ml][bj][n] * ALPHA + acc[ai][bj][m][n];
                        s_ += (z[n][0] + z[n][1]) + (z[n][2] + z[n][3]); q_ += (z[n][0] * z[n][0] + z[n][1] * z[n][1]) + (z[n][2] * z[n][2] + z[n][3] * z[n][3]); }
                    *(u32x4*)(ZB + off + bj * HALF) = pack8(z[0], z[1]); }
                row_stat_add(rs, row, s_, q_, fq); }
            asm volatile("" ::: "memory"); }
    }
};
template <size_t ZB_OFF, size_t RSIN_OFF, size_t RSOUT_OFF, bool STATS, int ZR = 0> struct EpiResLN {
    static constexpr bool PERM = true;
    unsigned char* wsb; const float* g; const float* b;
    __device__ __forceinline__ void operator()(const Acc& acc, const Unit& u, int wr, int wc, int fr, int fq) const {
        bf16_t* ZB = (bf16_t*)(wsb + ZB_OFF); const float* rsin = (const float*)(wsb + RSIN_OFF); float* rsout = (float*)(wsb + RSOUT_OFF);
        const int row0 = u.z * ZR + u.pm * BM + wr * 64 + fr, col0 = u.pn * BM + wc * 32 + 8 * fq;
        f32x4 g4[2][2], b4[2][2];
#pragma unroll
        for (int bj = 0; bj < 2; ++bj)
#pragma unroll
            for (int n = 0; n < 2; ++n) { g4[bj][n] = *(const f32x4*)(g + col0 + bj * HALF + 4 * n); b4[bj][n] = *(const f32x4*)(b + col0 + bj * HALF + 4 * n); }
#pragma unroll
        for (int ah = 0; ah < 4; ++ah) { const int ai = ah >> 1, mh = ah & 1; u32x4 zw[2][2]; f32x2 st[2];
#pragma unroll
            for (int ml = 0; ml < 2; ++ml) { const size_t row = (size_t)(row0 + ai * HALF + (2 * mh + ml) * 16); st[ml] = *(const f32x2*)(rsin + row * 2);
#pragma unroll
                for (int bj = 0; bj < 2; ++bj) zw[ml][bj] = *(const u32x4*)(ZB + row * D + col0 + bj * HALF); }
            asm volatile("" ::: "memory");
#pragma unroll
            for (int ml = 0; ml < 2; ++ml) { const int m = 2 * mh + ml, row = row0 + ai * HALF + m * 16; const size_t off = (size_t)row * D + col0; float s_ = 0.f, q_ = 0.f;
                const float mean = st[ml].x * (1.0f / D), rstd = rsqrtf(st[ml].y * (1.0f / D) - mean * mean + LN_EPS);
#pragma unroll
                for (int bj = 0; bj < 2; ++bj) { const u32x4 w_ = zw[ml][bj]; f32x4 z[2];
                    const f32x4 zo0 = {bf_lo(w_.x), bf_hi(w_.x), bf_lo(w_.y), bf_hi(w_.y)}, zo1 = {bf_lo(w_.z), bf_hi(w_.z), bf_lo(w_.w), bf_hi(w_.w)};
                    z[0] = ((zo0 - mean) * rstd * g4[bj][0] + b4[bj][0]) * ALPHA + acc[ai][bj][m][0]; z[1] = ((zo1 - mean) * rstd * g4[bj][1] + b4[bj][1]) * ALPHA + acc[ai][bj][m][1];
#pragma unroll
                    for (int n = 0; n < 2; ++n) { s_ += (z[n][0] + z[n][1]) + (z[n][2] + z[n][3]); q_ += (z[n][0] * z[n][0] + z[n][1] * z[n][1]) + (z[n][2] * z[n][2] + z[n][3] * z[n][3]); }
                    *(u32x4*)(ZB + off + bj * HALF) = pack8(z[0], z[1]); }
                if (STATS) row_stat_add(rsout, row, s_, q_, fq); }
            asm volatile("" ::: "memory"); }
    }
};
struct EpiGate0 {
    static constexpr bool PERM = true;
    bf16_t* C; const bf16_t* G;
    __device__ __forceinline__ void operator()(const Acc& acc, const Unit& u, int wr, int wc, int fr, int fq) const {
        const int row0 = u.pm * BM + wr * 64 + fr, col0 = u.pn * BM + wc * 32 + 8 * fq;
#pragma unroll
        for (int ai = 0; ai < 2; ++ai) { u32x4 gw[4][2];
#pragma unroll
            for (int m = 0; m < 4; ++m)
#pragma unroll
                for (int bj = 0; bj < 2; ++bj) gw[m][bj] = *(const u32x4*)(G + (size_t)(row0 + ai * HALF + m * 16) * GTP + col0 + bj * HALF);
            asm volatile("" ::: "memory");
#pragma unroll
            for (int m = 0; m < 4; ++m) { const int row = row0 + ai * HALF + m * 16;
#pragma unroll
                for (int bj = 0; bj < 2; ++bj) { const int col = col0 + bj * HALF; const u32x4 g = gw[m][bj];
                    const f32x4 g0 = {bf_lo(g.x), bf_hi(g.x), bf_lo(g.y), bf_hi(g.y)}, g1 = {bf_lo(g.z), bf_hi(g.z), bf_lo(g.w), bf_hi(g.w)};
                    *(u32x4*)(C + (size_t)row * D + col) = pack8(g0 * acc[ai][bj][m][0], g1 * acc[ai][bj][m][1]); } }
            asm volatile("" ::: "memory"); }
    }
};
struct EpiGate1 {
    static constexpr bool PERM = true;
    bf16_t* O; const bf16_t* TMP; const bf16_t* G;
    __device__ __forceinline__ void operator()(const Acc& acc, const Unit& u, int wr, int wc, int fr, int fq) const {
        const int row0 = u.pm * BM + wr * 64 + fr, col0 = u.pn * BM + wc * 32 + 8 * fq;
#pragma unroll
        for (int ah = 0; ah < 4; ++ah) { const int ai = ah >> 1, mh = ah & 1; u32x4 g0w[2][2], g1w[2][2], tw[2][2];
#pragma unroll
            for (int ml = 0; ml < 2; ++ml)
#pragma unroll
                for (int bj = 0; bj < 2; ++bj) { const size_t row = (size_t)(row0 + ai * HALF + (2 * mh + ml) * 16);
                    g0w[ml][bj] = *(const u32x4*)(G + row * GTP + col0 + bj * HALF); g1w[ml][bj] = *(const u32x4*)(G + row * GTP + 4096 + col0 + bj * HALF); tw[ml][bj] = *(const u32x4*)(TMP + row * D + col0 + bj * HALF); }
            asm volatile("" ::: "memory");
#pragma unroll
            for (int ml = 0; ml < 2; ++ml) { const int m = 2 * mh + ml, row = row0 + ai * HALF + m * 16;
#pragma unroll
                for (int bj = 0; bj < 2; ++bj) { const int col = col0 + bj * HALF; const u32x4 ga = g0w[ml][bj], gb = g1w[ml][bj], t = tw[ml][bj];
                    const f32x4 a0 = {bf_lo(ga.x), bf_hi(ga.x), bf_lo(ga.y), bf_hi(ga.y)}, a1 = {bf_lo(ga.z), bf_hi(ga.z), bf_lo(ga.w), bf_hi(ga.w)};
                    const f32x4 b0 = {bf_lo(gb.x), bf_hi(gb.x), bf_lo(gb.y), bf_hi(gb.y)}, b1 = {bf_lo(gb.z), bf_hi(gb.z), bf_lo(gb.w), bf_hi(gb.w)};
                    const f32x4 t0 = {bf_lo(t.x), bf_hi(t.x), bf_lo(t.y), bf_hi(t.y)}, t1 = {bf_lo(t.z), bf_hi(t.z), bf_lo(t.w), bf_hi(t.w)};
                    *(u32x4*)(O + (size_t)row * D + col) = pack8(a0 * t0 + b0 * acc[ai][bj][m][0], a1 * t1 + b1 * acc[ai][bj][m][1]); } }
            asm volatile("" ::: "memory"); }
    }
};
__device__ __forceinline__ unsigned dpp_ror1u(unsigned x)  { return (unsigned)__builtin_amdgcn_update_dpp(0, (int)x, 0x121, 0xf, 0xf, false); }
__device__ __forceinline__ unsigned dpp_ror15u(unsigned x) { return (unsigned)__builtin_amdgcn_update_dpp(0, (int)x, 0x12f, 0xf, 0xf, false); }
template <size_t ACT_OFF, size_t EDGE_OFF, size_t RS_OFF, size_t SV_OFF, size_t CV_OFF, size_t CW_OFF, size_t CB_OFF> struct EpiFfnConv {
    static constexpr bool PERM = true;
    unsigned char* wsb; LAS unsigned* H;
    __device__ __forceinline__ void operator()(const Acc& acc, const Unit& u, int wr, int wc, int fr, int fq) const {
        bf16_t* ACT = (bf16_t*)(wsb + ACT_OFF); unsigned* EDGE = (unsigned*)(wsb + EDGE_OFF);
        const float* rs = (const float*)(wsb + RS_OFF); const float* sv = (const float*)(wsb + SV_OFF); const float* cv = (const float*)(wsb + CV_OFF);
        const float* cw = (const float*)(wsb + CW_OFF); const float* cb = (const float*)(wsb + CB_OFF);
        int frl = fr, colt = wc * 32 + 8 * fq; asm volatile("" : "+v"(frl), "+v"(colt));
        const int row0 = u.pm * BM + wr * 64 + frl;
        u32x2 P[2][2][4][2];
#pragma unroll
        for (int ai = 0; ai < 2; ++ai) { float mean[4], rstd[4];
#pragma unroll
            for (int m = 0; m < 4; ++m) { const f32x2 st = *(const f32x2*)(rs + (size_t)(row0 + ai * HALF + m * 16) * 2); mean[m] = st.x * (1.0f / D); rstd[m] = rsqrtf(st.y * (1.0f / D) - mean[m] * mean[m] + LN_EPS); }
#pragma unroll
            for (int bj = 0; bj < 2; ++bj) { f32x4 s4[2], c4[2];
#pragma unroll
                for (int n = 0; n < 2; ++n) { s4[n] = *(const f32x4*)(sv + u.pn * BM + bj * HALF + colt + 4 * n); c4[n] = *(const f32x4*)(cv + u.pn * BM + bj * HALF + colt + 4 * n); }
#pragma unroll
                for (int m = 0; m < 4; ++m)
#pragma unroll
                    for (int n = 0; n < 2; ++n) { const f32x4 v = (acc[ai][bj][m][n] - s4[n] * mean[m]) * rstd[m] + c4[n]; P[ai][bj][m][n].x = cvt_pk_bf16(v[0], v[1]); P[ai][bj][m][n].y = cvt_pk_bf16(v[2], v[3]); }
                __builtin_amdgcn_sched_barrier(0); } }
        if (frl == 0 || frl == 15) { const int tb = frl == 15 ? 1 : 0;
#pragma unroll
            for (int ai = 0; ai < 2; ++ai)
#pragma unroll
                for (int bj = 0; bj < 2; ++bj)
#pragma unroll
                    for (int n = 0; n < 2; ++n) { const int hp = (bj * HALF + colt + 4 * n) >> 1, blk = 2 * ai + wr; const unsigned mk = 0u - (unsigned)tb; u32x2 v; v.x = (P[ai][bj][0][n].x & ~mk) | (P[ai][bj][3][n].x & mk); v.y = (P[ai][bj][0][n].y & ~mk) | (P[ai][bj][3][n].y & mk);
                        *(LAS u32x2*)(H + (blk * 2 + tb) * 128 + hp) = v; } }
        if (wr == 0 ? frl < 2 : frl >= 14) { const int e = wr == 0 ? frl : frl - 12;
#pragma unroll
            for (int bj = 0; bj < 2; ++bj)
#pragma unroll
                for (int n = 0; n < 2; ++n) { const int hp = (bj * HALF + colt + 4 * n) >> 1; const unsigned mk = wr == 0 ? 0u : ~0u; u32x2 v; v.x = (P[0][bj][0][n].x & ~mk) | (P[1][bj][3][n].x & mk); v.y = (P[0][bj][0][n].y & ~mk) | (P[1][bj][3][n].y & mk);
                    *(u32x2*)(EDGE + (size_t)(u.pm * 4 + e) * (DFF2 / 2) + u.pn * (BM / 2) + hp) = v; } }
        asm volatile("s_waitcnt lgkmcnt(0)" ::: "memory"); __builtin_amdgcn_s_barrier(); asm volatile("" ::: "memory");
#pragma unroll
        for (int n = 0; n < 2; ++n) {
            f32x4 W[2][4];
#pragma unroll
            for (int bj = 0; bj < 2; ++bj) { const int c_ = bj * DFF + u.pn * 128 + colt + 4 * n;
                W[bj][0] = *(const f32x4*)(cw + c_); W[bj][1] = *(const f32x4*)(cw + DFF2 + c_); W[bj][2] = *(const f32x4*)(cw + 2 * (size_t)DFF2 + c_); W[bj][3] = *(const f32x4*)(cb + c_); }
            asm volatile("" ::: "memory");
#pragma unroll
            for (int ai = 0; ai < 2; ++ai) { int frb = frl, colb = colt; asm volatile("" : "+v"(frb), "+v"(colb));
                const int ch = u.pn * 128 + colb + 4 * n, blk = 2 * ai + wr, bup = blk > 0 ? blk - 1 : 0, bdn = blk < 3 ? blk + 1 : 3;
                const bool first = frb == 0, lastl = frb == 15;
                u32x2 ht[2], hb[2];
#pragma unroll
                for (int bj = 0; bj < 2; ++bj) { const int hp = (bj * HALF + colb + 4 * n) >> 1; ht[bj] = *(const LAS u32x2*)(H + (bup * 2 + 1) * 128 + hp); hb[bj] = *(const LAS u32x2*)(H + (bdn * 2 + 0) * 128 + hp); }
                unsigned wlo[4];
#pragma unroll
                for (int jp = 0; jp < 2; ++jp) { float cu0[4], cu1[4];
#pragma unroll
                    for (int bj = 0; bj < 2; ++bj) {
                        const f32x2 w0 = {W[bj][0][2 * jp], W[bj][0][2 * jp + 1]}, w1 = {W[bj][1][2 * jp], W[bj][1][2 * jp + 1]}, w2 = {W[bj][2][2 * jp], W[bj][2][2 * jp + 1]}, bb = {W[bj][3][2 * jp], W[bj][3][2 * jp + 1]};
                        unsigned a[4], b[4];
#pragma unroll
                        for (int m = 0; m < 4; ++m) { a[m] = dpp_ror1u(P[ai][bj][m][n][jp]); b[m] = dpp_ror15u(P[ai][bj][m][n][jp]); }
#pragma unroll
                        for (int m = 0; m < 4; ++m) { const unsigned xc = P[ai][bj][m][n][jp];
                            const unsigned pv = first ? (m > 0 ? a[m > 0 ? m - 1 : 0] : ht[bj][jp]) : a[m];
                            const unsigned nx = lastl ? (m < 3 ? b[m < 3 ? m + 1 : 3] : hb[bj][jp]) : b[m];
                            const float r0 = bf_lo(pv) * w0[0] + bf_lo(xc) * w1[0] + bf_lo(nx) * w2[0] + bb[0];
                            const float r1 = bf_hi(pv) * w0[1] + bf_hi(xc) * w1[1] + bf_hi(nx) * w2[1] + bb[1];
                            if (bj == 0) { cu0[m] = r0; cu1[m] = r1; }
                            else { cu0[m] = siluf_(r0) * cu0[m]; cu1[m] = siluf_(r1) * cu1[m]; } } }
#pragma unroll
                    for (int m = 0; m < 4; ++m) { const unsigned w_ = cvt_pk_bf16(cu0[m], cu1[m]);
                        if (jp == 0) wlo[m] = w_;
                        else { const int rt = ai * HALF + wr * 64 + m * 16 + frb; u32x2 w; w.x = wlo[m]; w.y = w_;
                               *(u32x2*)(ACT + (size_t)(u.pm * BM + rt) * DFF + ch) = w; } } }
                asm volatile("" ::: "memory"); __builtin_amdgcn_sched_barrier(0); } }
    }
};
struct EpiRetS {
    static constexpr bool PERM = true;
    bf16_t* O; const float* dec;
    __device__ __forceinline__ void operator()(const Acc& acc, const Unit& u, int wr, int wc, int fr, int fq) const {
        const int h = u.z & 7; const float lf = dec[h], lb = dec[8 + h];
        bf16_t* base = O + (size_t)u.z * SEQ * SEQ;
        int frl = fr, cwl = wc * 32 + 8 * fq; asm volatile("" : "+v"(frl), "+v"(cwl));
        const int rl0 = wr * 64 + frl, row0 = u.pm * BM + rl0, col0 = u.pn * BM + cwl;
        if (u.pm != u.pn) {
            const bool below = u.pm > u.pn; const float lg = below ? lf : lb;
            const float cb0 = below ? (float)((u.pm - u.pn) * BM) : (float)((u.pn - u.pm) * BM - 255);
            float R[2][4]; f32x4 C[2][2];
#pragma unroll
            for (int ai = 0; ai < 2; ++ai)
#pragma unroll
                for (int m = 0; m < 4; ++m) { const float r_ = (float)(rl0 + ai * HALF + m * 16); R[ai][m] = __builtin_amdgcn_exp2f((below ? r_ : 255.0f - r_) * lg); }
#pragma unroll
            for (int bj = 0; bj < 2; ++bj)
#pragma unroll
                for (int n = 0; n < 2; ++n)
#pragma unroll
                    for (int j = 0; j < 4; ++j) { const float c_ = (float)(cwl + bj * HALF + 4 * n + j); C[bj][n][j] = __builtin_amdgcn_exp2f((below ? cb0 - c_ : cb0 + c_) * lg); }
#pragma unroll
            for (int ai = 0; ai < 2; ++ai)
#pragma unroll
                for (int m = 0; m < 4; ++m) { const int row = row0 + ai * HALF + m * 16;
#pragma unroll
                    for (int bj = 0; bj < 2; ++bj) *(u32x4*)(base + (size_t)row * SEQ + col0 + bj * HALF) = pack8(acc[ai][bj][m][0] * C[bj][0] * R[ai][m], acc[ai][bj][m][1] * C[bj][1] * R[ai][m]); }
        } else {
#pragma unroll
            for (int ai = 0; ai < 2; ++ai)
#pragma unroll
                for (int m = 0; m < 4; ++m) { const int row = row0 + ai * HALF + m * 16;
#pragma unroll
                    for (int bj = 0; bj < 2; ++bj) { const int col = col0 + bj * HALF; f32x4 v[2];
#pragma unroll
                        for (int n = 0; n < 2; ++n)
#pragma unroll
                            for (int j = 0; j < 4; ++j) { const int dd = row - (col + 4 * n + j); const float e = dd >= 0 ? (float)dd * lf : (float)(-dd) * lb; v[n][j] = acc[ai][bj][m][n][j] * __builtin_amdgcn_exp2f(e); }
                        *(u32x4*)(base + (size_t)row * SEQ + col) = pack8(v[0], v[1]); } }
        }
    }
};
struct EpiQ {
    static constexpr bool PERM = true;
    bf16_t* Q; const float* rss; const int* pos;
    __device__ __forceinline__ void operator()(const Acc& acc, const Unit& u, int wr, int wc, int fr, int fq) const {
        const int row0 = u.pm * BM + wr * 64 + fr;
        float rs[2][4]; int ps[2][4];
#pragma unroll
        for (int ai = 0; ai < 2; ++ai)
#pragma unroll
            for (int m = 0; m < 4; ++m) { rs[ai][m] = rss[row0 + ai * HALF + m * 16]; ps[ai][m] = pos[row0 + ai * HALF + m * 16]; }
        asm volatile("" ::: "memory");
        if (u.pn < 8) {
#pragma unroll
            for (int ai = 0; ai < 2; ++ai)
#pragma unroll
                for (int m = 0; m < 4; ++m) { const int row = row0 + ai * HALF + m * 16; const float sc = rsqrtf(rs[ai][m] * (1.0f / 1024.0f) + RMS_EPS); bf16_t* qrow = Q + (size_t)row * 3072;
#pragma unroll
                    for (int bj = 0; bj < 2; ++bj) *(u32x4*)(qrow + (2 * u.pn + bj) * 192 + wc * 32 + 8 * fq) = pack8(acc[ai][bj][m][0] * sc, acc[ai][bj][m][1] * sc); }
        } else {
            const int head = 4 * (u.pn - 8) + wc; float invr[8]; int fql = fq; asm volatile("" : "+v"(fql));
#pragma unroll
            for (int i = 0; i < 8; ++i) invr[i] = rope_invr(8 * fql + i, 1.0f / 32.0f);
#pragma unroll
            for (int ai = 0; ai < 2; ++ai)
#pragma unroll
                for (int m = 0; m < 4; ++m) { const int row = row0 + ai * HALF + m * 16; const float sc = rsqrtf(rs[ai][m] * (1.0f / 1024.0f) + RMS_EPS), pf = (float)ps[ai][m]; bf16_t* qrow = Q + (size_t)row * 3072; f32x4 o1[2], o2[2];
#pragma unroll
                    for (int n = 0; n < 2; ++n)
#pragma unroll
                        for (int j = 0; j < 4; ++j) { float c, sn; rope_cs(pf, invr[4 * n + j], c, sn); const float t1 = acc[ai][0][m][n][j] * sc, t2 = acc[ai][1][m][n][j] * sc; o1[n][j] = t1 * c - t2 * sn; o2[n][j] = t2 * c + t1 * sn; }
                    *(u32x4*)(qrow + head * 192 + 128 + 8 * fq) = pack8(o1[0], o1[1]); *(u32x4*)(qrow + head * 192 + 160 + 8 * fq) = pack8(o2[0], o2[1]); }
        }
    }
};
struct EpiProj {
    static constexpr bool PERM = true;
    bf16_t *CQ, *CKV, *KPE, *RQ, *RK, *RVT, *RG, *GT; float* rss; const int* pos; const float* gbias; LAS unsigned char* lds;
    __device__ __forceinline__ void operator()(const Acc& acc, const Unit& u, int wr, int wc, int fr, int fq) const {
        int fql = fq; asm volatile("" : "+v"(fql));
        const int pn = u.pn, row0 = u.pm * BM + wr * 64 + fr, cw = wc * 32 + 8 * fq, cwl = wc * 32 + 8 * fql;
        if (pn < 6) {
            bf16_t* O = pn < 4 ? CQ : CKV; const int ldc = pn < 4 ? 1024 : 512, colt = pn < 4 ? pn * BM : (pn - 4) * BM; float* ss = rss + (pn < 4 ? 0 : T);
#pragma unroll
            for (int ai = 0; ai < 2; ++ai)
#pragma unroll
                for (int m = 0; m < 4; ++m) { const int row = row0 + ai * HALF + m * 16; float s = 0.f;
#pragma unroll
                    for (int bj = 0; bj < 2; ++bj) { const f32x4 a = acc[ai][bj][m][0], b = acc[ai][bj][m][1];
                        s += (a[0] * a[0] + a[1] * a[1]) + (a[2] * a[2] + a[3] * a[3]) + (b[0] * b[0] + b[1] * b[1]) + (b[2] * b[2] + b[3] * b[3]);
                        *(u32x4*)(O + (size_t)row * ldc + colt + bj * HALF + cw) = pack8(a, b); }
                    s += __shfl_xor(s, 16); s += __shfl_xor(s, 32);
                    if (fq == 0) atomicAdd(ss + row, s); }
        } else if (pn == 6) {
            if (wc == 0) {
                int ps[2][4]; float invr[8];
#pragma unroll
                for (int ai = 0; ai < 2; ++ai)
#pragma unroll
                    for (int m = 0; m < 4; ++m) ps[ai][m] = pos[row0 + ai * HALF + m * 16];
                asm volatile("" ::: "memory");
#pragma unroll
                for (int i = 0; i < 8; ++i) invr[i] = rope_invr(8 * fql + i, 1.0f / 32.0f);
#pragma unroll
                for (int ai = 0; ai < 2; ++ai)
#pragma unroll
                    for (int m = 0; m < 4; ++m) { const int row = row0 + ai * HALF + m * 16; const float pf = (float)ps[ai][m]; f32x4 o1[2], o2[2];
#pragma unroll
                        for (int n = 0; n < 2; ++n)
#pragma unroll
                            for (int j = 0; j < 4; ++j) { float c, sn; rope_cs(pf, invr[4 * n + j], c, sn); const float t1 = acc[ai][0][m][n][j], t2 = acc[ai][1][m][n][j]; o1[n][j] = t1 * c - t2 * sn; o2[n][j] = t2 * c + t1 * sn; }
                        *(u32x4*)(KPE + (size_t)row * 64 + 8 * fq) = pack8(o1[0], o1[1]); *(u32x4*)(KPE + (size_t)row * 64 + 32 + 8 * fq) = pack8(o2[0], o2[1]); }
            }
        } else if (pn < 23) {
            const bool isk = pn >= 15; const int head = isk ? pn - 15 : pn - 7; bf16_t* O = isk ? RK : RQ; const float sc = isk ? 0.0625f : 1.0f;
            int ps[2][4]; float invr[8];
#pragma unroll
            for (int ai = 0; ai < 2; ++ai)
#pragma unroll
                for (int m = 0; m < 4; ++m) ps[ai][m] = pos[row0 + ai * HALF + m * 16];
            asm volatile("" ::: "memory");
#pragma unroll
            for (int i = 0; i < 8; ++i) invr[i] = rope_invr(cwl + i, 1.0f / 128.0f);
#pragma unroll
            for (int ai = 0; ai < 2; ++ai)
#pragma unroll
                for (int m = 0; m < 4; ++m) { const int row = row0 + ai * HALF + m * 16; const float pf = (float)ps[ai][m]; f32x4 o1[2], o2[2];
#pragma unroll
                    for (int n = 0; n < 2; ++n)
#pragma unroll
                        for (int j = 0; j < 4; ++j) { float c, sn; rope_cs(pf, invr[4 * n + j], c, sn); const float t1 = acc[ai][0][m][n][j] * sc, t2 = acc[ai][1][m][n][j] * sc; o1[n][j] = t1 * c - t2 * sn; o2[n][j] = t2 * c + t1 * sn; }
                    bf16_t* op = O + (size_t)row * 2048 + head * 256 + cw;
                    *(u32x4*)op = pack8(o1[0], o1[1]); *(u32x4*)(op + 128) = pack8(o2[0], o2[1]); }
        } else if (pn < 39) {
            const int t = pn - 23, head = t >> 1, e0 = (t & 1) * 256, lane = fq * 16 + fr;
            LAS unsigned char* tb = lds + TR_OFF + (wr * 4 + wc) * 2048;
            const int b = (u.pm * BM) >> 11, s0 = (u.pm * BM) & 2047;
#pragma unroll
            for (int ai = 0; ai < 2; ++ai)
#pragma unroll
                for (int bj = 0; bj < 2; ++bj)
#pragma unroll
                    for (int n = 0; n < 2; ++n) {
#pragma unroll
                        for (int m = 0; m < 4; ++m)
#pragma unroll
                            for (int j = 0; j < 4; ++j) { const unsigned w = cvt_pk_bf16(acc[ai][bj][m][n][j], 0.f); *(LAS bf16_t*)(tb + (4 * fq + j) * 128 + (16 * m + fr) * 2) = (bf16_t)(w & 0xffffu); }
#pragma unroll
                        for (int i = 0; i < 2; ++i) { const int q = lane + 64 * i, lc = q >> 3, rc = q & 7; const u32x4 v = *(const LAS u32x4*)(tb + lc * 128 + rc * 16);
                            const int e = e0 + bj * HALF + wc * 32 + 8 * (lc >> 2) + 4 * n + (lc & 3), sp = s0 + ai * HALF + wr * 64 + rc * 8;
                            *(u32x4*)(RVT + ((size_t)(b * 8 + head) * 512 + e) * SEQ + sp) = v; }
                    }
        } else if (pn < 55) {
            const int colt = (pn - 39) * BM;
#pragma unroll
            for (int ai = 0; ai < 2; ++ai)
#pragma unroll
                for (int m = 0; m < 4; ++m) { const int row = row0 + ai * HALF + m * 16;
#pragma unroll
                    for (int bj = 0; bj < 2; ++bj) { f32x4 v[2];
#pragma unroll
                        for (int n = 0; n < 2; ++n)
#pragma unroll
                            for (int j = 0; j < 4; ++j) v[n][j] = siluf_(acc[ai][bj][m][n][j]);
                        *(u32x4*)(RG + (size_t)row * RGP + colt + bj * HALF + cw) = pack8(v[0], v[1]); } }
        } else {
            const int colt = (pn - 55) * BM;
#pragma unroll
            for (int ai = 0; ai < 2; ++ai)
#pragma unroll
                for (int m = 0; m < 4; ++m) { const int row = row0 + ai * HALF + m * 16;
#pragma unroll
                    for (int bj = 0; bj < 2; ++bj) { const int col = colt + bj * HALF + cw; const f32x4 b0 = *(const f32x4*)(gbias + col), b1 = *(const f32x4*)(gbias + col + 4); f32x4 v[2];
#pragma unroll
                        for (int j = 0; j < 4; ++j) { v[0][j] = sigmoidf_(acc[ai][bj][m][0][j] + b0[j]); v[1][j] = sigmoidf_(acc[ai][bj][m][1][j] + b1[j]); }
                        *(u32x4*)(GT + (size_t)row * GTP + col) = pack8(v[0], v[1]); } }
        }
    }
};
}

namespace att {
constexpr int NW = 8, QBLK = 32, KVBLK = 64;
constexpr float SCALE = 0.07216878364870323f;
constexpr float THR = 8.f;
constexpr int LDQ = 3072, LDKV = 4096, LDKR = 64, LDO = 2048;
constexpr int SHM_V = KVBLK * 128 * 2, SHM_K = KVBLK * 128 * 2, SHM_KR = KVBLK * 64 * 2;
constexpr int OFF_V = 0, OFF_K = 2 * SHM_V, OFF_KR = OFF_K + 2 * SHM_K, OFF_WS = OFF_KR + 2 * SHM_KR, OFF_QR = OFF_WS + NW * 64 * 4, ATT_LDS = OFF_QR + NW * 4096;
#define KSWZ(row, colB) ((row) * 256 + ((colB) ^ (((row) & 7) << 4)))
#define KRSWZ(row, colB) ((row) * 128 + ((colB) ^ ((((row) >> 1) & 7) << 4)))
#define SBAR() __builtin_amdgcn_sched_barrier(0)
typedef LAS char* lptr;
__device__ __forceinline__ int crow(int r, int hi) { return (r & 3) + 8 * (r >> 2) + 4 * hi; }
__device__ __forceinline__ void partialSM(f32x16& p0, f32x16& p1, float& m_reg, float& mn, float& alpha) {
    constexpr float C = SCALE * 1.4426950408889634f;
    float pmax = p0[0];
#pragma unroll
    for (int r = 1; r < 16; ++r) pmax = fmaxf(pmax, p0[r]);
#pragma unroll
    for (int r = 0; r < 16; ++r) pmax = fmaxf(pmax, p1[r]);
    { auto rr = __builtin_amdgcn_permlane32_swap(__float_as_uint(pmax), __float_as_uint(pmax), false, false);
      pmax = fmaxf(__uint_as_float(rr[0]), __uint_as_float(rr[1])); }
    if (__builtin_expect(__all(pmax - m_reg <= THR / SCALE), 1)) { mn = m_reg; alpha = 1.f; }
    else { mn = fmaxf(m_reg, pmax); alpha = __builtin_amdgcn_exp2f((m_reg - mn) * C); m_reg = mn; }
    const float mnC = -mn * C;
#pragma unroll
    for (int r = 0; r < 16; ++r) p0[r] = fmaf(p0[r], C, mnC);
#pragma unroll
    for (int r = 0; r < 16; ++r) p1[r] = fmaf(p1[r], C, mnC);
#pragma unroll
    for (int r = 0; r < 16; ++r) p0[r] = __builtin_amdgcn_exp2f(p0[r]);
}
__device__ __forceinline__ void finishSM(f32x16& p0, f32x16& p1, float alpha, float& l_reg, bf16x8& pa0, bf16x8& pa1, bf16x8& pa2, bf16x8& pa3) {
#pragma unroll
    for (int r = 0; r < 16; ++r) p1[r] = __builtin_amdgcn_exp2f(p1[r]);
    float ps = 0;
#pragma unroll
    for (int r = 0; r < 16; ++r) ps += p0[r];
#pragma unroll
    for (int r = 0; r < 16; ++r) ps += p1[r];
    { auto rr = __builtin_amdgcn_permlane32_swap(__float_as_uint(ps), __float_as_uint(ps), false, false);
      ps = __uint_as_float(rr[0]) + __uint_as_float(rr[1]); }
    l_reg = l_reg * alpha + ps;
#define PK4(P, BASE, OUT) do { unsigned a0 = cvt_pk_bf16(P[BASE + 0], P[BASE + 1]), a1 = cvt_pk_bf16(P[BASE + 2], P[BASE + 3]);   \
    unsigned b0 = cvt_pk_bf16(P[BASE + 4], P[BASE + 5]), b1 = cvt_pk_bf16(P[BASE + 6], P[BASE + 7]);                              \
    auto r0 = __builtin_amdgcn_permlane32_swap(a0, b0, false, false); auto r1 = __builtin_amdgcn_permlane32_swap(a1, b1, false, false); \
    u32x4 w = {r0[0], r1[0], r0[1], r1[1]}; OUT = *reinterpret_cast<bf16x8*>(&w); } while (0)
    PK4(p0, 0, pa0); PK4(p0, 8, pa1); PK4(p1, 0, pa2); PK4(p1, 8, pa3);
#undef PK4
}
__device__ __forceinline__ void qkt(f32x16& p0, f32x16& p1, lptr Ks, lptr Krs, const bf16x8* qr, const LAS bf16x8* qsp, int r32, int hi) {
    p0 = f32x16{}; p1 = f32x16{};
#pragma unroll
    for (int d0 = 0; d0 < 8; ++d0) { const int cb = (d0 * 16 + hi * 8) * 2;
        const bf16x8 b0 = *(const LAS bf16x8*)(Ks + KSWZ(r32, cb));
        const bf16x8 b1 = *(const LAS bf16x8*)(Ks + KSWZ(32 + r32, cb));
        p0 = __builtin_amdgcn_mfma_f32_32x32x16_bf16(b0, qr[d0], p0, 0, 0, 0);
        p1 = __builtin_amdgcn_mfma_f32_32x32x16_bf16(b1, qr[d0], p1, 0, 0, 0); }
#pragma unroll
    for (int d0 = 0; d0 < 4; ++d0) { const int cb = (d0 * 16 + hi * 8) * 2;
        const bf16x8 b0 = *(const LAS bf16x8*)(Krs + KRSWZ(r32, cb));
        const bf16x8 b1 = *(const LAS bf16x8*)(Krs + KRSWZ(32 + r32, cb));
        const bf16x8 q = qsp[d0 * 64];
        p0 = __builtin_amdgcn_mfma_f32_32x32x16_bf16(b0, q, p0, 0, 0, 0);
        p1 = __builtin_amdgcn_mfma_f32_32x32x16_bf16(b1, q, p1, 0, 0, 0); }
}
__device__ __forceinline__ int v_st(int k, int c) { const int kk = (k & ~0xC) | ((k & 4) << 1) | ((k & 8) >> 1); return ((kk >> 3) * 4 + (c >> 5)) * 512 + ((kk & 7) * 32 + (c & 31)) * 2; }
__device__ __forceinline__ int v_rd_base(int lane) { return ((lane & 3) << 3) | (((lane >> 2) & 3) << 6) | (((lane >> 4) & 1) << 5) | (((lane >> 5) & 1) << 8); }
constexpr int v_rd_off(int d0, int ks, int half) { return d0 * 512 + ks * 4096 + half * 2048; }
template <int OFF> __device__ __forceinline__ s16x4 tr_read(int vb) {
    s16x4 r; asm volatile("ds_read_b64_tr_b16 %0, %1 offset:%2" : "=&v"(r) : "v"(vb), "i"(OFF) : "memory"); return r;
}
template <int D0> __device__ __forceinline__ void pv_one(f32x16& od, int vb, bf16x8 pa0, bf16x8 pa1, bf16x8 pa2, bf16x8 pa3) {
    const s16x4 l0 = tr_read<v_rd_off(D0, 0, 0)>(vb), h0 = tr_read<v_rd_off(D0, 0, 1)>(vb), l1 = tr_read<v_rd_off(D0, 1, 0)>(vb), h1 = tr_read<v_rd_off(D0, 1, 1)>(vb);
    const s16x4 l2 = tr_read<v_rd_off(D0, 2, 0)>(vb), h2 = tr_read<v_rd_off(D0, 2, 1)>(vb), l3 = tr_read<v_rd_off(D0, 3, 0)>(vb), h3 = tr_read<v_rd_off(D0, 3, 1)>(vb);
    asm volatile("s_waitcnt lgkmcnt(0)" ::: "memory"); SBAR();
#define PK(L, H) (bf16x8){L[0], L[1], L[2], L[3], H[0], H[1], H[2], H[3]}
    od = __builtin_amdgcn_mfma_f32_32x32x16_bf16(pa0, PK(l0, h0), od, 0, 0, 0);
    od = __builtin_amdgcn_mfma_f32_32x32x16_bf16(pa1, PK(l1, h1), od, 0, 0, 0);
    od = __builtin_amdgcn_mfma_f32_32x32x16_bf16(pa2, PK(l2, h2), od, 0, 0, 0);
    od = __builtin_amdgcn_mfma_f32_32x32x16_bf16(pa3, PK(l3, h3), od, 0, 0, 0);
#undef PK
}
__device__ __forceinline__ void pv_d0(f32x16* o, int vb, bf16x8 pa0, bf16x8 pa1, bf16x8 pa2, bf16x8 pa3) {
    pv_one<0>(o[0], vb, pa0, pa1, pa2, pa3); pv_one<1>(o[1], vb, pa0, pa1, pa2, pa3); pv_one<2>(o[2], vb, pa0, pa1, pa2, pa3); pv_one<3>(o[3], vb, pa0, pa1, pa2, pa3);
}
__device__ __forceinline__ void attn_unit(const bf16_t* __restrict__ Qb, const bf16_t* __restrict__ Kh, const bf16_t* __restrict__ Vh, const bf16_t* __restrict__ Krb,
                                          bf16_t* __restrict__ Ob, int seq, lptr lds, const int wid) {
    const int lane = lane_id(), tid = wid * 64 + lane, r32 = lane & 31, hi = lane >> 5;
    (void)Vh; lptr V_lds = lds + OFF_V; lptr K_lds = lds + OFF_K; lptr KR_lds = lds + OFF_KR;
    LAS float* ws = (LAS float*)(lds + OFF_WS) + wid * 64; LAS float* li_l = ws; LAS float* al_l = ws + 32;
    float m_reg = -1e30f, l_reg = 0; f32x16 o[4] = {}; bf16x8 qr[8];
    LAS bf16x8* qsp = (LAS bf16x8*)(lds + OFF_QR + wid * 4096) + lane;
    { const char* Qw = (const char*)Qb + (size_t)(wid * QBLK) * LDQ * 2; const unsigned qoff = (unsigned)(r32 * LDQ + hi * 8) * 2u;
#pragma unroll
      for (int d0 = 0; d0 < 8; ++d0) qr[d0] = *reinterpret_cast<const bf16x8*>(Qw + qoff + d0 * 32);
#pragma unroll
      for (int d0 = 0; d0 < 4; ++d0) qsp[d0 * 64] = *reinterpret_cast<const bf16x8*>(Qw + qoff + (8 + d0) * 32); }
    const int sr = tid >> 4, sc = (tid & 15) * 8, vst0 = v_st(sr, sc), vst1 = v_st(32 + sr, sc);
    const int kr_r = tid >> 3, kr_c = (tid & 7) * 8, krst = KRSWZ(kr_r, kr_c * 2);
    const int vb0 = (int)(uintptr_t)V_lds + v_rd_base(lane);
    const unsigned kvoff = (unsigned)(sr * LDKV + sc) * 2u, kroff = (unsigned)(kr_r * LDKR + kr_c) * 2u;
    bf16x8 vs0, vs1, ks0, ks1, krs;
#define SLOAD(k0) do { const char* kb_ = (const char*)Kh + (size_t)(k0) * LDKV * 2; const char* rb_ = (const char*)Krb + (size_t)(k0) * LDKR * 2; \
    ks0 = *reinterpret_cast<const bf16x8*>(kb_ + kvoff); vs0 = *reinterpret_cast<const bf16x8*>(kb_ + kvoff + 256); \
    ks1 = *reinterpret_cast<const bf16x8*>(kb_ + (size_t)32 * LDKV * 2 + kvoff); vs1 = *reinterpret_cast<const bf16x8*>(kb_ + (size_t)32 * LDKV * 2 + kvoff + 256); \
    krs = *reinterpret_cast<const bf16x8*>(rb_ + kroff); } while (0)
#define SWRITE(b) do { *(LAS bf16x8*)(V_lds + (b) * SHM_V + vst0) = vs0; *(LAS bf16x8*)(V_lds + (b) * SHM_V + vst1) = vs1; const int kc = sc * 2; \
    *(LAS bf16x8*)(K_lds + (b) * SHM_K + KSWZ(sr, kc)) = ks0; *(LAS bf16x8*)(K_lds + (b) * SHM_K + KSWZ(32 + sr, kc)) = ks1; \
    *(LAS bf16x8*)(KR_lds + (b) * SHM_KR + krst) = krs; } while (0)
#define SWAIT() asm volatile("s_waitcnt vmcnt(0)" ::: "memory")
#define RESC(a) do { if (__any((a) < 1.f)) { if (hi == 0) al_l[r32] = (a); asm volatile("s_waitcnt lgkmcnt(0)" ::: "memory"); \
    _Pragma("unroll") for (int d = 0; d < 4; ++d) _Pragma("unroll") for (int r = 0; r < 16; ++r) o[d][r] *= al_l[crow(r, hi)]; } } while (0)
    f32x16 pA0, pA1, pB0, pB1; float mnA, mnB, alA, alB; bf16x8 pa0, pa1, pa2, pa3; const int NT = seq / KVBLK;
    SLOAD(0); SWAIT(); SWRITE(0); __syncthreads();
    qkt(pA0, pA1, K_lds, KR_lds, qr, qsp, r32, hi); partialSM(pA0, pA1, m_reg, mnA, alA);
    SLOAD(KVBLK);
    SWAIT(); SWRITE(1); __syncthreads();
    for (int j = 1; j + 1 < NT; j += 2) {
        SBAR(); qkt(pB0, pB1, K_lds + SHM_K, KR_lds + SHM_KR, qr, qsp, r32, hi);
        finishSM(pA0, pA1, alA, l_reg, pa0, pa1, pa2, pa3); SBAR();
        SLOAD((j + 1) * KVBLK); SBAR();
        pv_d0(o, vb0, pa0, pa1, pa2, pa3); partialSM(pB0, pB1, m_reg, mnB, alB);
        __syncthreads(); SWAIT(); SWRITE(0);
        RESC(alB); __syncthreads();
        SBAR(); qkt(pA0, pA1, K_lds, KR_lds, qr, qsp, r32, hi);
        finishSM(pB0, pB1, alB, l_reg, pa0, pa1, pa2, pa3); SBAR();
        SLOAD((j + 2) * KVBLK); SBAR();
        pv_d0(o, vb0 + SHM_V, pa0, pa1, pa2, pa3); partialSM(pA0, pA1, m_reg, mnA, alA);
        __syncthreads(); SWAIT(); SWRITE(1);
        RESC(alA); __syncthreads();
    }
    SBAR(); qkt(pB0, pB1, K_lds + SHM_K, KR_lds + SHM_KR, qr, qsp, r32, hi);
    finishSM(pA0, pA1, alA, l_reg, pa0, pa1, pa2, pa3); SBAR();
    pv_d0(o, vb0, pa0, pa1, pa2, pa3); partialSM(pB0, pB1, m_reg, mnB, alB);
    __syncthreads(); RESC(alB);
    finishSM(pB0, pB1, alB, l_reg, pa0, pa1, pa2, pa3); SBAR();
    pv_d0(o, vb0 + SHM_V, pa0, pa1, pa2, pa3);
    if (hi == 0) li_l[r32] = l_reg; asm volatile("s_waitcnt lgkmcnt(0)" ::: "memory");
    float rli[16];
#pragma unroll
    for (int r = 0; r < 16; ++r) rli[r] = __builtin_amdgcn_rcpf(li_l[crow(r, hi)]);
    char* Ow = (char*)Ob + (size_t)(wid * QBLK) * LDO * 2; const unsigned ooff = (unsigned)(4 * hi * LDO + r32) * 2u;
#pragma unroll
    for (int r = 0; r < 16; ++r) { const int orel = (r & 3) + 8 * (r >> 2);
#pragma unroll
        for (int d0 = 0; d0 < 4; ++d0) { const unsigned w = cvt_pk_bf16(o[d0][r] * rli[r], 0.f); *(bf16_t*)(Ow + ooff + (orel * LDO + d0 * 32) * 2) = (bf16_t)(w & 0xffffu); } }
    __syncthreads();
#undef SLOAD
#undef SWRITE
#undef SWAIT
#undef RESC
}
}

#define XB_TMO      128
#define XB_XCNT(j)  (256  + 64 * (j))
#define XB_XSUB(j)  (1280 + 64 * (j))
#define XB_XGEN(j)  (2304 + 64 * (j))
#define XB_TOP      3328
#define XB_TOPGEN   3392
#define XCD_BAR_WORDS 3456
#define XB_SPIN_CAP (1u << 18)
__device__ __forceinline__ unsigned xb_ld(unsigned* p)              { return __hip_atomic_load(p, __ATOMIC_RELAXED, __HIP_MEMORY_SCOPE_AGENT); }
__device__ __forceinline__ unsigned xb_add(unsigned* p, unsigned v) { return __hip_atomic_fetch_add(p, v, __ATOMIC_RELAXED, __HIP_MEMORY_SCOPE_AGENT); }
__device__ __forceinline__ unsigned xb_xcc_id() { return (unsigned)__builtin_amdgcn_s_getreg((3 << 11) | 20) & 0xFu; }
#define XB_SPIN(cond, bar) do { unsigned _sp = 0; while (cond) { __builtin_amdgcn_s_sleep(1); \
    if ((++_sp & 255u) == 0u) { if (xb_ld(&(bar)[XB_TMO])) break; if (_sp > XB_SPIN_CAP) { atomicAdd(&(bar)[XB_TMO], 1u); break; } } } } while (0)
struct XcdBarrier { unsigned* bar; unsigned x; volatile LAS unsigned* st; };
__device__ __forceinline__ XcdBarrier xcd_barrier_post(unsigned* bar, volatile LAS unsigned* st, const bool t0) {
    XcdBarrier b; b.bar = bar; b.x = xb_xcc_id(); b.st = st;
    if (t0) (void)xb_add(&bar[XB_XCNT(b.x)], 1u);
    return b;
}
__device__ __forceinline__ void xcd_barrier_complete(unsigned* bar, unsigned x, unsigned& nloc, unsigned& nx) {
    const unsigned G = gridDim.x * gridDim.y * gridDim.z;
    unsigned sum, cnt, mine, sp = 0u;
    for (;;) {
        sum = 0u; cnt = 0u; mine = 0u;
#pragma unroll
        for (unsigned j = 0; j < 16; ++j) { const unsigned c = xb_ld(&bar[XB_XCNT(j)]); sum += c; cnt += (c > 0u) ? 1u : 0u; mine = (j == x) ? c : mine; }
        if (sum == G) break;
        __builtin_amdgcn_s_sleep(1);
        if ((++sp & 255u) == 0u) { if (xb_ld(&bar[XB_TMO])) break; if (sp > XB_SPIN_CAP) { atomicAdd(&bar[XB_TMO], 1u); break; } }
    }
    nloc = mine > 0u ? mine : 1u; nx = cnt > 0u ? cnt : 1u;
}
__device__ __forceinline__ void xcd_barrier(const XcdBarrier& b, const bool t0) {
    asm volatile("s_waitcnt vmcnt(0)" ::: "memory");
    __syncthreads();
    if (t0) {
        unsigned* bar = b.bar;
        __builtin_amdgcn_s_waitcnt(0);
        unsigned nloc = b.st[0], nx = b.st[1];
        if (nloc == 0u) { xcd_barrier_complete(bar, b.x, nloc, nx); b.st[0] = nloc; b.st[1] = nx; }
        const unsigned old = xb_add(&bar[XB_XSUB(b.x)], 1u);
        const unsigned gen = old / nloc;
        if (old + 1u == (gen + 1u) * nloc) {
            __builtin_amdgcn_fence(__ATOMIC_RELEASE, "agent");
            asm volatile("s_waitcnt vmcnt(0)" ::: "memory");
            const unsigned og = xb_add(&bar[XB_TOP], 1u);
            const unsigned tg = og / nx;
            if (og + 1u == (tg + 1u) * nx) xb_add(&bar[XB_TOPGEN], 1u);
            else XB_SPIN(xb_ld(&bar[XB_TOPGEN]) == tg, bar);
            __builtin_amdgcn_fence(__ATOMIC_ACQUIRE, "agent");
            xb_add(&bar[XB_XGEN(b.x)], 1u);
            asm volatile("s_waitcnt vmcnt(0)" ::: "memory");
        } else {
            XB_SPIN(xb_ld(&bar[XB_XGEN(b.x)]) == gen, bar);
            __builtin_amdgcn_fence(__ATOMIC_ACQUIRE, "agent");
            asm volatile("s_waitcnt vmcnt(0)" ::: "memory");
        }
    }
    __syncthreads();
}

__device__ __forceinline__ int wfi_src(int nb) { const int pn = nb >> 3, q = nb & 7; return (q >> 2) * DFF + pn * 128 + (q & 3) * 32; }
__device__ __forceinline__ int win_src(int nb) { const int n0 = nb * 32; if (n0 < 1536) return n0; if (n0 < 1792) return n0 == 1536 ? 1536 : (n0 == 1664 ? 1568 : -1); return n0 - 192; }
__device__ __forceinline__ int wuq_src(int nb) { const int n0 = nb * 32; if (n0 < 2048) return (n0 >> 7) * 192 + (n0 & 127);
    const int w = n0 - 2048, t = w >> 8, wi = w & 255, bj = wi >> 7, hh = (wi & 127) >> 5; return (4 * t + hh) * 192 + 128 + 32 * bj; }
__device__ __forceinline__ void p0_item(const float* __restrict__ W, int ldw, int K, bf16_t* __restrict__ WT, int sc, int dn, int k0, const float* __restrict__ gk, LAS float* scr, int lane) {
    const int c = lane & 7;
    if (sc < 0) {
#pragma unroll
        for (int j = 0; j < 4; ++j) { const int n = (lane >> 3) + 8 * j; *(u32x4*)(WT + (size_t)(dn + n) * K + k0 + 8 * c) = (u32x4){0u, 0u, 0u, 0u}; }
        return;
    }
#pragma unroll 8
    for (int i = 0; i < 32; ++i) { const int kk = 2 * i + (lane >> 5); float v = __builtin_nontemporal_load(W + (size_t)(k0 + kk) * ldw + sc + (lane & 31)); if (gk) v *= gk[k0 + kk]; scr[kk * 33 + (lane & 31)] = v; }
    LDS_WAIT(); asm volatile("" ::: "memory");
#pragma unroll
    for (int j = 0; j < 4; ++j) { const int n = (lane >> 3) + 8 * j; const LAS float* s = scr + (8 * c) * 33 + n;
        u32x4 o; o.x = cvt_pk_bf16(s[0 * 33], s[1 * 33]); o.y = cvt_pk_bf16(s[2 * 33], s[3 * 33]); o.z = cvt_pk_bf16(s[4 * 33], s[5 * 33]); o.w = cvt_pk_bf16(s[6 * 33], s[7 * 33]);
        __builtin_nontemporal_store(o, (u32x4*)(WT + (size_t)(dn + n) * K + k0 + 8 * c)); }
    LDS_WAIT(); asm volatile("" ::: "memory");
}

__device__ __forceinline__ void p0_item_ln(const float* __restrict__ W, int ldw, int K, bf16_t* __restrict__ WT, int sc, int dn, int k0, const float* __restrict__ gk, const float* __restrict__ bk,
                                           float* sv, float* cv, LAS float* scr, int lane) {
    const int c = lane & 7;
#pragma unroll 8
    for (int i = 0; i < 32; ++i) { const int kk = 2 * i + (lane >> 5); scr[kk * 33 + (lane & 31)] = __builtin_nontemporal_load(W + (size_t)(k0 + kk) * ldw + sc + (lane & 31)); }
    const f32x4 ga = *(const f32x4*)(gk + k0 + 8 * c), gb = *(const f32x4*)(gk + k0 + 8 * c + 4), ba = *(const f32x4*)(bk + k0 + 8 * c), bb = *(const f32x4*)(bk + k0 + 8 * c + 4);
    LDS_WAIT(); asm volatile("" ::: "memory");
    float sk = 0.f, ck = 0.f;
#pragma unroll
    for (int j = 0; j < 4; ++j) { const int n = (lane >> 3) + 8 * j; const LAS float* sp = scr + (8 * c) * 33 + n;
        const float w0 = sp[0 * 33], w1 = sp[1 * 33], w2 = sp[2 * 33], w3 = sp[3 * 33], w4 = sp[4 * 33], w5 = sp[5 * 33], w6 = sp[6 * 33], w7 = sp[7 * 33];
        u32x4 o; o.x = cvt_pk_bf16(w0 * ga[0], w1 * ga[1]); o.y = cvt_pk_bf16(w2 * ga[2], w3 * ga[3]); o.z = cvt_pk_bf16(w4 * gb[0], w5 * gb[1]); o.w = cvt_pk_bf16(w6 * gb[2], w7 * gb[3]);
        __builtin_nontemporal_store(o, (u32x4*)(WT + (size_t)(dn + n) * K + k0 + 8 * c));
        float ss = ((bf_lo(o.x) + bf_hi(o.x)) + (bf_lo(o.y) + bf_hi(o.y))) + ((bf_lo(o.z) + bf_hi(o.z)) + (bf_lo(o.w) + bf_hi(o.w)));
        float cs = ((w0 * ba[0] + w1 * ba[1]) + (w2 * ba[2] + w3 * ba[3])) + ((w4 * bb[0] + w5 * bb[1]) + (w6 * bb[2] + w7 * bb[3]));
        ss += __shfl_xor(ss, 1); ss += __shfl_xor(ss, 2); ss += __shfl_xor(ss, 4); cs += __shfl_xor(cs, 1); cs += __shfl_xor(cs, 2); cs += __shfl_xor(cs, 4);
        if (c == j) { sk = ss; ck = cs; } }
    if (c < 4) { const int n = (lane >> 3) + 8 * c; atomicAdd(sv + dn + n, sk); atomicAdd(cv + dn + n, ck); }
    LDS_WAIT(); asm volatile("" ::: "memory");
}

__device__ __forceinline__ void p0_item_lnr(const float* __restrict__ W, int ldw, bf16_t* __restrict__ WR, int sc, int k0, const float* __restrict__ gk, const float* __restrict__ bk,
                                            float* sv, float* cv, int lane) {
    const int cp = lane & 15, r4 = lane >> 4;
    float s0 = 0.f, s1 = 0.f, c0 = 0.f, c1 = 0.f;
#pragma unroll 8
    for (int i = 0; i < 16; ++i) { const int k = k0 + 4 * i + r4; const f32x2 w = __builtin_nontemporal_load((const f32x2*)(W + (size_t)k * ldw + sc + 2 * cp)); const float g = gk[k], b = bk[k];
        const unsigned o = cvt_pk_bf16(w.x * g, w.y * g); *(unsigned*)(WR + (size_t)k * ldw + sc + 2 * cp) = o;
        s0 += bf_lo(o); s1 += bf_hi(o); c0 += w.x * b; c1 += w.y * b; }
    s0 += __shfl_xor(s0, 16); s0 += __shfl_xor(s0, 32); s1 += __shfl_xor(s1, 16); s1 += __shfl_xor(s1, 32);
    c0 += __shfl_xor(c0, 16); c0 += __shfl_xor(c0, 32); c1 += __shfl_xor(c1, 16); c1 += __shfl_xor(c1, 32);
    if (r4 == 0) { atomicAdd(sv + sc + 2 * cp, s0); atomicAdd(sv + sc + 2 * cp + 1, s1); atomicAdd(cv + sc + 2 * cp, c0); atomicAdd(cv + sc + 2 * cp + 1, c1); }
}

constexpr int NPHASE = 21;
struct Args { const void* in[28]; float* out; unsigned char* ws; int ph_lo, ph_hi; };
static_assert(WS_CONVB + (size_t)DFF2 * 4 <= WS_MISC && WS_CONVW >= CTL_ZERO_BYTES, "conv weight copy");
static_assert(WS_C2 + DFF2 * 4 <= CTL_ZERO_BYTES && WS_MISC >= CTL_ZERO_BYTES && WS_MISC + 64 <= WS_WIN, "control region");
static_assert(sizeof(Args) == 28 * 8 + 8 + 8 + 8, "Args has no padding");

__global__ void __launch_bounds__(NWAVES * 64, 2) mk_fwd(Args args) {
    extern __shared__ __attribute__((aligned(16))) unsigned char lds_raw[];
    LAS unsigned char* lds = (LAS unsigned char*)lds_raw;
    volatile LAS unsigned* MISC = (volatile LAS unsigned*)(lds + MISC_OFF);
    const int wave = __builtin_amdgcn_readfirstlane((int)threadIdx.x >> 6);
#define tid (wave * 64 + lane)
    const int G = gridDim.x, bx = blockIdx.x;
    const int vcu = (G % 8 == 0) ? (bx % 8) * (G / 8) + bx / 8 : bx;
    const int gw = vcu * NWAVES + wave, NGW = G * NWAVES;
    const int NGT = G * NWAVES * 64;
#define gtid (vcu * (NWAVES * 64) + wave * 64 + lane)
    unsigned char* ws = args.ws;
    unsigned* ctl = (unsigned*)(ws + WS_CTL);
    { const int lane = lane_id(); for (int u = tid; u < (LDS_BYTES - LDSCTL_OFF) / 4; u += NWAVES * 64) ((LAS unsigned*)(lds + LDSCTL_OFF))[u] = 0u; }
    __syncthreads();
    XcdBarrier bar; bar.bar = ctl + CW_BAR; bar.x = 0; bar.st = nullptr;
#if !MK_PER_PHASE
    bar = xcd_barrier_post(ctl + CW_BAR, MISC + 8, wave == 0 && lane_id() == 0);
#define GRID_BAR() xcd_barrier(bar, wave == 0 && lane_id() == 0)
#else
#define GRID_BAR() do {} while (0)
#endif
    const int lo = args.ph_lo, hi = args.ph_hi;
#ifndef DUP_MASK
#define DUP_MASK 0u
#endif
#define IN(k) (lo <= (k) && (k) < hi)
#define REP(k) for (int rep_ = 0; rep_ < (((DUP_MASK >> (k)) & 1u) ? 2 : 1); ++rep_)
#define SEAM(k) do { if (IN(k) && IN((k) + 1)) GRID_BAR(); } while (0)

#define in_x ((const float*)args.in[0])
#define in_mem ((const float*)args.in[1])
#define in_positions ((const int*)args.in[2])
#define in_w_in ((const float*)args.in[3])
#define in_gate_bias ((const float*)args.in[4])
#define in_q_norm_g ((const float*)args.in[5])
#define in_w_uq ((const float*)args.in[6])
#define in_kv_norm_g ((const float*)args.in[7])
#define in_w_ukv ((const float*)args.in[8])
#define in_dec_f ((const float*)args.in[9])
#define in_dec_b ((const float*)args.in[10])
#define in_w_br_mla ((const float*)args.in[11])
#define in_w_br_ret ((const float*)args.in[12])
#define in_w_o ((const float*)args.in[13])
#define in_ln1_g ((const float*)args.in[14])
#define in_ln1_b ((const float*)args.in[15])
#define in_w_cq ((const float*)args.in[16])
#define in_w_ck ((const float*)args.in[17])
#define in_w_cv ((const float*)args.in[18])
#define in_w_co ((const float*)args.in[19])
#define in_ln2_g ((const float*)args.in[20])
#define in_ln2_b ((const float*)args.in[21])
#define in_w_ffn_in ((const float*)args.in[22])
#define in_conv_w ((const float*)args.in[23])
#define in_conv_b ((const float*)args.in[24])
#define in_w_ffn_out ((const float*)args.in[25])
#define in_ln3_g ((const float*)args.in[26])
#define in_ln3_b ((const float*)args.in[27])
#define Win_t ((bf16_t*)(ws + WS_WIN))
#define Wfi_t ((bf16_t*)(ws + WS_WFI))
#define Wfo_t ((bf16_t*)(ws + WS_WFO))
#define Wbr_t ((bf16_t*)(ws + WS_WBR))
#define Wo_t ((bf16_t*)(ws + WS_WO))
#define Wcq_r ((bf16_t*)(ws + WS_WCQ))
#define Wck_t ((bf16_t*)(ws + WS_WCK))
#define Wcv_t ((bf16_t*)(ws + WS_WCV))
#define Wco_t ((bf16_t*)(ws + WS_WCO))
#define Wbm_t ((bf16_t*)(ws + WS_WBM))
#define Wuq_t ((bf16_t*)(ws + WS_WUQ))
#define Wukv_t ((bf16_t*)(ws + WS_WUKV))
#define MEMB ((bf16_t*)(ws + WS_MEMB))
#define ROPER ((f32x2*)(ws + WS_ROPER))
#define ROPEA ((f32x2*)(ws + WS_ROPEA))
#define RSS ((float*)(ws + WS_RSS))
#define RS1 ((float*)(ws + WS_RS1))
#define RS2 ((float*)(ws + WS_RS2))
#define RS3 ((float*)(ws + WS_RS3))
#define S1V ((float*)(ws + WS_S1))
#define C1V ((float*)(ws + WS_C1))
#define S2V ((float*)(ws + WS_S2))
#define C2V ((float*)(ws + WS_C2))
#define ZB ((bf16_t*)(ws + WS_ZB))
#define DEC ((float*)(ws + WS_MISC))
#define XB ((bf16_t*)(ws + WS_XB))
#define CQM ((bf16_t*)(ws + WS_CQM))
#define CKV ((bf16_t*)(ws + WS_CKV))
#define KPE ((bf16_t*)(ws + WS_KPE))
#define RQ ((bf16_t*)(ws + WS_RQ))
#define RK ((bf16_t*)(ws + WS_RK))
#define RVT ((bf16_t*)(ws + WS_RVT))
#define RG ((bf16_t*)(ws + WS_RG))
#define GT ((bf16_t*)(ws + WS_GT))
#define SC ((bf16_t*)(ws + WS_SC))
#define AO ((bf16_t*)(ws + WS_AO))
#define QB ((bf16_t*)(ws + WS_Q))
#define KVB ((bf16_t*)(ws + WS_KV))
#define ORET ((bf16_t*)(ws + WS_ORET))
#define ROUT ((bf16_t*)(ws + WS_ROUT))
#define TMP ((bf16_t*)(ws + WS_TMP))
#define MIXED ((bf16_t*)(ws + WS_MIXED))
#define Z ((float*)(ws + WS_Z))
#define MQT ((bf16_t*)(ws + WS_MQT))
#define VWT ((bf16_t*)(ws + WS_VWT))
#define CK ((bf16_t*)(ws + WS_CK))
#define CV ((bf16_t*)(ws + WS_CV))
#define SXV ((float*)(ws + WS_SX))
#define CXV ((float*)(ws + WS_CX))
#define XS ((float*)(ws + WS_XS))
#define XP ((bf16_t*)(ws + WS_XP))
#define EDGE ((unsigned*)(ws + WS_EDGE))
#define ACT ((bf16_t*)(ws + WS_ACT))

#define GEMM_CALL(EpiT, Ev, Aptr, Bptr, lda_, ldb_, K_, nM_, nN_, nZ_, nh_, sAb_, sAh_, sBb_, sBh_) do { \
        pg8::Gemm g_{(Aptr), (Bptr), (lda_), (ldb_), (K_), (nh_), (long)(sAb_), (long)(sAh_), (long)(sBb_), (long)(sBh_)}; \
        pg8::Order S_; S_.init((nM_), (nN_), (nZ_), G, bx); pg8::gemm_phase<EpiT>(lds, g_, S_, (Ev), wave); } while (0)

    constexpr int I_IN = (INP / 32) * (D / 64), I_UQ = (3072 / 32) * (1024 / 64), I_UKV = (4096 / 32) * (512 / 64), I_BM = (4096 / 32) * (2048 / 64), I_SQ = (4096 / 32) * (4096 / 64);
    constexpr int I_FI = (DFF2 / 32) * (D / 64), I_FO = (4096 / 32) * (DFF / 64);
    const bool split = (G == 256);
    constexpr int I_FO_P2 = (I_FO / 3 / 1024) * 1024;
#define CONV_WCO(lo_, hi_, w_, nw_) do { LAS float* scr_ = (LAS float*)(lds + wave * 16384); for (int r = (lo_) + (w_); r < (hi_); r += (nw_)) { const int nblk = 4096 / 32, kb = r / nblk, nb = r % nblk; \
        p0_item(in_w_co, 4096, 4096, Wco_t, nb * 32, nb * 32, kb * 64, nullptr, scr_, lane); } } while (0)
#define CONV_WFI2(w_, nw_) do { LAS float* scr_ = (LAS float*)(lds + wave * 16384); for (int r = I_FI / 2 + (w_); r < I_FI; r += (nw_)) { const int nblk = DFF2 / 32, kb = r / nblk, nb = r % nblk; \
        p0_item_ln(in_w_ffn_in, DFF2, D, Wfi_t, wfi_src(nb), nb * 32, kb * 64, in_ln2_g, in_ln2_b, S2V, C2V, scr_, lane); } } while (0)
#define CONV_WFO(lo_, hi_, w_, nw_) do { LAS float* scr_ = (LAS float*)(lds + wave * 16384); for (int r = (lo_) + (w_); r < (hi_); r += (nw_)) { const int nblk = 4096 / 32, kb = r / nblk, nb = r % nblk; \
        p0_item(in_w_ffn_out, 4096, DFF, Wfo_t, nb * 32, nb * 32, kb * 64, nullptr, scr_, lane); } } while (0)
    if (IN(0)) REP(0) { const int lane = lane_id();
        LAS float* scr = (LAS float*)(lds + wave * 16384);
        constexpr int NITEMS = I_IN + I_UQ + I_UKV + I_BM + 5 * I_SQ + I_FI / 2;
        for (int it = gw; it < NITEMS; it += NGW) {
            int r = it;
            if (r < I_IN) { const int nblk = INP / 32, kb = r / nblk, nb = r % nblk; p0_item(in_w_in, INW, D, Win_t, win_src(nb), nb * 32, kb * 64, nullptr, scr, lane); continue; } r -= I_IN;
            if (r < I_UQ) { const int nblk = 3072 / 32, kb = r / nblk, nb = r % nblk; p0_item(in_w_uq, 3072, 1024, Wuq_t, wuq_src(nb), nb * 32, kb * 64, in_q_norm_g, scr, lane); continue; } r -= I_UQ;
            if (r < I_UKV) { const int nblk = 4096 / 32, kb = r / nblk, nb = r % nblk; p0_item(in_w_ukv, 4096, 512, Wukv_t, nb * 32, nb * 32, kb * 64, in_kv_norm_g, scr, lane); continue; } r -= I_UKV;
            if (r < I_BM) { const int nblk = 4096 / 32, kb = r / nblk, nb = r % nblk; p0_item(in_w_br_mla, 4096, 2048, Wbm_t, nb * 32, nb * 32, kb * 64, nullptr, scr, lane); continue; } r -= I_BM;
            if (r < 5 * I_SQ) { const int wsel = r / I_SQ; r -= wsel * I_SQ; const int nblk = 4096 / 32, kb = r / nblk, nb = r % nblk;
                const float* W = wsel == 0 ? in_w_br_ret : wsel == 1 ? in_w_o : wsel == 2 ? in_w_cq : wsel == 3 ? in_w_ck : in_w_cv;
                bf16_t* WT = wsel == 0 ? Wbr_t : wsel == 1 ? Wo_t : wsel == 2 ? Wcq_r : wsel == 3 ? Wck_t : Wcv_t;
                if (wsel == 2) p0_item_lnr(W, 4096, WT, nb * 32, kb * 64, in_ln1_g, in_ln1_b, S1V, C1V, lane);
                else p0_item(W, 4096, 4096, WT, nb * 32, nb * 32, kb * 64, nullptr, scr, lane);
                continue; } r -= 5 * I_SQ;
            { const int nblk = DFF2 / 32, kb = r / nblk, nb = r % nblk; p0_item_ln(in_w_ffn_in, DFF2, D, Wfi_t, wfi_src(nb), nb * 32, kb * 64, in_ln2_g, in_ln2_b, S2V, C2V, scr, lane); }
        }
        if (!split) { CONV_WCO(0, I_SQ, gw, NGW); CONV_WFI2(gw, NGW); CONV_WFO(0, I_FO, gw, NGW); }
        for (long i = gtid; i < (long)T * D / 8; i += NGT) { const f32x4 a = __builtin_nontemporal_load((const f32x4*)(in_x + i * 8)), b = __builtin_nontemporal_load((const f32x4*)(in_x + i * 8 + 4)); *(u32x4*)(XB + i * 8) = pg8::pack8(a, b); }
        for (long i = gtid; i < (long)TM * D / 8; i += NGT) { const f32x4 a = *(const f32x4*)(in_mem + i * 8), b = *(const f32x4*)(in_mem + i * 8 + 4); *(u32x4*)(MEMB + i * 8) = pg8::pack8(a, b); }
        for (int i = gtid; i < 3 * DFF2 / 4; i += NGT) ((f32x4*)(ws + WS_CONVW))[i] = ((const f32x4*)in_conv_w)[i];
        for (int i = gtid; i < DFF2 / 4; i += NGT) ((f32x4*)(ws + WS_CONVB))[i] = ((const f32x4*)in_conv_b)[i];
        if (gtid < 16) { const float e = gtid < 8 ? in_dec_f[gtid] : in_dec_b[gtid - 8]; DEC[gtid] = log1pf(-exp2f(-e)) * 1.4426950408889634f; }
        __syncthreads();
    }
    SEAM(0);

    if (IN(1)) REP(1) {
        pg8::EpiProj E{CQM, CKV, KPE, RQ, RK, RVT, RG, GT, RSS, in_positions, in_gate_bias, lds};
        GEMM_CALL(pg8::EpiProj, E, XB, Win_t, D, D, D, 32, 87, 1, 1, 0, 0, 0, 0);
        const int lane = lane_id();
        if (split && bx >= 224) CONV_WCO(0, I_SQ / 2, (bx - 224) * NWAVES + wave, 32 * NWAVES);
    }
    SEAM(1);

    if (IN(2)) REP(2) {
        { pg8::EpiQ E{QB, RSS, in_positions}; GEMM_CALL(pg8::EpiQ, E, CQM, Wuq_t, 1024, 1024, 1024, 32, 12, 1, 1, 0, 0, 0, 0); }
        { const int lane = lane_id(); if (split && bx >= 128) { CONV_WFO(0, I_FO_P2, (bx - 128) * NWAVES + wave, 128 * NWAVES); __syncthreads(); } }
        { pg8::EpiBf16 E{KVB, 4096, 1.0f, 1, 0, 0, RSS + T, 1.0f / 512.0f}; GEMM_CALL(pg8::EpiBf16, E, CKV, Wukv_t, 512, 512, 512, 32, 16, 1, 1, 0, 0, 0, 0); }
    }
    SEAM(2);

    if (IN(3)) REP(3) {
        for (int idx = vcu; idx < 512; idx += G) {
            const int bh = idx >> 3, qb = idx & 7, b = bh >> 4, h = bh & 15;
            const size_t row0 = (size_t)b * SEQ + qb * 256, key0 = (size_t)b * SEQ;
            att::attn_unit(QB + row0 * 3072 + h * 192, KVB + key0 * 4096 + h * 256, KVB + key0 * 4096 + h * 256 + 128, KPE + key0 * 64, AO + row0 * 2048 + h * 128, SEQ, (att::lptr)lds, wave);
        }
    }
    if (IN(3) && IN(4)) __syncthreads();

    if (IN(4)) REP(4) {
        pg8::EpiRetS E{SC, DEC};
        pg8::Gemm g_{RQ, RK, 2048, 2048, 256, 8, (long)SEQ * 2048, 256, (long)SEQ * 2048, 256}; pg8::Order S_; S_.init(8, 8, 32, G, bx); S_.rowmode = (G == 256) ? 1 : 0;
        pg8::gemm_phase<pg8::EpiRetS>(lds, g_, S_, E, wave);
    }
    SEAM(4);

    if (IN(5)) REP(5) {
        pg8::EpiBf16 E{ORET, D, 1.0f, 8, (long)SEQ * D, 512, nullptr, 0.f};
        GEMM_CALL(pg8::EpiBf16, E, SC, RVT, 2048, 2048, 2048, 8, 2, 32, 8, (long)8 * SEQ * SEQ, (long)SEQ * SEQ, (long)8 * 512 * SEQ, (long)512 * SEQ);
    }
    SEAM(5);

    if (IN(6)) REP(6) { const int lane = lane_id();
        for (int it = gw; it < T * 8; it += NGW) {
            const size_t off = (size_t)it * 512;
            const u32x2 aw = __builtin_nontemporal_load((const u32x2*)(ORET + off + lane * 4)), bw = __builtin_nontemporal_load((const u32x2*)(ORET + off + 256 + lane * 4));
            const f32x4 a = {bf_lo(aw.x), bf_hi(aw.x), bf_lo(aw.y), bf_hi(aw.y)}, b = {bf_lo(bw.x), bf_hi(bw.x), bf_lo(bw.y), bf_hi(bw.y)};
            const float mean = wave_sum((a[0] + a[1]) + (a[2] + a[3]) + (b[0] + b[1]) + (b[2] + b[3])) * (1.0f / 512.0f);
            const f32x4 da = a - mean, db = b - mean;
            const float var = wave_sum((da[0] * da[0] + da[1] * da[1]) + (da[2] * da[2] + da[3] * da[3]) + (db[0] * db[0] + db[1] * db[1]) + (db[2] * db[2] + db[3] * db[3])) * (1.0f / 512.0f);
            const float rstd = rsqrtf(var + LN_EPS);
            const size_t goff = (size_t)(it >> 3) * RGP + (it & 7) * 512;
            const u32x2 ga = __builtin_nontemporal_load((const u32x2*)(RG + goff + lane * 4)), gb = __builtin_nontemporal_load((const u32x2*)(RG + goff + 256 + lane * 4));
            u32x2 oa, ob;
            oa.x = cvt_pk_bf16(da[0] * rstd * bf_lo(ga.x), da[1] * rstd * bf_hi(ga.x)); oa.y = cvt_pk_bf16(da[2] * rstd * bf_lo(ga.y), da[3] * rstd * bf_hi(ga.y));
            ob.x = cvt_pk_bf16(db[0] * rstd * bf_lo(gb.x), db[1] * rstd * bf_hi(gb.x)); ob.y = cvt_pk_bf16(db[2] * rstd * bf_lo(gb.y), db[3] * rstd * bf_hi(gb.y));
            *(u32x2*)(ROUT + off + lane * 4) = oa; *(u32x2*)(ROUT + off + 256 + lane * 4) = ob;
        }
    }
    if (IN(6) && IN(7)) __syncthreads();

    if (IN(7)) REP(7) { pg8::EpiBf16 E{TMP, D, 1.0f, 1, 0, 0, nullptr, 0.f}; GEMM_CALL(pg8::EpiBf16, E, AO, Wbm_t, 2048, 2048, 2048, 32, 16, 1, 1, 0, 0, 0, 0); }
    SEAM(7);
    if (IN(8)) REP(8) { pg8::EpiGate1 E{MIXED, TMP, GT}; GEMM_CALL(pg8::EpiGate1, E, ROUT, Wbr_t, D, D, D, 32, 16, 1, 1, 0, 0, 0, 0); }
    SEAM(8);
    if (IN(9)) REP(9) { typedef pg8::EpiResStat<WS_ZB, WS_RS1> EpiT9; EpiT9 E{ws, in_x}; GEMM_CALL(EpiT9, E, MIXED, Wo_t, D, D, D, 32, 16, 1, 1, 0, 0, 0, 0); }
    SEAM(9);

#define LN_PHASE(Zp, gp, bp, outF, outB) do { \
        for (int m = gw; m < T; m += NGW) { \
            const f32x4* zr = (const f32x4*)((Zp) + (size_t)m * D) + lane; f32x4 v[16]; float s = 0.f; \
            _Pragma("unroll") for (int j = 0; j < 16; ++j) { v[j] = zr[64 * j]; s += (v[j][0] + v[j][1]) + (v[j][2] + v[j][3]); } \
            const float mean = wave_sum(s) * (1.0f / D); float s2 = 0.f; \
            _Pragma("unroll") for (int j = 0; j < 16; ++j) { v[j] = v[j] - mean; s2 += (v[j][0] * v[j][0] + v[j][1] * v[j][1]) + (v[j][2] * v[j][2] + v[j][3] * v[j][3]); } \
            const float rstd = rsqrtf(wave_sum(s2) * (1.0f / D) + LN_EPS); \
            _Pragma("unroll") for (int j = 0; j < 16; ++j) { const f32x4 gg = ((const f32x4*)(gp))[64 * j + lane], bb = ((const f32x4*)(bp))[64 * j + lane]; const f32x4 y = v[j] * rstd * gg + bb; \
                if ((outF) != nullptr) ((f32x4*)((outF) + (size_t)m * D))[64 * j + lane] = y; \
                if ((outB) != nullptr) { u32x2 w; w.x = cvt_pk_bf16(y[0], y[1]); w.y = cvt_pk_bf16(y[2], y[3]); ((u32x2*)((outB) + (size_t)m * D))[64 * j + lane] = w; } } \
        } } while (0)

    if (IN(11)) REP(11) { const int lane = lane_id();
        if (bx < 64) { pg8::EpiBf16 E{CK, D, 1.0f, 1, 0, 0, nullptr, 0.f}; pg8::Gemm g_{MEMB, Wck_t, D, D, D, 1, 0, 0, 0, 0}; pg8::Order S_; S_.init(4, 16, 1, 64, bx); pg8::gemm_phase<pg8::EpiBf16>(lds, g_, S_, E, wave); }
        else if (bx >= 128) { if (split) { CONV_WFI2((bx - 128) * NWAVES + wave, 128 * NWAVES); CONV_WCO(I_SQ / 2, I_SQ, (bx - 128) * NWAVES + wave, 128 * NWAVES); } }
        else { pg8::EpiBf16 E{CV, D, 1.0f, 1, 0, 0, nullptr, 0.f}; pg8::Gemm g_{MEMB, Wcv_t, D, D, D, 1, 0, 0, 0, 0}; pg8::Order S_; S_.init(4, 16, 1, 64, bx - 64); pg8::gemm_phase<pg8::EpiBf16>(lds, g_, S_, E, wave); }
    }
    SEAM(11);

    if (IN(12)) REP(12) {
        { pg8::EpiBf16 E{MQT, D, 1.0f, 4, (long)1024 * D, (long)256 * D, nullptr, 0.f}; GEMM_CALL(pg8::EpiBf16, E, CK, Wcq_r, D, D, 1024, 1, 16, 16, 4, (long)MEM * D, 1024, 0, 1024); }
        { pg8::EpiBf16 E{VWT, 1024, 1.0f, 4, (long)D * 1024, 256, nullptr, 0.f}; GEMM_CALL(pg8::EpiBf16, E, Wco_t, CV, D, D, 1024, 16, 1, 16, 4, 0, 1024, (long)MEM * D, 1024); }
        const int lane = lane_id();
        for (int it = gw; it < TM * 4; it += NGW) { const int row = it >> 2, h = it & 3;
            const bf16_t* cr = CK + (size_t)row * D + h * 1024 + lane * 8; const float* sp = S1V + h * 1024 + lane * 8; const float* cp = C1V + h * 1024 + lane * 8;
            float sa = 0.f, ca = 0.f;
#pragma unroll
            for (int j = 0; j < 2; ++j) { const u32x4 w_ = *(const u32x4*)(cr + j * 512); const f32x4 s0 = *(const f32x4*)(sp + j * 512), s1 = *(const f32x4*)(sp + j * 512 + 4), c0 = *(const f32x4*)(cp + j * 512), c1 = *(const f32x4*)(cp + j * 512 + 4);
                const f32x4 k0 = {bf_lo(w_.x), bf_hi(w_.x), bf_lo(w_.y), bf_hi(w_.y)}, k1 = {bf_lo(w_.z), bf_hi(w_.z), bf_lo(w_.w), bf_hi(w_.w)};
                sa += ((k0[0] * s0[0] + k0[1] * s0[1]) + (k0[2] * s0[2] + k0[3] * s0[3])) + ((k1[0] * s1[0] + k1[1] * s1[1]) + (k1[2] * s1[2] + k1[3] * s1[3]));
                ca += ((k0[0] * c0[0] + k0[1] * c0[1]) + (k0[2] * c0[2] + k0[3] * c0[3])) + ((k1[0] * c1[0] + k1[1] * c1[1]) + (k1[2] * c1[2] + k1[3] * c1[3])); }
            sa = wave_sum(sa); ca = wave_sum(ca);
            if (lane == 0) { const int o = (row >> 8) * 1024 + h * 256 + (row & 255); SXV[o] = sa; CXV[o] = ca; } }
    }
    SEAM(12);

    if (IN(13)) REP(13) { pg8::EpiF32 E{XS, 1024, 2, (long)SEQ * 1024, (long)T * 1024}; GEMM_CALL(pg8::EpiF32, E, ZB, MQT, D, D, 2048, 8, 4, 8, 2, (long)SEQ * D, 2048, (long)1024 * D, 2048); }
    SEAM(13);

    if (IN(14)) REP(14) { const int lane = lane_id();
        for (int it = gw; it < T * 4; it += NGW) {
            const size_t off = (size_t)it * 256 + lane * 4; const int tok = it >> 2, fo = (tok >> 11) * 1024 + (it & 3) * 256 + lane * 4;
            const f32x4 a0 = __builtin_nontemporal_load((const f32x4*)(XS + off)), a1 = __builtin_nontemporal_load((const f32x4*)(XS + (size_t)T * 1024 + off)), sx = *(const f32x4*)(SXV + fo), cx = *(const f32x4*)(CXV + fo);
            const f32x2 st = *(const f32x2*)(RS1 + (size_t)tok * 2);
            const float mean = st.x * (1.0f / D), rstd = rsqrtf(st.y * (1.0f / D) - mean * mean + LN_EPS);
            const f32x4 a = (((a0 + a1) - sx * mean) * rstd + cx) * 0.03125f;
            const float mx = wave_max(fmaxf(fmaxf(a[0], a[1]), fmaxf(a[2], a[3])));
            f32x4 e; e[0] = __expf(a[0] - mx); e[1] = __expf(a[1] - mx); e[2] = __expf(a[2] - mx); e[3] = __expf(a[3] - mx);
            const float inv = 1.0f / wave_sum((e[0] + e[1]) + (e[2] + e[3]));
            u32x2 w; w.x = cvt_pk_bf16(e[0] * inv, e[1] * inv); w.y = cvt_pk_bf16(e[2] * inv, e[3] * inv);
            *(u32x2*)(XP + off) = w;
        }
    }
    SEAM(14);
    if (IN(15)) REP(15) { typedef pg8::EpiResLN<WS_ZB, WS_RS1, WS_RS2, true, SEQ> EpiT15; EpiT15 E{ws, in_ln1_g, in_ln1_b}; GEMM_CALL(EpiT15, E, XP, VWT, 1024, 1024, 1024, 8, 16, 4, 1, (long)SEQ * 1024, 0, (long)D * 1024, 0); }
    SEAM(15);
    if (IN(17)) REP(17) { typedef pg8::EpiFfnConv<WS_ACT, WS_EDGE, WS_RS2, WS_S2, WS_C2, WS_CONVW, WS_CONVB> EpiT17; EpiT17 E{ws, (LAS unsigned*)(lds + TR_OFF)};
        GEMM_CALL(EpiT17, E, ZB, Wfi_t, D, D, D, 32, 86, 1, 1, 0, 0, 0, 0);
        const int lane = lane_id();
        if (split && bx >= 192) CONV_WFO(I_FO_P2, I_FO, (bx - 192) * NWAVES + wave, 64 * NWAVES); }
    SEAM(17);

    if (IN(18)) REP(18) { const int lane = lane_id();
        constexpr int CU8 = DFF / 8, NIT = 64 * CU8;
        for (int it = gtid; it < NIT; it += NGT) {
            const int pe = it / CU8, cu = it - pe * CU8, c0 = cu * 8, pmi = pe >> 1, bot = pe & 1;
            const int tp = ((c0 >> 7) * 256 + (c0 & 127)) >> 1;
            const unsigned* e0 = EDGE + (size_t)(pmi * 4) * (DFF2 / 2) + tp;
            const bool hasp = bot ? true : (pmi & 7) != 0, hasn = bot ? (pmi & 7) != 7 : true;
            const unsigned* pp = bot ? e0 + 2 * (size_t)(DFF2 / 2) : e0 - (size_t)(DFF2 / 2);
            const unsigned* pc = bot ? e0 + 3 * (size_t)(DFF2 / 2) : e0;
            const unsigned* pn_ = bot ? e0 + 4 * (size_t)(DFF2 / 2) : e0 + (size_t)(DFF2 / 2);
            const u32x4 z4 = {0u, 0u, 0u, 0u};
            const u32x4 up = hasp ? *(const u32x4*)pp : z4, uc = *(const u32x4*)pc, un = hasn ? *(const u32x4*)pn_ : z4;
            const u32x4 gp = hasp ? *(const u32x4*)(pp + 64) : z4, gc = *(const u32x4*)(pc + 64), gn = hasn ? *(const u32x4*)(pn_ + 64) : z4;
            float o[8];
#pragma unroll
            for (int q = 0; q < 4; ++q) { const int c = c0 + 2 * q;
                const float u0 = bf_lo(up[q]) * in_conv_w[c] + bf_lo(uc[q]) * in_conv_w[DFF2 + c] + bf_lo(un[q]) * in_conv_w[2 * (size_t)DFF2 + c] + in_conv_b[c];
                const float u1 = bf_hi(up[q]) * in_conv_w[c + 1] + bf_hi(uc[q]) * in_conv_w[DFF2 + c + 1] + bf_hi(un[q]) * in_conv_w[2 * (size_t)DFF2 + c + 1] + in_conv_b[c + 1];
                const float g0 = bf_lo(gp[q]) * in_conv_w[DFF + c] + bf_lo(gc[q]) * in_conv_w[DFF2 + DFF + c] + bf_lo(gn[q]) * in_conv_w[2 * (size_t)DFF2 + DFF + c] + in_conv_b[DFF + c];
                const float g1 = bf_hi(gp[q]) * in_conv_w[DFF + c + 1] + bf_hi(gc[q]) * in_conv_w[DFF2 + DFF + c + 1] + bf_hi(gn[q]) * in_conv_w[2 * (size_t)DFF2 + DFF + c + 1] + in_conv_b[DFF + c + 1];
                o[2 * q] = siluf_(g0) * u0; o[2 * q + 1] = siluf_(g1) * u1; }
            u32x4 w; w.x = cvt_pk_bf16(o[0], o[1]); w.y = cvt_pk_bf16(o[2], o[3]); w.z = cvt_pk_bf16(o[4], o[5]); w.w = cvt_pk_bf16(o[6], o[7]);
            *(u32x4*)(ACT + (size_t)(pmi * 256 + (bot ? 255 : 0)) * DFF + c0) = w;
        }
    }
    SEAM(18);
    if (IN(19)) REP(19) { typedef pg8::EpiResLN<WS_ZB, WS_RS2, WS_RS3, false> EpiT19; EpiT19 E{ws, in_ln2_g, in_ln2_b}; GEMM_CALL(EpiT19, E, ACT, Wfo_t, DFF, DFF, DFF, 32, 16, 1, 1, 0, 0, 0, 0); }
    SEAM(19);
    if (IN(20)) REP(20) { const int lane = lane_id();
        for (int m = gw; m < T; m += NGW) {
            const u32x4* zr = (const u32x4*)(ZB + (size_t)m * D) + lane; f32x4* orow = (f32x4*)(args.out + (size_t)m * D);
            f32x4 z[16]; float s_ = 0.f;
#pragma unroll
            for (int j = 0; j < 8; ++j) { const u32x4 zw = __builtin_nontemporal_load(zr + 64 * j); z[2 * j] = (f32x4){bf_lo(zw.x), bf_hi(zw.x), bf_lo(zw.y), bf_hi(zw.y)}; z[2 * j + 1] = (f32x4){bf_lo(zw.z), bf_hi(zw.z), bf_lo(zw.w), bf_hi(zw.w)};
                s_ += ((z[2 * j][0] + z[2 * j][1]) + (z[2 * j][2] + z[2 * j][3])) + ((z[2 * j + 1][0] + z[2 * j + 1][1]) + (z[2 * j + 1][2] + z[2 * j + 1][3])); }
            const float mean = wave_sum(s_) * (1.0f / D); float q_ = 0.f;
#pragma unroll
            for (int j = 0; j < 16; ++j) { z[j] = z[j] - mean; q_ += (z[j][0] * z[j][0] + z[j][1] * z[j][1]) + (z[j][2] * z[j][2] + z[j][3] * z[j][3]); }
            const float rstd = rsqrtf(wave_sum(q_) * (1.0f / D) + LN_EPS);
#pragma unroll
            for (int j = 0; j < 8; ++j) { const int c4 = (64 * j + lane) * 2;
                const f32x4 g0 = ((const f32x4*)in_ln3_g)[c4], g1 = ((const f32x4*)in_ln3_g)[c4 + 1], b0 = ((const f32x4*)in_ln3_b)[c4], b1 = ((const f32x4*)in_ln3_b)[c4 + 1];
                __builtin_nontemporal_store(z[2 * j] * rstd * g0 + b0, orow + c4); __builtin_nontemporal_store(z[2 * j + 1] * rstd * g1 + b1, orow + c4 + 1); }
        }
    }
#undef IN
#undef SEAM
}

extern "C" void kernel_launch(void* const* d_in, const int* in_sizes, int n_in, void* d_out, int out_size, void* d_ws, size_t ws_size, hipStream_t stream) {
    static int grid = 0;
    if (grid == 0) {
        if (n_in != 28 || in_sizes[0] != T * D || out_size != T * D || ws_size < WS_END) { fprintf(stderr, "kernel_launch: unexpected shapes (n_in %d, in0 %d, out %d, ws %zu < %zu)\n", n_in, n_in > 0 ? in_sizes[0] : -1, out_size, ws_size, (size_t)WS_END); grid = -1; return; }
        int dev = 0, cus = 0, per_cu = 0;
        if (hipGetDevice(&dev) != hipSuccess || hipDeviceGetAttribute(&cus, hipDeviceAttributeMultiprocessorCount, dev) != hipSuccess) { grid = -1; return; }
        if (hipFuncSetAttribute((const void*)mk_fwd, hipFuncAttributeMaxDynamicSharedMemorySize, LDS_BYTES) != hipSuccess) { fprintf(stderr, "kernel_launch: hipFuncSetAttribute failed\n"); grid = -1; return; }
        if (hipOccupancyMaxActiveBlocksPerMultiprocessor(&per_cu, (const void*)mk_fwd, NWAVES * 64, LDS_BYTES) != hipSuccess || per_cu < 1) fprintf(stderr, "kernel_launch: occupancy query says %d\n", per_cu);
        (void)hipGetLastError();
        grid = cus;
    }
    if (grid < 0) return;
    (void)hipMemsetAsync((char*)d_ws + WS_CTL, 0, CTL_ZERO_BYTES, stream);
    Args a{};
    for (int i = 0; i < 28; ++i) a.in[i] = d_in[i];
    a.out = (float*)d_out; a.ws = (unsigned char*)d_ws;
#if MK_PER_PHASE
    for (int p = 0; p < NPHASE; ++p) { a.ph_lo = p; a.ph_hi = p + 1; hipLaunchKernelGGL(mk_fwd, dim3(grid), dim3(NWAVES * 64), LDS_BYTES, stream, a); }
#else
    a.ph_lo = 0; a.ph_hi = NPHASE; hipLaunchKernelGGL(mk_fwd, dim3(grid), dim3(NWAVES * 64), LDS_BYTES, stream, a);
#endif
    const hipError_t le = hipPeekAtLastError();
    if (le != hipSuccess) fprintf(stderr, "kernel_launch: launch failed: %s\n", hipGetErrorName(le));
}
```
